# Optimizing an MI355X kernel written in HIP

```python
import jax, jax.numpy as jnp
from jax import lax
import numpy as np

D_MODEL = 1024
BATCH = 16
SEQ = 2048
DEPTH = 1

D_MIX = D_MODEL
D_ATTN = D_MIX // 2
N_ATTN_HEADS = 8
HEAD_DIM = D_ATTN // N_ATTN_HEADS
D_CONV = D_MIX - D_ATTN
CONV_WIDTH = 31
Q_BLOCK = 128
D_IN_PROJ = 3 * D_ATTN + N_ATTN_HEADS + 2 * D_CONV
N_KEYS = 128
N_EXPERTS = N_KEYS * N_KEYS
PEER_HEADS = 8
PEER_QUERY_DIM = 256
PEER_HALF = PEER_QUERY_DIM // 2
PEER_TOPK = 16
PEER_CHUNK = 128
D_PLE = 256
EPS = 1e-6
LN_EPS = 1e-5

kernel_name = "hymba_fox_conformer_peer_layer"


def rmsnorm(x, g, eps=EPS):
    xf = x.astype(jnp.float32)
    y = xf * lax.rsqrt(jnp.mean(xf * xf, axis=-1, keepdims=True) + eps)
    return (y * g.astype(jnp.float32)).astype(x.dtype)


def layernorm(x, g, b, eps=LN_EPS):
    xf = x.astype(jnp.float32)
    mu = jnp.mean(xf, axis=-1, keepdims=True)
    var = jnp.mean(jnp.square(xf - mu), axis=-1, keepdims=True)
    y = (xf - mu) * lax.rsqrt(var + eps)
    return (y * g.astype(jnp.float32) + b.astype(jnp.float32)).astype(x.dtype)


def forgetting_attention(q, k, v, logf):
    b, s, h, dh = q.shape
    scale = dh ** -0.5
    qh = q.transpose(0, 2, 1, 3)
    kh = k.transpose(0, 2, 1, 3)
    vh = v.transpose(0, 2, 1, 3)
    F = jnp.cumsum(logf.astype(jnp.float32), axis=1).transpose(0, 2, 1)
    outs = []
    for blk in range(s // Q_BLOCK):
        q0 = blk * Q_BLOCK
        end = q0 + Q_BLOCK
        qb = qh[:, :, q0:end]
        kb = kh[:, :, :end]
        vb = vh[:, :, :end]
        logits = jnp.einsum('bhqd,bhkd->bhqk', qb, kb).astype(jnp.float32) * scale
        logits = logits + F[:, :, q0:end, None] - F[:, :, None, :end]
        qpos = q0 + jnp.arange(Q_BLOCK)
        kpos = jnp.arange(end)
        mask = qpos[:, None] >= kpos[None, :]
        logits = jnp.where(mask[None, None], logits, jnp.finfo(jnp.float32).min)
        probs = jax.nn.softmax(logits, axis=-1)
        outs.append(jnp.einsum('bhqk,bhkd->bhqd', probs.astype(vb.dtype), vb))
    o = jnp.concatenate(outs, axis=2)
    return o.transpose(0, 2, 1, 3).reshape(b, s, h * dh)


def conformer_conv(a, g, conv_w, conv_b, ln_g, ln_b):
    u = a * jax.nn.sigmoid(g)
    y = lax.conv_general_dilated(
        u, conv_w.astype(u.dtype), window_strides=(1,), padding=[(CONV_WIDTH - 1, 0)],
        dimension_numbers=('NWC', 'WIO', 'NWC'), feature_group_count=D_CONV)
    y = y + conv_b.astype(y.dtype)
    y = layernorm(y, ln_g, ln_b)
    return jax.nn.silu(y)


def peer_ffn(xn, w_q, sub_keys1, sub_keys2, expert_u, expert_v):
    b, s, d = xn.shape
    qp = (xn @ w_q).reshape(b, s, PEER_HEADS, PEER_QUERY_DIM)
    q1, q2 = qp[..., :PEER_HALF], qp[..., PEER_HALF:]
    s1 = jnp.einsum('bshd,kd->bshk', q1, sub_keys1).astype(jnp.float32)
    s2 = jnp.einsum('bshd,kd->bshk', q2, sub_keys2).astype(jnp.float32)
    v1, i1 = lax.top_k(s1, PEER_TOPK)
    v2, i2 = lax.top_k(s2, PEER_TOPK)
    cand = (v1[..., :, None] + v2[..., None, :]).reshape(b, s, PEER_HEADS, PEER_TOPK * PEER_TOPK)
    vs, ic = lax.top_k(cand, PEER_TOPK)
    e1 = jnp.take_along_axis(i1, ic // PEER_TOPK, axis=-1)
    e2 = jnp.take_along_axis(i2, ic % PEER_TOPK, axis=-1)
    idx = e1 * N_KEYS + e2
    gates = jax.nn.softmax(vs, axis=-1)
    t = b * s
    n_sel = PEER_HEADS * PEER_TOPK
    xt = xn.reshape(t // PEER_CHUNK, PEER_CHUNK, d)
    it = idx.reshape(t // PEER_CHUNK, PEER_CHUNK, n_sel)
    gt = gates.reshape(t // PEER_CHUNK, PEER_CHUNK, n_sel).astype(xn.dtype)

    def chunk_fn(args):
        xc, ic_, gc = args
        act = jax.nn.gelu(jnp.einsum('ckd,cd->ck', expert_u[ic_], xc))
        return jnp.einsum('ck,ckd->cd', gc * act, expert_v[ic_])

    out = lax.map(chunk_fn, (xt, it, gt))
    return out.reshape(b, s, d)


def setup_inputs(seed: int = 0) -> dict:
    key = jax.random.key(seed)
    ks = jax.random.split(key, 24)
    f32 = jnp.float32
    nrm = lambda k, shape, sc: jax.random.normal(k, shape, f32) * sc
    gain = lambda k, shape: 1.0 + 0.05 * jax.random.normal(k, shape, f32)
    L = DEPTH
    return {
        "x": nrm(ks[0], (BATCH, SEQ, D_MODEL), 1.0),
        "p": nrm(ks[1], (DEPTH, BATCH, SEQ, D_PLE), 1.0),
        "ln_mix": gain(ks[2], (L, D_MODEL)),
        "w_in": nrm(ks[3], (L, D_MODEL, D_IN_PROJ), D_MODEL ** -0.5),
        "b_fgate": 2.0 + 0.5 * jax.random.normal(ks[4], (L, N_ATTN_HEADS), f32),
        "q_norm": gain(ks[5], (L, HEAD_DIM)),
        "k_norm": gain(ks[6], (L, HEAD_DIM)),
        "conv_w": nrm(ks[7], (L, CONV_WIDTH, 1, D_CONV), CONV_WIDTH ** -0.5),
        "conv_b": nrm(ks[8], (L, D_CONV), 0.02),
        "conv_ln_g": gain(ks[9], (L, D_CONV)),
        "conv_ln_b": nrm(ks[10], (L, D_CONV), 0.02),
        "attn_out_norm": gain(ks[11], (L, D_ATTN)),
        "conv_out_norm": gain(ks[12], (L, D_CONV)),
        "w_out": nrm(ks[13], (L, D_MIX, D_MODEL), D_MIX ** -0.5),
        "ln_ffn": gain(ks[14], (L, D_MODEL)),
        "w_peer_q": nrm(ks[15], (L, D_MODEL, PEER_HEADS * PEER_QUERY_DIM), D_MODEL ** -0.5),
        "sub_keys1": nrm(ks[16], (L, N_KEYS, PEER_HALF), PEER_HALF ** -0.5),
        "sub_keys2": nrm(ks[17], (L, N_KEYS, PEER_HALF), PEER_HALF ** -0.5),
        "expert_u": nrm(ks[18], (L, N_EXPERTS, D_MODEL), D_MODEL ** -0.5),
        "expert_v": nrm(ks[19], (L, N_EXPERTS, D_MODEL), PEER_HEADS ** -0.5),
        "ln_pl": gain(ks[20], (L, D_MODEL)),
        "w_pl_gate": nrm(ks[21], (L, D_MODEL, D_MODEL), D_MODEL ** -0.5),
        "w_pl_proj": nrm(ks[22], (L, D_PLE, D_MODEL), D_PLE ** -0.5),
    }


def reference(x, p, ln_mix, w_in, b_fgate, q_norm, k_norm, conv_w, conv_b, conv_ln_g, conv_ln_b,
              attn_out_norm, conv_out_norm, w_out, ln_ffn, w_peer_q, sub_keys1, sub_keys2,
              expert_u, expert_v, ln_pl, w_pl_gate, w_pl_proj):
    b, s, _ = x.shape
    h = x
    for i in range(DEPTH):
        xn = rmsnorm(h, ln_mix[i])
        z = xn @ w_in[i]
        o = 0
        q = z[..., o:o + D_ATTN]; o += D_ATTN
        k = z[..., o:o + D_ATTN]; o += D_ATTN
        v = z[..., o:o + D_ATTN]; o += D_ATTN
        f_logit = z[..., o:o + N_ATTN_HEADS]; o += N_ATTN_HEADS
        glu_a = z[..., o:o + D_CONV]; o += D_CONV
        glu_g = z[..., o:o + D_CONV]
        q = rmsnorm(q.reshape(b, s, N_ATTN_HEADS, HEAD_DIM), q_norm[i])
        k = rmsnorm(k.reshape(b, s, N_ATTN_HEADS, HEAD_DIM), k_norm[i])
        v = v.reshape(b, s, N_ATTN_HEADS, HEAD_DIM)
        logf = jax.nn.log_sigmoid(f_logit.astype(jnp.float32) + b_fgate[i].astype(jnp.float32))
        y_attn = forgetting_attention(q, k, v, logf)
        y_conv = conformer_conv(glu_a, glu_g, conv_w[i], conv_b[i], conv_ln_g[i], conv_ln_b[i])
        y = jnp.concatenate([rmsnorm(y_attn, attn_out_norm[i]),
                             rmsnorm(y_conv, conv_out_norm[i])], axis=-1)
        h = h + y @ w_out[i]
        h = h + peer_ffn(rmsnorm(h, ln_ffn[i]), w_peer_q[i], sub_keys1[i], sub_keys2[i],
                         expert_u[i], expert_v[i])
        gate = jax.nn.sigmoid(rmsnorm(h, ln_pl[i]) @ w_pl_gate[i])
        h = h + gate * (p[i] @ w_pl_proj[i])
    return h
```

```cpp
#include <hip/hip_runtime.h>
#include <hip/hip_bf16.h>
#include <cstdio>
#include <cstdint>
#include <cmath>

#define MK_ONE_LAUNCH 1
#define SELFCHECK 0
#ifndef LAST_PHASE
#define LAST_PHASE 99
#endif

#ifndef PH_MASK
#define PH_MASK 0x1ff
#endif

constexpr int BATCH = 16, SEQ = 2048, DMODEL = 1024, T = BATCH * SEQ;
constexpr int DATT = 512, NH = 8, HD = 64, DCONV = 512, CW = 31;
constexpr int NIN = 2568, NINP = 2560;
constexpr int COL_F = 1536, COL_A = 1544, COL_G = 2056;
constexpr int NKEY = 128, NEXP = 16384, PH = 8, PQ = 256, PHALF = 128, PK = 16, NSEL = PH * PK;
constexpr int DPLE = 256;
constexpr float EPS = 1e-6f, LN_EPS = 1e-5f;
constexpr float LOG2E = 1.4426950408889634f;

namespace pg8 {
#define PG8_LAS __attribute__((address_space(3)))
typedef unsigned short bf16_t;
typedef short bf16x8 __attribute__((ext_vector_type(8)));
typedef float f32x4 __attribute__((ext_vector_type(4)));
typedef unsigned u32x4 __attribute__((ext_vector_type(4)));
constexpr int BM = 256, BK = 64, HALF = 128, HTB = HALF * BK * 2  , STAGE_BYTES = 8 * HTB, NXCD = 8, WGM = 8;

__host__ __device__ __forceinline__ int lds_byte(int r, int c) { const int st = (r >> 4) * 2 + (c >> 5), rr = r & 15, cc = c & 31, ob = rr * 64 + cc * 2; return st * 1024 + (ob ^ (((ob >> 9) & 1) << 5)); }
__host__ __device__ __forceinline__ void stage_rc(int b, int& R, int& C) { const int st = b / 1024, sb = b % 1024, swz = sb ^ (((sb >> 9) & 1) << 5); R = (st >> 1) * 16 + swz / 64; C = (st & 1) * 32 + (swz % 64) / 2; }
__host__ __device__ __forceinline__ int perm32(int rho) { const int n = rho >> 4, i = rho & 15; return 8 * (i >> 2) + 4 * n + (i & 3); }

struct Unit { int pm, pn; };
struct Gemm { const bf16_t* A; const bf16_t* Bt; int M, N, K; };

struct StaticOrder {
    int nM, nN, nwg, G, c;
    __host__ __device__ void init(int M, int N, int G_, int c_) { nM = M / BM; nN = N / BM; nwg = nM * nN; G = G_; c = c_; }
    __host__ __device__ bool next(int i, Unit& u) const {
        const long L = (long)i * G + c; if (L >= nwg) return false;
        int wgid = (int)L; { const int q = nwg / NXCD, r = nwg % NXCD, xcd = wgid % NXCD, off = wgid / NXCD; wgid = (xcd < r ? xcd * (q + 1) : r * (q + 1) + (xcd - r) * q) + off; }
        const int nig = WGM * nN, gid = wgid / nig, fm = gid * WGM, gsz = (nM - fm) < WGM ? (nM - fm) : WGM;
        u.pm = fm + ((wgid % nig) % gsz); u.pn = (wgid % nig) / gsz; return true;
    }
    __device__ __forceinline__ void a_ready(const Unit&) const {}
    __device__ __forceinline__ void done(const Unit&) const {}
};

template <class Epi, class Sched, bool ALIGN_EPI = false, bool SP2 = false>
__device__ __forceinline__ void gemm_phase(PG8_LAS unsigned char* lds, const Gemm g, const Sched& S, const Epi& E) {
    const int tid = threadIdx.x, wid = __builtin_amdgcn_readfirstlane(tid >> 6), lane = tid & 63, wr = wid >> 2, wc = wid & 3, fr = lane & 15, fq = lane >> 4;
    const int K = g.K, nt = K / BK;
    unsigned voffA[2], voffB[2];
#pragma unroll
    for (int i = 0; i < 2; ++i) { int R, C; stage_rc(tid * 16 + i * 8192, R, C); const int Rb = Epi::PERM ? ((R & ~31) + perm32(R & 31)) : R;
        voffA[i] = (unsigned)(R * K + C) * 2u; voffB[i] = (unsigned)(Rb * K + C) * 2u; }
    const size_t kstep = (size_t)(BK * 2);
    const size_t hstep = (size_t)HALF * K * 2;
    const size_t tstep = 2 * hstep;
    const unsigned ldsw = (unsigned)wid * 1024u;
    const int aoff = lds_byte(wr * 64 + fr, fq * 8), boff = lds_byte(wc * 32 + fr, fq * 8);
#define PG8_SA(b, h) (((b) * 2 + (h)) * HTB)
#define PG8_SB(b, h) ((4 + (b) * 2 + (h)) * HTB)
#define PG8_STAGE(bufoff, gbase, voff) do { _Pragma("unroll") for (int _i = 0; _i < 2; ++_i) \
        __builtin_amdgcn_global_load_lds((const unsigned*)((const char*)(gbase) + (voff)[_i]), (PG8_LAS unsigned*)(lds + (bufoff) + ldsw + _i * 8192), 16, 0, 0); } while (0)
#define PG8_LDA(dst, b, h) do { _Pragma("unroll") for (int m = 0; m < 4; ++m) _Pragma("unroll") for (int k = 0; k < 2; ++k) dst[m][k] = *(const PG8_LAS bf16x8*)(lds + PG8_SA(b, h) + aoff + m * 2048 + k * 1024); } while (0)
#define PG8_LDB(dst, b, h) do { _Pragma("unroll") for (int n = 0; n < 2; ++n) _Pragma("unroll") for (int k = 0; k < 2; ++k) dst[n][k] = *(const PG8_LAS bf16x8*)(lds + PG8_SB(b, h) + boff + n * 2048 + k * 1024); } while (0)
#define PG8_MMA(ai, bj, At, Bt) do { __builtin_amdgcn_s_setprio(1); _Pragma("unroll") for (int m = 0; m < 4; ++m) _Pragma("unroll") for (int n = 0; n < 2; ++n) _Pragma("unroll") for (int k = 0; k < 2; ++k) \
        acc[ai][bj][m][n] = __builtin_amdgcn_mfma_f32_16x16x32_bf16(Bt[n][k], At[m][k], acc[ai][bj][m][n], 0, 0, 0); __builtin_amdgcn_s_setprio(0); } while (0)
#define PG8_WAIT_V(n) asm volatile("s_waitcnt vmcnt(" #n ")" ::: "memory")
#define PG8_WAIT_L(n) asm volatile("s_waitcnt lgkmcnt(" #n ")" ::: "memory")
#define PG8_BAR __builtin_amdgcn_s_barrier()
#define PG8_SCHED __builtin_amdgcn_sched_barrier(0)
    Unit cur, nxt; int ui = 0;
    if (!S.next(0, cur)) return;
    f32x4 acc[2][2][4][2];
#pragma unroll
    for (int a = 0; a < 2; ++a)
#pragma unroll
        for (int b = 0; b < 2; ++b)
#pragma unroll
            for (int m = 0; m < 4; ++m)
#pragma unroll
                for (int n = 0; n < 2; ++n) acc[a][b][m][n] = (f32x4){0.f, 0.f, 0.f, 0.f};
    bf16x8 At[4][2], B0[2][2], B1[2][2];
    const char* cA = (const char*)g.A + (size_t)cur.pm * tstep; const char* cB = (const char*)g.Bt + (size_t)cur.pn * tstep;
    S.a_ready(cur);
    if constexpr (SP2) {
        PG8_STAGE(PG8_SB(0, 0), cB, voffB); PG8_STAGE(PG8_SB(0, 1), cB + hstep, voffB); PG8_STAGE(PG8_SA(0, 0), cA, voffA); PG8_STAGE(PG8_SA(0, 1), cA + hstep, voffA);
        if (wr == 1) PG8_BAR;
        PG8_WAIT_V(2); PG8_BAR;
        PG8_STAGE(PG8_SB(1, 0), cB + kstep, voffB); PG8_STAGE(PG8_SA(1, 0), cA + kstep, voffA); PG8_STAGE(PG8_SB(1, 1), cB + hstep + kstep, voffB);
        PG8_WAIT_V(6); PG8_BAR;
    } else {
        PG8_STAGE(PG8_SB(0, 0), cB, voffB); PG8_STAGE(PG8_SA(0, 0), cA, voffA); PG8_STAGE(PG8_SB(0, 1), cB + hstep, voffB); PG8_STAGE(PG8_SA(0, 1), cA + hstep, voffA);
        if (wr == 1) PG8_BAR;
        PG8_WAIT_V(4); PG8_BAR;
        PG8_STAGE(PG8_SB(1, 0), cB + kstep, voffB); PG8_STAGE(PG8_SA(1, 0), cA + kstep, voffA); PG8_STAGE(PG8_SB(1, 1), cB + hstep + kstep, voffB);
        PG8_WAIT_V(6); PG8_BAR;
    }
    for (;;) {
        const bool has_next = S.next(ui + 1, nxt);
        const char* nA = has_next ? (const char*)g.A + (size_t)nxt.pm * tstep : cA; const char* nB = has_next ? (const char*)g.Bt + (size_t)nxt.pn * tstep : cB;
        for (int t = 0; t < nt; t += 2) {
            if constexpr (Epi::MIDK > 0) { if (t == Epi::MIDK) E.mid(acc, cur, ui, lds, wr, wc, fr, fq); }
            const bool last = (t == nt - 2);
            const char* a1 = cA + (size_t)(t + 1) * kstep;
            const char* a2 = last ? nA : cA + (size_t)(t + 2) * kstep; const char* b2 = last ? nB : cB + (size_t)(t + 2) * kstep;
            const char* a3 = a2 + kstep; const char* b3 = b2 + kstep;
            if (last && has_next) S.a_ready(nxt);
            if constexpr (SP2) {
            PG8_LDB(B0, 0, 0); PG8_LDB(B1, 0, 1); PG8_SCHED; PG8_LDA(At, 0, 0); PG8_STAGE(PG8_SA(1, 1), a1 + hstep, voffA);
            PG8_WAIT_V(8); PG8_WAIT_L(0); PG8_BAR; PG8_MMA(0, 0, At, B0); PG8_MMA(0, 1, At, B1); PG8_BAR; PG8_SCHED;
            PG8_LDA(At, 0, 1); PG8_STAGE(PG8_SB(0, 0), b2, voffB); PG8_STAGE(PG8_SB(0, 1), b2 + hstep, voffB); PG8_STAGE(PG8_SA(0, 0), a2, voffA);
            PG8_WAIT_V(8); PG8_WAIT_L(0); PG8_BAR; PG8_MMA(1, 0, At, B0); PG8_MMA(1, 1, At, B1); PG8_BAR; PG8_SCHED;
            PG8_LDB(B0, 1, 0); PG8_LDB(B1, 1, 1); PG8_SCHED; PG8_LDA(At, 1, 0); PG8_STAGE(PG8_SA(0, 1), a2 + hstep, voffA);
            PG8_WAIT_V(8); PG8_WAIT_L(0); PG8_BAR; PG8_MMA(0, 0, At, B0); PG8_MMA(0, 1, At, B1); PG8_BAR; PG8_SCHED;
            PG8_LDA(At, 1, 1); PG8_STAGE(PG8_SB(1, 0), b3, voffB); PG8_STAGE(PG8_SB(1, 1), b3 + hstep, voffB); PG8_STAGE(PG8_SA(1, 0), a3, voffA);
            PG8_WAIT_V(8); PG8_WAIT_L(0); PG8_BAR; PG8_MMA(1, 0, At, B0); PG8_MMA(1, 1, At, B1); PG8_BAR; PG8_SCHED;
            } else {
            PG8_LDB(B0, 0, 0); PG8_SCHED; PG8_LDA(At, 0, 0); PG8_STAGE(PG8_SA(1, 1), a1 + hstep, voffA);
            PG8_WAIT_L(8); PG8_BAR; PG8_WAIT_L(0); PG8_MMA(0, 0, At, B0); PG8_BAR; PG8_SCHED;
            PG8_LDB(B1, 0, 1); PG8_STAGE(PG8_SB(0, 0), b2, voffB);
            PG8_BAR; PG8_WAIT_L(0); PG8_MMA(0, 1, At, B1); PG8_BAR;
            PG8_LDA(At, 0, 1); PG8_STAGE(PG8_SA(0, 0), a2, voffA);
            PG8_BAR; PG8_WAIT_L(0); PG8_MMA(1, 0, At, B0); PG8_BAR; PG8_SCHED;
            PG8_STAGE(PG8_SB(0, 1), b2 + hstep, voffB);
            PG8_WAIT_V(6); PG8_BAR; PG8_MMA(1, 1, At, B1); PG8_BAR;
            PG8_LDB(B0, 1, 0); PG8_SCHED; PG8_LDA(At, 1, 0); PG8_STAGE(PG8_SA(0, 1), a2 + hstep, voffA);
            PG8_WAIT_L(8); PG8_BAR; PG8_WAIT_L(0); PG8_MMA(0, 0, At, B0); PG8_BAR; PG8_SCHED;
            PG8_LDB(B1, 1, 1); PG8_STAGE(PG8_SB(1, 0), b3, voffB);
            PG8_BAR; PG8_WAIT_L(0); PG8_MMA(0, 1, At, B1); PG8_BAR;
            PG8_LDA(At, 1, 1); PG8_STAGE(PG8_SA(1, 0), a3, voffA);
            PG8_BAR; PG8_WAIT_L(0); PG8_MMA(1, 0, At, B0); PG8_BAR; PG8_SCHED;
            PG8_STAGE(PG8_SB(1, 1), b3 + hstep, voffB);
            PG8_WAIT_V(6); PG8_BAR; PG8_MMA(1, 1, At, B1); PG8_BAR;
            }
        }
        if constexpr (ALIGN_EPI) { if (wr == 0) PG8_BAR; }
        if constexpr (!Epi::AFTER_DRAIN) { E(acc, cur, wr, wc, fr, fq); S.done(cur); }
        if (!has_next) break;
#pragma unroll
        for (int a = 0; a < 2; ++a)
#pragma unroll
            for (int b = 0; b < 2; ++b)
#pragma unroll
                for (int m = 0; m < 4; ++m)
#pragma unroll
                    for (int n = 0; n < 2; ++n) acc[a][b][m][n] = (f32x4){0.f, 0.f, 0.f, 0.f};
        cur = nxt; cA = nA; cB = nB; ++ui;
        if constexpr (ALIGN_EPI) { if (wr == 1) PG8_BAR; }
    }
    PG8_WAIT_V(0);
    if constexpr (!ALIGN_EPI) { if (wr == 0) PG8_BAR; }
    PG8_BAR;
    if constexpr (Epi::AFTER_DRAIN) { E.fused(acc, cur, wr, wc, fr, fq, lds, wid, lane); S.done(cur); }
#undef PG8_SA
#undef PG8_SB
#undef PG8_STAGE
#undef PG8_LDA
#undef PG8_LDB
#undef PG8_MMA
#undef PG8_WAIT_V
#undef PG8_WAIT_L
#undef PG8_BAR
#undef PG8_SCHED
}
}
namespace pg8 {
typedef float f32x2_t __attribute__((ext_vector_type(2))); typedef __bf16 bf16x2_t __attribute__((ext_vector_type(2)));
__device__ __forceinline__ unsigned cvt_pk_bf16(float lo, float hi) { f32x2_t v = {lo, hi}; bf16x2_t b = __builtin_convertvector(v, bf16x2_t); return __builtin_bit_cast(unsigned, b); }
__device__ __forceinline__ u32x4 pack8(const f32x4 a, const f32x4 b) { u32x4 w; w.x = cvt_pk_bf16(a[0], a[1]); w.y = cvt_pk_bf16(a[2], a[3]); w.z = cvt_pk_bf16(b[0], b[1]); w.w = cvt_pk_bf16(b[2], b[3]); return w; }
__device__ __forceinline__ float bf_lo(unsigned w) { return __uint_as_float(w << 16); }
__device__ __forceinline__ float bf_hi(unsigned w) { return __uint_as_float(w & 0xffff0000u); }
__device__ __forceinline__ float sigmoidf_fast(float v) { return __builtin_amdgcn_rcpf(1.0f + __builtin_amdgcn_exp2f(-v * 1.4426950408889634f)); }
constexpr float ATT_C2 = 0.125f * 1.4426950408889634f;

struct EpiInProj {
    static constexpr bool PERM = true, AFTER_DRAIN = false; static constexpr int MIDK = 0;
    bf16_t* QKV; bf16_t* U; const float* rs1; const float* qn; const float* kn;
    __device__ __forceinline__ void mid(f32x4 (&)[2][2][4][2], const Unit&, int, PG8_LAS unsigned char*, int, int, int, int) const {}
    __device__ __forceinline__ void operator()(const f32x4 (&acc)[2][2][4][2], const Unit& u, int wr, int wc, int fr, int fq) const {
        const int row0 = u.pm * BM + wr * 64 + fr;
        if (u.pn < 6) {
            const int kind = u.pn >> 1, head = 4 * (u.pn & 1) + wc;
            f32x4 gs[2][2];
#pragma unroll
            for (int bj = 0; bj < 2; ++bj)
#pragma unroll
                for (int n = 0; n < 2; ++n) { const int d = 32 * bj + 8 * fq + 4 * n;
                    gs[bj][n] = kind == 0 ? *(const f32x4*)(qn + d) * ATT_C2 : (kind == 1 ? *(const f32x4*)(kn + d) : (f32x4){1.f, 1.f, 1.f, 1.f}); }
            bf16_t* base = QKV + kind * 512 + head * 64 + 8 * fq;
#pragma unroll
            for (int ai = 0; ai < 2; ++ai)
#pragma unroll
                for (int m = 0; m < 4; ++m) { const int row = row0 + ai * HALF + m * 16; const float rs = rs1[row];
                    f32x4 z[2][2]; float ss = 0.f;
#pragma unroll
                    for (int bj = 0; bj < 2; ++bj)
#pragma unroll
                        for (int n = 0; n < 2; ++n) { z[bj][n] = acc[ai][bj][m][n] * rs; const f32x4 q = z[bj][n] * z[bj][n]; ss += (q[0] + q[1]) + (q[2] + q[3]); }
                    float inv = 1.f;
                    if (kind < 2) { ss += __shfl_xor(ss, 16); ss += __shfl_xor(ss, 32); inv = 1.0f / sqrtf(ss * (1.0f / 64.0f) + 1e-6f); }
#pragma unroll
                    for (int bj = 0; bj < 2; ++bj) *(u32x4*)(base + (size_t)row * 1536 + 32 * bj) = pack8(z[bj][0] * inv * gs[bj][0], z[bj][1] * inv * gs[bj][1]); }
        } else {
            bf16_t* base = U + 128 * (u.pn - 6) + 32 * wc + 8 * fq;
#pragma unroll
            for (int ai = 0; ai < 2; ++ai)
#pragma unroll
                for (int m = 0; m < 4; ++m) { const int row = row0 + ai * HALF + m * 16; const float rs = rs1[row];
                    f32x4 uu[2];
#pragma unroll
                    for (int n = 0; n < 2; ++n) { const f32x4 a = acc[ai][0][m][n] * rs, g = acc[ai][1][m][n] * rs;
                        uu[n] = (f32x4){a[0] * sigmoidf_fast(g[0]), a[1] * sigmoidf_fast(g[1]), a[2] * sigmoidf_fast(g[2]), a[3] * sigmoidf_fast(g[3])}; }
                    *(u32x4*)(base + (size_t)row * 512) = pack8(uu[0], uu[1]); }
        }
    }
};

struct EpiOutProj {
    static constexpr bool PERM = true, AFTER_DRAIN = false; static constexpr int MIDK = 8;
    const float* x; bf16_t* H1B; float* SS1P; const float* SSA;
    int rsa_off;
    __device__ __forceinline__ void mid(f32x4 (&acc)[2][2][4][2], const Unit& u, int ui, PG8_LAS unsigned char* lds, int wr, int wc, int fr, int fq) const {
        const PG8_LAS float* tab = (const PG8_LAS float*)(lds + rsa_off) + ui * BM + wr * 64 + fr;
#pragma unroll
        for (int ai = 0; ai < 2; ++ai)
#pragma unroll
            for (int m = 0; m < 4; ++m) { const float rsa = tab[ai * HALF + m * 16];
#pragma unroll
                for (int bj = 0; bj < 2; ++bj)
#pragma unroll
                    for (int n = 0; n < 2; ++n) acc[ai][bj][m][n] *= rsa; }
    }
    __device__ __forceinline__ void operator()(const f32x4 (&acc)[2][2][4][2], const Unit& u, int wr, int wc, int fr, int fq) const {
        const int row0 = u.pm * BM + wr * 64 + fr, col0 = u.pn * BM + wc * 32 + 8 * fq;
#pragma unroll
        for (int ai = 0; ai < 2; ++ai)
#pragma unroll
            for (int m = 0; m < 4; ++m) { const int row = row0 + ai * HALF + m * 16; float ss = 0.f;
#pragma unroll
                for (int bj = 0; bj < 2; ++bj) { const size_t off = (size_t)row * 1024 + col0 + bj * HALF;
                    const f32x4 h0 = *(const f32x4*)(x + off) + acc[ai][bj][m][0], h1 = *(const f32x4*)(x + off + 4) + acc[ai][bj][m][1];
                    ss += (h0[0] * h0[0] + h0[1] * h0[1]) + (h0[2] * h0[2] + h0[3] * h0[3]) + (h1[0] * h1[0] + h1[1] * h1[1]) + (h1[2] * h1[2] + h1[3] * h1[3]);
                    *(u32x4*)(H1B + off) = pack8(h0, h1); }
                ss += __shfl_xor(ss, 16); ss += __shfl_xor(ss, 32);
                if (fq == 0) SS1P[(size_t)row * 16 + u.pn * 4 + wc] = ss; }
    }
};

struct EpiRowScale {
    static constexpr bool PERM = true, AFTER_DRAIN = false; static constexpr int MIDK = 0;
    bf16_t* O; int ldc; const float* ssp; int np; float inv_n;
    __device__ __forceinline__ void mid(f32x4 (&)[2][2][4][2], const Unit&, int, PG8_LAS unsigned char*, int, int, int, int) const {}
    __device__ __forceinline__ void operator()(const f32x4 (&acc)[2][2][4][2], const Unit& u, int wr, int wc, int fr, int fq) const {
        const int row0 = u.pm * BM + wr * 64 + fr, col0 = u.pn * BM + wc * 32 + 8 * fq;
#pragma unroll
        for (int ai = 0; ai < 2; ++ai)
#pragma unroll
            for (int m = 0; m < 4; ++m) { const int row = row0 + ai * HALF + m * 16; float rs = 1.f;
                if (np > 0) { float s = 0.f; for (int i = 0; i < np; i += 4) { const f32x4 v = *(const f32x4*)(ssp + (size_t)row * np + i); s += (v[0] + v[1]) + (v[2] + v[3]); } rs = 1.0f / sqrtf(s * inv_n + 1e-6f); }
#pragma unroll
                for (int bj = 0; bj < 2; ++bj) *(u32x4*)(O + (size_t)row * ldc + col0 + bj * HALF) = pack8(acc[ai][bj][m][0] * rs, acc[ai][bj][m][1] * rs); }
    }
};

struct EpiFinal {
    static constexpr bool PERM = true, AFTER_DRAIN = false; static constexpr int MIDK = 0;
    const bf16_t* H2B; const bf16_t* PLE; const float* SS2; float* out;
    __device__ __forceinline__ void mid(f32x4 (&)[2][2][4][2], const Unit&, int, PG8_LAS unsigned char*, int, int, int, int) const {}
    __device__ __forceinline__ void operator()(const f32x4 (&acc)[2][2][4][2], const Unit& u, int wr, int wc, int fr, int fq) const {
        const int row0 = u.pm * BM + wr * 64 + fr, col0 = u.pn * BM + wc * 32 + 8 * fq;
#pragma unroll
        for (int ai = 0; ai < 2; ++ai)
#pragma unroll
            for (int m = 0; m < 4; ++m) { const int row = row0 + ai * HALF + m * 16; const float rs = 1.0f / sqrtf(SS2[row] * (1.0f / 1024.0f) + 1e-6f);
#pragma unroll
                for (int bj = 0; bj < 2; ++bj) { const size_t off = (size_t)row * 1024 + col0 + bj * HALF;
                    const u32x4 hh = *(const u32x4*)(H2B + off), pp = *(const u32x4*)(PLE + off);
                    const f32x4 a0 = acc[ai][bj][m][0] * rs, a1 = acc[ai][bj][m][1] * rs;
                    f32x4 o0, o1;
                    o0[0] = bf_lo(hh.x) + sigmoidf_fast(a0[0]) * bf_lo(pp.x); o0[1] = bf_hi(hh.x) + sigmoidf_fast(a0[1]) * bf_hi(pp.x);
                    o0[2] = bf_lo(hh.y) + sigmoidf_fast(a0[2]) * bf_lo(pp.y); o0[3] = bf_hi(hh.y) + sigmoidf_fast(a0[3]) * bf_hi(pp.y);
                    o1[0] = bf_lo(hh.z) + sigmoidf_fast(a1[0]) * bf_lo(pp.z); o1[1] = bf_hi(hh.z) + sigmoidf_fast(a1[1]) * bf_hi(pp.z);
                    o1[2] = bf_lo(hh.w) + sigmoidf_fast(a1[2]) * bf_lo(pp.w); o1[3] = bf_hi(hh.w) + sigmoidf_fast(a1[3]) * bf_hi(pp.w);
                    *(f32x4*)(out + off) = o0; *(f32x4*)(out + off + 4) = o1; } }
    }
};
}

#include <hip/hip_bf16.h>
namespace attn_body {
using bf16=__hip_bfloat16;
using bf16x8=__attribute__((ext_vector_type(8)))short;
using s16x4=__attribute__((ext_vector_type(4)))short;
using f32x16=__attribute__((ext_vector_type(16)))float;
using u32x4=__attribute__((ext_vector_type(4)))unsigned;
typedef float f32x4_t __attribute__((ext_vector_type(4)));
constexpr int BATCH=16,NHEAD=8,SEQ=2048,D=64,DMI=1536,DMO=1024;
constexpr int NW=8,QBLK=32,QB=QBLK*NW,KVBLK=64,NQB=SEQ/QB;
constexpr int ATTN_UNIT_ROWS=QB;
__device__ __forceinline__ int crow(int r,int hi){return (r&3)+8*(r>>2)+4*hi;}
#define SBAR() __builtin_amdgcn_sched_barrier(0)
__device__ __forceinline__ void cmask(f32x16&p0,f32x16&p1,int jb,int qrel,int hi){
  const float NEG=-INFINITY; int kb=64*jb+4*hi;
  #pragma unroll
  for(int r=0;r<16;++r){int kv=kb+(r&3)+8*(r>>2); if(kv>qrel)p0[r]=NEG; if(kv+32>qrel)p1[r]=NEG;}
}

constexpr int NSLOT=3, SLOTB=8192;
constexpr int LDS_K=0, LDS_V=NSLOT*SLOTB, LDS_WS=2*NSLOT*SLOTB, LDS_OST=LDS_WS+NW*64*4, LDS_GB=LDS_OST+NW*4096, LDS_BYTES=LDS_GB+SEQ*4;
constexpr float C2=0.125f*1.4426950408889634f;
__device__ __forceinline__ void glds16(const void*gsrc,unsigned lds_dst){unsigned keep;
  asm volatile("s_mov_b32 %0, m0\n\ts_mov_b32 m0, %2\n\ts_nop 0\n\tglobal_load_lds_dwordx4 %1, off\n\ts_mov_b32 m0, %0":"=&s"(keep):"v"(gsrc),"s"(lds_dst):"memory");}
__device__ __forceinline__ float max3f(float a,float b,float c){float r;asm("v_max3_f32 %0, %1, %2, %3":"=v"(r):"v"(a),"v"(b),"v"(c));return r;}
__device__ __forceinline__ float max2f(float a,float b){float r;asm("v_max_f32_e32 %0, %1, %2":"=v"(r):"v"(a),"v"(b));return r;}
__device__ __forceinline__ float fadd_s(float a,float b){float r;asm("v_add_f32_e32 %0, %1, %2":"=v"(r):"v"(a),"v"(b));return r;}
__device__ __forceinline__ float fsub_s(float a,float b){float r;asm("v_sub_f32_e32 %0, %1, %2":"=v"(r):"v"(a),"v"(b));return r;}
typedef float f32x2_t __attribute__((ext_vector_type(2))); typedef __bf16 bf16x2_t __attribute__((ext_vector_type(2)));
__device__ __forceinline__ unsigned cvtpk_s(float lo,float hi){f32x2_t v={lo,hi};bf16x2_t b=__builtin_convertvector(v,bf16x2_t);return __builtin_bit_cast(unsigned,b);}
#define WAIT_BAR(N) asm volatile("s_waitcnt vmcnt(" #N ") lgkmcnt(0)\n\ts_barrier":::"memory")

__device__ __forceinline__ void qkt(f32x16&p0,f32x16&p1,const char*Kslot,const bf16x8*qr,const f32x16&c0,const f32x16&c1,int r32,int hi){
  const char*kb=Kslot+hi*1024+r32*16;
  #pragma unroll
  for(int d0=0;d0<4;++d0){
    const bf16x8 b0=*reinterpret_cast<const bf16x8*>(kb+d0*2048);
    const bf16x8 b1=*reinterpret_cast<const bf16x8*>(kb+d0*2048+512);
    if(d0==0){p0=__builtin_amdgcn_mfma_f32_32x32x16_bf16(b0,qr[0],c0,0,0,0);p1=__builtin_amdgcn_mfma_f32_32x32x16_bf16(b1,qr[0],c1,0,0,0);}
    else{p0=__builtin_amdgcn_mfma_f32_32x32x16_bf16(b0,qr[d0],p0,0,0,0);p1=__builtin_amdgcn_mfma_f32_32x32x16_bf16(b1,qr[d0],p1,0,0,0);}}
}
typedef __attribute__((address_space(3))) const char* lds_cptr;
typedef short v4i16_t __attribute__((ext_vector_type(4)));
__device__ __forceinline__ void kload8(bf16x8*kf,lds_cptr kp){
  kf[0]=*(const __attribute__((address_space(3))) bf16x8*)(kp);      kf[1]=*(const __attribute__((address_space(3))) bf16x8*)(kp+512);
  kf[2]=*(const __attribute__((address_space(3))) bf16x8*)(kp+2048); kf[3]=*(const __attribute__((address_space(3))) bf16x8*)(kp+2560);
  kf[4]=*(const __attribute__((address_space(3))) bf16x8*)(kp+4096); kf[5]=*(const __attribute__((address_space(3))) bf16x8*)(kp+4608);
  kf[6]=*(const __attribute__((address_space(3))) bf16x8*)(kp+6144); kf[7]=*(const __attribute__((address_space(3))) bf16x8*)(kp+6656);
}
__device__ __forceinline__ void kload2(bf16x8*kf,lds_cptr kp,int j){ kf[2*j]=*(const __attribute__((address_space(3))) bf16x8*)(kp+j*2048); kf[2*j+1]=*(const __attribute__((address_space(3))) bf16x8*)(kp+j*2048+512); }
__device__ __forceinline__ s16x4 vtr(lds_cptr p){ return __builtin_bit_cast(s16x4,__builtin_amdgcn_ds_read_tr16_b64_v4i16((__attribute__((address_space(3))) v4i16_t*)p)); }
__device__ __forceinline__ float rowmax(const f32x16&p0,const f32x16&p1){
  float a=max3f(p0[0],p0[1],p1[0]),b=max3f(p0[2],p0[3],p1[1]);a=max3f(a,p1[2],p1[3]);
  #pragma unroll
  for(int r=4;r<16;r+=4){a=max3f(a,p0[r],p0[r+1]);b=max3f(b,p0[r+2],p0[r+3]);a=max3f(a,p1[r],p1[r+1]);b=max3f(b,p1[r+2],p1[r+3]);}
  const float m=max2f(a,b);
  auto rr=__builtin_amdgcn_permlane32_swap(__float_as_uint(m),__float_as_uint(m),false,false);
  return max2f(__uint_as_float(rr[0]),__uint_as_float(rr[1]));
}
__device__ __forceinline__ void pv(f32x16*o,int vb,bf16x8 pa0,bf16x8 pa1,bf16x8 pa2,bf16x8 pa3){
  #pragma unroll
  for(int d0=0;d0<2;++d0){s16x4 lo[4],hi[4];
    #pragma unroll
    for(int ks=0;ks<4;++ks){
      asm volatile("ds_read_b64_tr_b16 %0,%1 offset:%c2":"=&v"(lo[ks]):"v"(vb),"i"(d0*4096+ks*1024):"memory");
      asm volatile("ds_read_b64_tr_b16 %0,%1 offset:%c2":"=&v"(hi[ks]):"v"(vb),"i"(d0*4096+ks*1024+512):"memory");}
    asm volatile("s_waitcnt lgkmcnt(0)":::"memory");SBAR();
    #define PK(k) (bf16x8){lo[k][0],lo[k][1],lo[k][2],lo[k][3],hi[k][0],hi[k][1],hi[k][2],hi[k][3]}
    o[d0]=__builtin_amdgcn_mfma_f32_32x32x16_bf16(pa0,PK(0),o[d0],0,0,0);
    o[d0]=__builtin_amdgcn_mfma_f32_32x32x16_bf16(pa1,PK(1),o[d0],0,0,0);
    o[d0]=__builtin_amdgcn_mfma_f32_32x32x16_bf16(pa2,PK(2),o[d0],0,0,0);
    o[d0]=__builtin_amdgcn_mfma_f32_32x32x16_bf16(pa3,PK(3),o[d0],0,0,0);
    #undef PK
  }
}

#ifndef ATTN_STORE16
#define ATTN_STORE16(p,v) (*(u32x4*)(p)=(v))
#endif
template<int THRL> __device__ __forceinline__ void attn_unit(int b,int h,int qb,const bf16*Q,const bf16*__restrict__ K,const bf16*__restrict__ V,bf16*O,const float*Gf,float*SSA,char*shm){
  const int tid=threadIdx.x,lane=tid&63,r32=lane&31,hi=lane>>5; const int wid=__builtin_amdgcn_readfirstlane(tid>>6);
  const long rowbase=(long)b*SEQ; const int q0=qb*QB;
  const bf16*Qw=Q+(rowbase+q0+wid*QBLK)*DMI+h*D;
  const bf16*Kh=K+rowbase*DMI+h*D,*Vh=V+rowbase*DMI+h*D;
  typedef __attribute__((address_space(3))) char* lds_wptr; const lds_wptr shm3w=(lds_wptr)shm;
  const unsigned lds0=(unsigned)(uintptr_t)shm;
  float*wsf=(float*)(shm+LDS_WS)+wid*64;
  const bf16*ksrc=Kh+(long)lane*DMI+wid*8;
  const bf16*vsrc=Vh+(long)(16*(wid&3)+(lane>>2))*DMI+(wid>>2)*32+(lane&3)*8;
  const unsigned kdst=lds0+LDS_K+wid*1024, vdst=lds0+LDS_V+wid*1024;
  #define DMA_K(t,slot) glds16(ksrc+(long)(t)*KVBLK*DMI,(unsigned)__builtin_amdgcn_readfirstlane(kdst+(slot)))
  #define DMA_V(t,slot) glds16(vsrc+(long)(t)*KVBLK*DMI,(unsigned)__builtin_amdgcn_readfirstlane(vdst+(slot)))
  const int vb0=(int)(lds0+LDS_V)+((lane>>4)&1)*32+(lane&3)*8+(4*hi+((lane&15)>>2))*64;
  const char*Kbase=shm+LDS_K; bf16x8 kf[8];
  const lds_cptr shm3=(lds_cptr)shm; const lds_cptr kp0=shm3+LDS_K+hi*1024+r32*16; const lds_cptr vp0=shm3+LDS_V+((lane>>4)&1)*32+(lane&3)*8+(4*hi+((lane&15)>>2))*64;
  const int NT=(q0+QB)/KVBLK;
  DMA_K(0,0);DMA_V(0,0);DMA_K(1,SLOTB);
  { const float*Gbh=Gf+((long)b*NHEAD+h)*SEQ; const float g0=Gbh[q0]; __attribute__((address_space(3))) float*gbw=(__attribute__((address_space(3))) float*)(shm3w+LDS_GB);
    for(int s_=tid;s_<q0+QB;s_+=NW*64)gbw[s_]=g0-Gbh[s_]; }
  bf16x8 qr[4];
  #pragma unroll
  for(int d0=0;d0<4;++d0)qr[d0]=*reinterpret_cast<const bf16x8*>(&Qw[(long)r32*DMI+d0*16+hi*8]);
  float mhat=0.f,l_reg=0.f;f32x16 o[2];o[0]=f32x16{};o[1]=f32x16{};float nm=0.f; const f32x16 zero16=f32x16{};
  const __attribute__((address_space(3))) char*gbp0=(const __attribute__((address_space(3))) char*)(shm3w+LDS_GB)+hi*16;
  #define CBIAS(CA,CB,t) do{ const __attribute__((address_space(3))) char*gp_=gbp0+(t)*256; _Pragma("unroll") for(int g_=0;g_<4;++g_){ \
      const f32x4_t a_=*(const __attribute__((address_space(3))) f32x4_t*)(gp_+g_*32), b_=*(const __attribute__((address_space(3))) f32x4_t*)(gp_+128+g_*32); \
      _Pragma("unroll") for(int j_=0;j_<4;++j_){ CA[4*g_+j_]+=a_[j_]+nm; CB[4*g_+j_]+=b_[j_]+nm; } } }while(0)
  const int qrel=wid*QBLK+r32;
  #define CMASK(P0,P1,t) do{int jb_=(t)-(NT-4); if(jb_>=0){int hm_=hi,qm_=qrel; asm volatile("":"+v"(hm_),"+v"(qm_)); cmask(P0,P1,jb_,qm_,hm_);}}while(0)
  bool resc=false;
  #define START(P0,P1) do{ const float rm=rowmax(P0,P1); resc=false; \
    { const float dl=rm; mhat=fadd_s(mhat,dl); \
      _Pragma("unroll") for(int r=0;r<16;++r){P0[r]=fsub_s(P0[r],dl);P1[r]=fsub_s(P1[r],dl);} \
      nm=-mhat; } \
    _Pragma("unroll") for(int r=0;r<16;++r)P0[r]=__builtin_amdgcn_exp2f(P0[r]); }while(0)
  #define RESC() do{ if(resc){ asm volatile("s_waitcnt lgkmcnt(0)":::"memory"); \
      _Pragma("unroll") for(int d_=0;d_<2;++d_) _Pragma("unroll") for(int r=0;r<16;++r)o[d_][r]*=wsf[crow(r,hi)]; } }while(0)
  f32x16 pA0,pA1,pB0,pB1;
  int sl_prev=0,sl_cur=0,sl_next=SLOTB;
  #define ROT() do{sl_prev=sl_cur;sl_cur=sl_next;sl_next=(sl_next==(NSLOT-1)*SLOTB)?0:sl_next+SLOTB;}while(0)
  DMA_K(2,2*SLOTB);
  WAIT_BAR(3);
  qkt(pA0,pA1,Kbase,qr,zero16,zero16,r32,hi);asm volatile("s_nop 15\n\ts_nop 7":"+v"(pA0),"+v"(pA1));CBIAS(pA0,pA1,0);CMASK(pA0,pA1,0);
  START(pA0,pA1);
  _Pragma("unroll") for(int r=0;r<16;++r)pA1[r]=__builtin_amdgcn_exp2f(pA1[r]);
  WAIT_BAR(0);
  DMA_K(3,0);DMA_V(1,SLOTB);
  ROT();
  kload8(kf,kp0+sl_cur);
  WAIT_BAR(2);
  s16x4 vlo[8],vhi[8]; u32x4 pw0,pw1,pw2,pw3;
  #define PKW(P,B) cvtpk_s(P[B],P[B+1])
  #define PAF(k) __builtin_bit_cast(bf16x8,pw##k)
  #define VFR(i) (bf16x8){vlo[i][0],vlo[i][1],vlo[i][2],vlo[i][3],vhi[i][0],vhi[i][1],vhi[i][2],vhi[i][3]}
  #define PIN(x) asm volatile("":"+v"(x))
  #define MX3(a,b,c) __builtin_fmaxf(__builtin_fmaxf((a),(b)),(c))
  #define GAPA(MF,A0,A1,A2,A3,W0,W1,PW) do{ MF; sacc+=A0; sacc+=A1; sacc+=A2; sacc+=A3; PIN(sacc); W0; W1; PIN(PW); SBAR(); }while(0)
  #define EX(v) __builtin_amdgcn_exp2f(v)
  #define GAPB(MF,X,B) do{ MF; X[B]=EX(X[B]); X[B+1]=EX(X[B+1]); X[B+2]=EX(X[B+2]); X[B+3]=EX(X[B+3]); PIN(X); SBAR(); }while(0)
  #define VRD(i) do{ vlo[i]=vtr(vp_+(((i)>>2)*4096+((i)&3)*1024)); vhi[i]=vtr(vp_+(((i)>>2)*4096+((i)&3)*1024+512)); }while(0)
  #define KRD(G,j) do{ if(G){ kload2(kf,kp0+sl_next,j); SBAR(); } }while(0)
  #define STEP(C0,C1,P0,P1,t,GK,GV,GL) do{ SBAR(); \
    const lds_cptr vp_=vp0+sl_prev; \
    VRD(0); SBAR(); float sacc=(P0[0]+P0[1]); \
    GAPA(C0=__builtin_amdgcn_mfma_f32_32x32x16_bf16(kf[0],qr[0],zero16,0,0,0), P0[2],P0[3],P0[4],P0[5],     pw0[0]=PKW(P0,0), pw0[1]=PKW(P0,2), pw0); \
    VRD(4); SBAR(); GAPA(C1=__builtin_amdgcn_mfma_f32_32x32x16_bf16(kf[1],qr[0],zero16,0,0,0), P0[6],P0[7],P0[8],P0[9],     pw0[2]=PKW(P0,4), pw0[3]=PKW(P0,6), pw0); \
    VRD(1); SBAR(); GAPA(C0=__builtin_amdgcn_mfma_f32_32x32x16_bf16(kf[2],qr[1],C0,0,0,0),   P0[10],P0[11],P0[12],P0[13], pw1[0]=PKW(P0,8), pw1[1]=PKW(P0,10), pw1); \
    VRD(5); SBAR(); GAPA(C1=__builtin_amdgcn_mfma_f32_32x32x16_bf16(kf[3],qr[1],C1,0,0,0),   P0[14],P0[15],P1[0],P1[1],   pw1[2]=PKW(P0,12),pw1[3]=PKW(P0,14), pw1); \
    VRD(2); SBAR(); GAPA(C0=__builtin_amdgcn_mfma_f32_32x32x16_bf16(kf[4],qr[2],C0,0,0,0),   P1[2],P1[3],P1[4],P1[5],     pw2[0]=PKW(P1,0), pw2[1]=PKW(P1,2), pw2); \
    VRD(6); SBAR(); GAPA(C1=__builtin_amdgcn_mfma_f32_32x32x16_bf16(kf[5],qr[2],C1,0,0,0),   P1[6],P1[7],P1[8],P1[9],     pw2[2]=PKW(P1,4), pw2[3]=PKW(P1,6), pw2); \
    VRD(3); SBAR(); GAPA(C0=__builtin_amdgcn_mfma_f32_32x32x16_bf16(kf[6],qr[3],C0,0,0,0),   P1[10],P1[11],P1[12],P1[13], pw3[0]=PKW(P1,8), pw3[1]=PKW(P1,10), pw3); \
    VRD(7); SBAR(); GAPA(C1=__builtin_amdgcn_mfma_f32_32x32x16_bf16(kf[7],qr[3],C1,0,0,0),   P1[14],P1[15],0.f,0.f,       pw3[2]=PKW(P1,12),pw3[3]=PKW(P1,14), pw3); \
    l_reg+=sacc; \
    if(GK){DMA_K((t)+3,sl_cur);} if(GV){DMA_V((t)+1,sl_next);} \
    CBIAS(C0,C1,t); \
    CMASK(C0,C1,t); \
    { float a=MX3(C0[0],C0[1],C1[0]),b=MX3(C0[2],C0[3],C1[1]); a=MX3(a,C1[2],C1[3]); \
      _Pragma("unroll") for(int r=4;r<16;r+=4){a=MX3(a,C0[r],C0[r+1]);b=MX3(b,C0[r+2],C0[r+3]);a=MX3(a,C1[r],C1[r+1]);b=MX3(b,C1[r+2],C1[r+3]);} \
      float rm=__builtin_fmaxf(a,b); { auto rr=__builtin_amdgcn_permlane32_swap(__float_as_uint(rm),__float_as_uint(rm),false,false); rm=__builtin_fmaxf(__uint_as_float(rr[0]),__uint_as_float(rr[1])); } \
      resc=false; \
      if(__builtin_expect(__any(rm>(float)THRL),0)){ const float dl=__builtin_fmaxf(rm,0.f); mhat+=dl; \
        _Pragma("unroll") for(int r=0;r<16;++r){C0[r]-=dl;C1[r]-=dl;} \
        nm=-mhat; \
        const float f=__builtin_amdgcn_exp2f(-dl); l_reg*=f; if(hi==0)wsf[r32]=f; resc=true; } } \
    SBAR(); \
    GAPB(o[0]=__builtin_amdgcn_mfma_f32_32x32x16_bf16(PAF(0),VFR(0),o[0],0,0,0), C0,0); \
    GAPB(o[1]=__builtin_amdgcn_mfma_f32_32x32x16_bf16(PAF(0),VFR(4),o[1],0,0,0), C0,4); \
    KRD(GL,0); GAPB(o[0]=__builtin_amdgcn_mfma_f32_32x32x16_bf16(PAF(1),VFR(1),o[0],0,0,0), C0,8); \
    KRD(GL,1); GAPB(o[1]=__builtin_amdgcn_mfma_f32_32x32x16_bf16(PAF(1),VFR(5),o[1],0,0,0), C0,12); \
    KRD(GL,2); GAPB(o[0]=__builtin_amdgcn_mfma_f32_32x32x16_bf16(PAF(2),VFR(2),o[0],0,0,0), C1,0); \
    KRD(GL,3); GAPB(o[1]=__builtin_amdgcn_mfma_f32_32x32x16_bf16(PAF(2),VFR(6),o[1],0,0,0), C1,4); \
    GAPB(o[0]=__builtin_amdgcn_mfma_f32_32x32x16_bf16(PAF(3),VFR(3),o[0],0,0,0), C1,8); \
    GAPB(o[1]=__builtin_amdgcn_mfma_f32_32x32x16_bf16(PAF(3),VFR(7),o[1],0,0,0), C1,12); \
    }while(0)
  int t=1;
  #undef CMASK
  #define CMASK(P0,P1,t) do{}while(0)
  for(;t+5<NT;t+=2){
    STEP(pB0,pB1,pA0,pA1,t,true,true,true);     WAIT_BAR(2); RESC(); ROT();
    STEP(pA0,pA1,pB0,pB1,t+1,true,true,true);   WAIT_BAR(2); RESC(); ROT();
  }
  #undef CMASK
  #define CMASK(P0,P1,t) do{int jb_=(t)-(NT-4); if(jb_>=0){int hm_=hi,qm_=qrel; asm volatile("":"+v"(hm_),"+v"(qm_)); cmask(P0,P1,jb_,qm_,hm_);}}while(0)
  #define ENDW(tt) do{ if((tt)+3<NT){WAIT_BAR(2);} else if((tt)+2<NT){WAIT_BAR(1);} else {WAIT_BAR(0);} }while(0)
  for(;t+1<NT;t+=2){
    STEP(pB0,pB1,pA0,pA1,t,(t+3<NT),(t+1<NT),(t+1<NT));       ENDW(t);   RESC(); ROT();
    STEP(pA0,pA1,pB0,pB1,t+1,(t+4<NT),(t+2<NT),(t+2<NT));     ENDW(t+1); RESC(); ROT();
  }
  STEP(pB0,pB1,pA0,pA1,NT-1,false,false,false); RESC();
  { float sacc=pB0[0]+pB0[1]; _Pragma("unroll") for(int r=2;r<16;++r)sacc+=pB0[r]; _Pragma("unroll") for(int r=0;r<16;++r)sacc+=pB1[r]; l_reg+=sacc;
    pw0=(u32x4){PKW(pB0,0),PKW(pB0,2),PKW(pB0,4),PKW(pB0,6)};pw1=(u32x4){PKW(pB0,8),PKW(pB0,10),PKW(pB0,12),PKW(pB0,14)};pw2=(u32x4){PKW(pB1,0),PKW(pB1,2),PKW(pB1,4),PKW(pB1,6)};pw3=(u32x4){PKW(pB1,8),PKW(pB1,10),PKW(pB1,12),PKW(pB1,14)};
    SBAR(); pv(o,vb0+sl_cur,PAF(0),PAF(1),PAF(2),PAF(3)); }
  #undef PKW
  #undef PAF
  #undef VFR
  #undef PIN
  #undef MX3
  #undef GAPA
  #undef GAPB
  #undef EX
  #undef VRD
  #undef KRD
  #undef STEP
  #undef ENDW
  {auto rr=__builtin_amdgcn_permlane32_swap(__float_as_uint(l_reg),__float_as_uint(l_reg),false,false);l_reg=__uint_as_float(rr[0])+__uint_as_float(rr[1]);}
  if(hi==0)wsf[32+r32]=l_reg;asm volatile("s_waitcnt lgkmcnt(0)":::"memory");
  float rli[16];
  #pragma unroll
  for(int r=0;r<16;++r)rli[r]=__builtin_amdgcn_rcpf(wsf[32+crow(r,hi)]);
  bf16*Ow=O+(rowbase+q0+wid*QBLK)*DMO+h*D;
  { bf16*stg=(bf16*)(shm+LDS_OST)+wid*2048;
    #pragma unroll
    for(int r=0;r<16;++r){const int orow=crow(r,hi);
      #pragma unroll
      for(int d0=0;d0<2;++d0)stg[orow*64+d0*32+r32]=__float2bfloat16(o[d0][r]*rli[r]);}
    asm volatile("s_waitcnt lgkmcnt(0)":::"memory");
    int le_=lane; asm volatile("":"+v"(le_));
    #pragma unroll
    for(int i=0;i<4;++i){const int row=i*8+(le_>>3),ch=le_&7; const u32x4 v=*(const u32x4*)(stg+row*64+ch*8); ATTN_STORE16(Ow+(unsigned)(row*DMO+ch*8),v);
      float q_=0.f; _Pragma("unroll") for(int e_=0;e_<4;++e_){const float lo_=__uint_as_float(v[e_]<<16),hi_=__uint_as_float(v[e_]&0xffff0000u); q_+=lo_*lo_+hi_*hi_;}
      q_+=__shfl_xor(q_,1);q_+=__shfl_xor(q_,2);q_+=__shfl_xor(q_,4); if(ch==0)SSA[(rowbase+q0+wid*QBLK+row)*NHEAD+h]=q_; } }
  asm volatile("s_waitcnt lgkmcnt(0)\n\ts_barrier":::"memory");
  #undef DMA_K
  #undef DMA_V
  #undef CMASK
  #undef START
  #undef RESC
  #undef ROT
  #undef CBIAS
}
constexpr int ATTN_LDS_BYTES=LDS_BYTES;
struct AttnTensors { const bf16* Q; const bf16* K; const bf16* V; bf16* O; const float* G; float* SSA; };
struct AttnUnit { int bh; int qb; };
struct StaticOrder {
  int vcu,G;
  __device__ __forceinline__ explicit StaticOrder(int grid,int block):vcu((grid%8==0)?(block%8)*(grid/8)+block/8:block),G(grid){}
  __device__ __forceinline__ bool next(int i,AttnUnit&u)const{
    if(G==256){ if(i>=4)return false; const int hf=vcu&1; u.bh=vcu>>1; u.qb=(i==0)?7-hf:(i==1)?hf:(i==2)?5-hf:2+hf; return true; }
    const int L=i*G+vcu; if(L>=BATCH*NHEAD*NQB)return false; u.bh=L/NQB; u.qb=NQB-1-(L%NQB); return true; }
  __device__ __forceinline__ void a_ready(const AttnUnit&)const{}
  __device__ __forceinline__ void done(const AttnUnit&)const{}
};
template<class Sched,int THRL=40> __device__ __forceinline__ void attn_phase(char*lds,const AttnTensors&T,const Sched&S){
  AttnUnit u;
  for(int i=0;S.next(i,u);++i){ S.a_ready(u); attn_unit<THRL>(u.bh/NHEAD,u.bh%NHEAD,u.qb,T.Q,T.K,T.V,T.O,T.G,T.SSA,lds); S.done(u); }
}
#undef SBAR
#undef WAIT_BAR
}
constexpr size_t MiB = 1u << 20;
constexpr size_t WS_CTL = 0, CTL_ZERO_BYTES = 1 * MiB;
constexpr size_t WS_WI = 1 * MiB;
constexpr size_t WS_WO = 6 * MiB;
constexpr size_t WS_WQ = 8 * MiB;
constexpr size_t WS_WG = 12 * MiB;
constexpr size_t WS_WP = 14 * MiB;
constexpr size_t WS_SK = 14 * MiB + 512 * 1024;
constexpr size_t WS_RS1 = 15 * MiB;
constexpr size_t WS_SS2 = 15 * MiB + 512 * 1024;
constexpr size_t WS_LF = 16 * MiB;
constexpr size_t WS_G = 17 * MiB;
constexpr size_t WS_SSA = 18 * MiB;
constexpr size_t WS_SS1P = 19 * MiB;
constexpr size_t WS_EU = 22 * MiB;
constexpr size_t WS_EV = 54 * MiB;
constexpr size_t WS_PB = 86 * MiB;
constexpr size_t WS_XB = 102 * MiB;
constexpr size_t WS_QKV = 166 * MiB;
constexpr size_t WS_QP = 102 * MiB;
constexpr size_t WS_PLE = 102 * MiB;
constexpr size_t WS_U = 262 * MiB;
constexpr size_t WS_Y = 294 * MiB;
constexpr size_t WS_H2B = 294 * MiB;
constexpr size_t WS_H1B = 358 * MiB;
constexpr size_t WS_SEL = 422 * MiB;
constexpr size_t WS_GATE = 430 * MiB;
constexpr size_t WS_WACT = 446 * MiB;
constexpr size_t WS_END = 462 * MiB;
constexpr int CW_CODE = 2;
constexpr int CW_BAR = 4096;

constexpr int RING_OFF = 0, RING_BYTES = 131072;
constexpr int LDSCTL_OFF = RING_BYTES, MISC_OFF = LDSCTL_OFF + 320;
constexpr int SCAN_OFF = LDSCTL_OFF + 1024;
constexpr int RSA_OFF = LDSCTL_OFF + 2048;
constexpr int LDS_BYTES = 147456;

#define GAS __attribute__((address_space(1)))
#define LAS __attribute__((address_space(3)))
typedef unsigned short bf16;
typedef unsigned v4u __attribute__((ext_vector_type(4)));
typedef float f32x4 __attribute__((ext_vector_type(4)));
typedef short bf16x8 __attribute__((ext_vector_type(8)));
typedef GAS unsigned gu32;
typedef GAS unsigned long long gu64;
#define RLX_AGENT __ATOMIC_RELAXED, __HIP_MEMORY_SCOPE_AGENT
#define LDS_WAIT() asm volatile("s_waitcnt lgkmcnt(0)" ::: "memory")
#define VM_WAIT() asm volatile("s_waitcnt vmcnt(0)" ::: "memory")
__device__ __forceinline__ unsigned long long rt() { return __builtin_amdgcn_s_memrealtime(); }
__device__ __forceinline__ unsigned f2bf(float f) { unsigned u = __builtin_bit_cast(unsigned, f); return (u + 0x7fffu + ((u >> 16) & 1u)) >> 16; }
__device__ __forceinline__ unsigned pk2(float lo, float hi) { return f2bf(lo) | (f2bf(hi) << 16); }

#define XB_TMO      128
#define XB_XCNT(j)  (256  + 64 * (j))
#define XB_XSUB(j)  (1280 + 64 * (j))
#define XB_XGEN(j)  (2304 + 64 * (j))
#define XB_TOP      3328
#define XB_TOPGEN   3392
#define XCD_BAR_WORDS 3456
#define XB_SPIN_CAP (1u << 18)

__device__ __forceinline__ unsigned xb_ld(unsigned* p)              { return __hip_atomic_load(p, __ATOMIC_RELAXED, __HIP_MEMORY_SCOPE_AGENT); }
__device__ __forceinline__ unsigned xb_add(unsigned* p, unsigned v) { return __hip_atomic_fetch_add(p, v, __ATOMIC_RELAXED, __HIP_MEMORY_SCOPE_AGENT); }
__device__ __forceinline__ unsigned xb_xcc_id() { return (unsigned)__builtin_amdgcn_s_getreg((3 << 11) | 20) & 0xFu; }
#define XB_SPIN(cond, bar) do { unsigned _sp = 0; while (cond) { __builtin_amdgcn_s_sleep(1); \
    if ((++_sp & 255u) == 0u) { if (xb_ld(&(bar)[XB_TMO])) break; if (_sp > XB_SPIN_CAP) { atomicAdd(&(bar)[XB_TMO], 1u); break; } } } } while (0)

struct XcdBarrier {
    unsigned* bar; unsigned x;
    volatile LAS unsigned* st;
};

__device__ __forceinline__ XcdBarrier xcd_barrier_post(unsigned* bar, volatile LAS unsigned* st) {
    XcdBarrier b; b.bar = bar; b.x = xb_xcc_id(); b.st = st;
    if (threadIdx.x == 0) (void)xb_add(&bar[XB_XCNT(b.x)], 1u);
    return b;
}
__device__ __forceinline__ void xcd_barrier_complete(unsigned* bar, unsigned x, unsigned& nloc, unsigned& nx) {
    const unsigned G = gridDim.x * gridDim.y * gridDim.z;
    unsigned sum, cnt, mine, sp = 0u;
    for (;;) {
        sum = 0u; cnt = 0u; mine = 0u;
#pragma unroll
        for (unsigned j = 0; j < 16; ++j) { const unsigned c = xb_ld(&bar[XB_XCNT(j)]); sum += c; cnt += (c > 0u) ? 1u : 0u; mine = (j == x) ? c : mine; }
        if (sum == G) break;
        __builtin_amdgcn_s_sleep(1);
        if ((++sp & 255u) == 0u) { if (xb_ld(&bar[XB_TMO])) break; if (sp > XB_SPIN_CAP) { atomicAdd(&bar[XB_TMO], 1u); break; } }
    }
    nloc = mine > 0u ? mine : 1u; nx = cnt > 0u ? cnt : 1u;
}

__device__ __forceinline__ void xcd_barrier(const XcdBarrier& b) {
    asm volatile("s_waitcnt vmcnt(0)" ::: "memory");
    __syncthreads();
    if (threadIdx.x == 0) {
        unsigned* bar = b.bar;
        __builtin_amdgcn_s_waitcnt(0);
        unsigned nloc = b.st[0], nx = b.st[1];
        if (nloc == 0u) { xcd_barrier_complete(bar, b.x, nloc, nx); b.st[0] = nloc; b.st[1] = nx; }
        const unsigned old = xb_add(&bar[XB_XSUB(b.x)], 1u);
        const unsigned gen = old / nloc;
        if (old + 1u == (gen + 1u) * nloc) {
            __builtin_amdgcn_fence(__ATOMIC_RELEASE, "agent");
            asm volatile("s_waitcnt vmcnt(0)" ::: "memory");
            const unsigned og = xb_add(&bar[XB_TOP], 1u);
            const unsigned tg = og / nx;
            if (og + 1u == (tg + 1u) * nx) xb_add(&bar[XB_TOPGEN], 1u);
            else XB_SPIN(xb_ld(&bar[XB_TOPGEN]) == tg, bar);
            __builtin_amdgcn_fence(__ATOMIC_ACQUIRE, "agent");
            xb_add(&bar[XB_XGEN(b.x)], 1u);
            asm volatile("s_waitcnt vmcnt(0)" ::: "memory");
        } else {
            XB_SPIN(xb_ld(&bar[XB_XGEN(b.x)]) == gen, bar);
            __builtin_amdgcn_fence(__ATOMIC_ACQUIRE, "agent");
            asm volatile("s_waitcnt vmcnt(0)" ::: "memory");
        }
    }
    __syncthreads();
}

constexpr int NWAVES = 8;
struct Frame {
    LAS unsigned char* lds;
    volatile LAS unsigned* MISC;
    gu32* ctl;
    int tid, lane, wave;
    int vcu, G;
    unsigned char* ws;
    const float* in[23];
    float* out;
};
enum { I_X = 0, I_P, I_LN_MIX, I_W_IN, I_B_FGATE, I_Q_NORM, I_K_NORM, I_CONV_W, I_CONV_B, I_CONV_LN_G, I_CONV_LN_B, I_ATTN_OUT_NORM, I_CONV_OUT_NORM, I_W_OUT,
       I_LN_FFN, I_W_PEER_Q, I_SUB_KEYS1, I_SUB_KEYS2, I_EXPERT_U, I_EXPERT_V, I_LN_PL, I_W_PL_GATE, I_W_PL_PROJ };

__device__ __forceinline__ float wave_sum(float v) {
#pragma unroll
    for (int o = 1; o < 64; o <<= 1) v += __shfl_xor(v, o);
    return v;
}
__device__ __forceinline__ float fast_sigmoid(float v) { return __builtin_amdgcn_rcpf(1.0f + __builtin_amdgcn_exp2f(-v * LOG2E)); }

__device__ __forceinline__ void p0_transpose_item(const float* W, int Nsrc, int K, int col0, const float* gain, bf16* WT, int n0, int k0, LAS float* scr, int lane) {
#pragma unroll 8
    for (int i = 0; i < 32; ++i) { const int kk = 2 * i + (lane >> 5); const float g = gain ? gain[kk] : 1.0f; scr[kk * 33 + (lane & 31)] = W[(size_t)(k0 + kk) * Nsrc + col0 + (lane & 31)] * g; }
    LDS_WAIT(); asm volatile("" ::: "memory");
    const int c = lane & 7;
#pragma unroll
    for (int j = 0; j < 4; ++j) { const int n = (lane >> 3) + 8 * j; const LAS float* s = scr + (8 * c) * 33 + n;
        v4u o; o.x = pk2(s[0 * 33], s[1 * 33]); o.y = pk2(s[2 * 33], s[3 * 33]); o.z = pk2(s[4 * 33], s[5 * 33]); o.w = pk2(s[6 * 33], s[7 * 33]);
        *(GAS v4u*)(WT + (size_t)(n0 + n) * K + k0 + 8 * c) = o; }
    LDS_WAIT(); asm volatile("" ::: "memory");
}
__device__ __forceinline__ int inproj_src_col(int nb) {
    const int p0 = 32 * nb, pn = p0 >> 8, cp = p0 & 255;
    if (pn < 6) { const int bj = cp >> 7, wc = (cp >> 5) & 3; return 256 * pn + 64 * wc + 32 * bj; }
    const int pg = pn - 6; return cp < 128 ? COL_A + 128 * pg + cp : COL_G + 128 * pg + (cp - 128);
}
__device__ __forceinline__ v4u cvt8(const f32x4 a, const f32x4 b) { v4u o; o.x = pk2(a.x, a.y); o.y = pk2(a.z, a.w); o.z = pk2(b.x, b.y); o.w = pk2(b.z, b.w); return o; }

__device__ __forceinline__ void p0_prologue(Frame& F) {
    LAS float* scr = (LAS float*)(F.lds + RING_OFF + F.wave * 16384);
    const int gw = F.vcu * NWAVES + F.wave, NGW = F.G * NWAVES;
    bf16* WI = (bf16*)(F.ws + WS_WI); bf16* WO = (bf16*)(F.ws + WS_WO); bf16* WQ = (bf16*)(F.ws + WS_WQ); bf16* WG = (bf16*)(F.ws + WS_WG); bf16* WP = (bf16*)(F.ws + WS_WP);
    constexpr int I_IN = 16 * 80, I_OUT = 16 * 32, I_PQ = 16 * 64, I_GT = 16 * 32, I_PJ = 4 * 32, NITEMS = I_IN + I_OUT + I_PQ + I_GT + I_PJ;
    for (int it = gw; it < NITEMS; it += NGW) {
        int r = it;
        if (r < I_IN) { const int kb = r / 80, nb = r % 80; p0_transpose_item(F.in[I_W_IN], NIN, DMODEL, inproj_src_col(nb), F.in[I_LN_MIX] + 64 * kb, WI, 32 * nb, 64 * kb, scr, F.lane); continue; } r -= I_IN;
        if (r < I_OUT) { const int kb = r / 32, nb = r % 32; const float* g = kb < 8 ? F.in[I_ATTN_OUT_NORM] + 64 * kb : F.in[I_CONV_OUT_NORM] + 64 * (kb - 8);
            p0_transpose_item(F.in[I_W_OUT], DMODEL, DMODEL, 32 * nb, g, WO, 32 * nb, 64 * kb, scr, F.lane); continue; } r -= I_OUT;
        if (r < I_PQ) { const int kb = r / 64, nb = r % 64; p0_transpose_item(F.in[I_W_PEER_Q], PH * PQ, DMODEL, 32 * nb, F.in[I_LN_FFN] + 64 * kb, WQ, 32 * nb, 64 * kb, scr, F.lane); continue; } r -= I_PQ;
        if (r < I_GT) { const int kb = r / 32, nb = r % 32; p0_transpose_item(F.in[I_W_PL_GATE], DMODEL, DMODEL, 32 * nb, F.in[I_LN_PL] + 64 * kb, WG, 32 * nb, 64 * kb, scr, F.lane); continue; } r -= I_GT;
        { const int kb = r / 32, nb = r % 32; p0_transpose_item(F.in[I_W_PL_PROJ], DMODEL, DPLE, 32 * nb, nullptr, WP, 32 * nb, 64 * kb, scr, F.lane); }
    }
    {
        float wf[4][4][8];
        const float* w_in = F.in[I_W_IN]; const float* lnm = F.in[I_LN_MIX];
#pragma unroll
        for (int j = 0; j < 4; ++j)
#pragma unroll
            for (int e = 0; e < 4; ++e) { const int k = 4 * F.lane + 256 * j + e; const float g = lnm[k];
                const f32x4 a = *(const f32x4*)(w_in + (size_t)k * NIN + COL_F), b = *(const f32x4*)(w_in + (size_t)k * NIN + COL_F + 4);
                wf[j][e][0] = a.x * g; wf[j][e][1] = a.y * g; wf[j][e][2] = a.z * g; wf[j][e][3] = a.w * g; wf[j][e][4] = b.x * g; wf[j][e][5] = b.y * g; wf[j][e][6] = b.z * g; wf[j][e][7] = b.w * g; }
        const float* x = F.in[I_X]; bf16* XB = (bf16*)(F.ws + WS_XB); float* RS1 = (float*)(F.ws + WS_RS1); float* LF = (float*)(F.ws + WS_LF);
        const float bfh = F.in[I_B_FGATE][F.lane & 7];
        for (int m = gw; m < T; m += NGW) {
            const GAS f32x4* xr = (const GAS f32x4*)(x + (size_t)m * DMODEL) + F.lane;
            f32x4 v[4]; float s = 0.f; float d[8];
#pragma unroll
            for (int h = 0; h < 8; ++h) d[h] = 0.f;
#pragma unroll
            for (int j = 0; j < 4; ++j) { v[j] = xr[64 * j]; s += (v[j].x * v[j].x + v[j].y * v[j].y) + (v[j].z * v[j].z + v[j].w * v[j].w);
#pragma unroll
                for (int h = 0; h < 8; ++h) d[h] += (v[j].x * wf[j][0][h] + v[j].y * wf[j][1][h]) + (v[j].z * wf[j][2][h] + v[j].w * wf[j][3][h]); }
            const float rs = 1.0f / sqrtf(wave_sum(s) * (1.0f / DMODEL) + EPS);
            float mine = 0.f;
#pragma unroll
            for (int h = 0; h < 8; ++h) { const float t = wave_sum(d[h]); mine = ((F.lane & 7) == h) ? t : mine; }
            GAS unsigned long long* o8 = (GAS unsigned long long*)(XB + (size_t)m * DMODEL) + F.lane;
#pragma unroll
            for (int j = 0; j < 4; ++j) o8[64 * j] = (unsigned long long)pk2(v[j].x, v[j].y) | ((unsigned long long)pk2(v[j].z, v[j].w) << 32);
            if (F.lane == 0) RS1[m] = rs;
            if (F.lane < 8) { const float z = mine * rs + bfh; const float ls = fminf(z, 0.f) - log1pf(expf(-fabsf(z))); LF[(size_t)m * 8 + F.lane] = ls * LOG2E; }
        }
    }
    {
        const size_t gt = (size_t)F.vcu * (NWAVES * 64) + F.tid, NGT = (size_t)F.G * NWAVES * 64;
        const float* p = F.in[I_P]; bf16* PB = (bf16*)(F.ws + WS_PB);
        for (size_t c = gt; c < (size_t)T * DPLE / 8; c += NGT) { const GAS f32x4* s = (const GAS f32x4*)(p + c * 8); *(GAS v4u*)(PB + c * 8) = cvt8(s[0], s[1]); }
        const float* eu = F.in[I_EXPERT_U]; const float* ev = F.in[I_EXPERT_V]; const float* lnf = F.in[I_LN_FFN];
        bf16* EU = (bf16*)(F.ws + WS_EU); bf16* EV = (bf16*)(F.ws + WS_EV);
        for (size_t c = gt; c < (size_t)NEXP * DMODEL / 8; c += NGT) {
            const int d0 = (int)((c * 8) & (DMODEL - 1));
            const GAS f32x4* s = (const GAS f32x4*)(eu + c * 8); const f32x4 g0 = *(const f32x4*)(lnf + d0), g1 = *(const f32x4*)(lnf + d0 + 4);
            *(GAS v4u*)(EU + c * 8) = cvt8(s[0] * g0, s[1] * g1);
            const GAS f32x4* s2 = (const GAS f32x4*)(ev + c * 8); *(GAS v4u*)(EV + c * 8) = cvt8(s2[0], s2[1]);
        }
        bf16* SK = (bf16*)(F.ws + WS_SK);
        for (size_t c = gt; c < (size_t)2 * NKEY * PHALF / 8; c += NGT) {
            const float* src = c < (size_t)NKEY * PHALF / 8 ? F.in[I_SUB_KEYS1] + c * 8 : F.in[I_SUB_KEYS2] + (c - NKEY * PHALF / 8) * 8;
            const GAS f32x4* s = (const GAS f32x4*)src; *(GAS v4u*)(SK + c * 8) = cvt8(s[0], s[1]);
        }
    }
}

__device__ __forceinline__ void p1_scan(Frame& F) {
    const float* LF = (const float*)(F.ws + WS_LF); float* Gc = (float*)(F.ws + WS_G);
    LAS float* wt = (LAS float*)(F.lds + SCAN_OFF);
    for (int bh = blockIdx.x; bh < BATCH * NH; bh += F.G) {
        const int b = bh >> 3, h = bh & 7;
        float v[4];
#pragma unroll
        for (int j = 0; j < 4; ++j) v[j] = LF[((size_t)b * SEQ + 4 * F.tid + j) * 8 + h];
        v[1] += v[0]; v[2] += v[1]; v[3] += v[2];
        float incl = v[3];
#pragma unroll
        for (int o = 1; o < 64; o <<= 1) { const float t = __shfl_up(incl, o); if (F.lane >= o) incl += t; }
        if (F.lane == 63) wt[F.wave] = incl;
        __syncthreads();
        float base = incl - v[3];
        for (int w = 0; w < F.wave; ++w) base += wt[w];
        f32x4 o; o.x = base + v[0]; o.y = base + v[1]; o.z = base + v[2]; o.w = base + v[3];
        *(GAS f32x4*)(Gc + (size_t)bh * SEQ + 4 * F.tid) = o;
        __syncthreads();
    }
}

constexpr int CONV_TOK = 64, CONV_UW = 0, CONV_CWL = (CONV_TOK + 30) * 1024, CONV_LDS = CONV_CWL + CW * 1024;
static_assert(CONV_LDS <= RING_BYTES, "conv LDS");
__device__ __forceinline__ void unpack8(const v4u w, float (&f)[8]) {
    f[0] = __uint_as_float(w.x << 16); f[1] = __uint_as_float(w.x & 0xffff0000u); f[2] = __uint_as_float(w.y << 16); f[3] = __uint_as_float(w.y & 0xffff0000u);
    f[4] = __uint_as_float(w.z << 16); f[5] = __uint_as_float(w.z & 0xffff0000u); f[6] = __uint_as_float(w.w << 16); f[7] = __uint_as_float(w.w & 0xffff0000u);
}
__device__ __forceinline__ void p2_conv(Frame& F) {
    const bf16* U = (const bf16*)(F.ws + WS_U); bf16* Y = (bf16*)(F.ws + WS_Y);
    LAS unsigned char* uw = F.lds + RING_OFF + CONV_UW; LAS unsigned char* cwl = F.lds + RING_OFF + CONV_CWL;
    { const float* cw = F.in[I_CONV_W];
      for (int i = F.tid; i < CW * DCONV / 8; i += NWAVES * 64) { const GAS f32x4* s = (const GAS f32x4*)(cw + i * 8); *(LAS v4u*)(cwl + i * 16) = cvt8(s[0], s[1]); } }
    float cb[8], lg[8], lb[8];
    { const int c0 = 8 * F.lane;
#pragma unroll
      for (int e = 0; e < 8; ++e) { cb[e] = F.in[I_CONV_B][c0 + e]; lg[e] = F.in[I_CONV_LN_G][c0 + e]; lb[e] = F.in[I_CONV_LN_B][c0 + e]; } }
    const int NUNIT = T / CONV_TOK;
    for (int un = F.vcu; un < NUNIT; un += F.G) {
        const int b = un / (SEQ / CONV_TOK), s0 = (un % (SEQ / CONV_TOK)) * CONV_TOK;
        __syncthreads();
        for (int i = F.tid; i < (CONV_TOK + 30) * 64; i += NWAVES * 64) { const int r = i >> 6, ch = i & 63, s = s0 - 30 + r;
            v4u v = (v4u){0u, 0u, 0u, 0u}; if (s >= 0) v = *(const GAS v4u*)(U + ((size_t)b * SEQ + s) * DCONV + ch * 8);
            *(LAS v4u*)(uw + r * 1024 + ch * 16) = v; }
        __syncthreads();
#pragma unroll 1
        for (int grp = 0; grp < 2; ++grp) {
            const int sb = 8 * F.wave + 4 * grp;
            float acc[4][8];
#pragma unroll
            for (int q = 0; q < 4; ++q)
#pragma unroll
                for (int e = 0; e < 8; ++e) acc[q][e] = cb[e];
            float wv[4][8];
            const LAS unsigned char* up = uw + sb * 1024 + F.lane * 16; const LAS unsigned char* wp = cwl + F.lane * 16;
#define CONV_ROW(RHO, RI) do { float ur[8]; unpack8(*(const LAS v4u*)(up + (RHO) * 1024), ur); \
                if ((RI) < CW) unpack8(*(const LAS v4u*)(wp + (RHO) * 1024), wv[(RI) & 3]); \
                _Pragma("unroll") for (int q = 0; q < 4; ++q) { const int j = (RI) - q; if (j >= 0 && j < CW) { \
                    _Pragma("unroll") for (int e = 0; e < 8; ++e) acc[q][e] += wv[j & 3][e] * ur[e]; } } \
                __builtin_amdgcn_sched_barrier(0); } while (0)
            CONV_ROW(0, 0); CONV_ROW(1, 1); CONV_ROW(2, 2); CONV_ROW(3, 3);
#pragma unroll 1
            for (int r4 = 4; r4 < 28; r4 += 4) { CONV_ROW(r4, 4); CONV_ROW(r4 + 1, 5); CONV_ROW(r4 + 2, 6); CONV_ROW(r4 + 3, 7); }
            CONV_ROW(28, 28); CONV_ROW(29, 29); CONV_ROW(30, 30); CONV_ROW(31, 31); CONV_ROW(32, 32); CONV_ROW(33, 33);
#undef CONV_ROW
#pragma unroll
            for (int q = 0; q < 4; ++q) {
                float s = 0.f;
#pragma unroll
                for (int e = 0; e < 8; ++e) s += acc[q][e];
                const float mu = wave_sum(s) * (1.0f / DCONV); float s2 = 0.f;
#pragma unroll
                for (int e = 0; e < 8; ++e) { acc[q][e] -= mu; s2 += acc[q][e] * acc[q][e]; }
                const float rstd = 1.0f / sqrtf(wave_sum(s2) * (1.0f / DCONV) + LN_EPS); float s3 = 0.f;
#pragma unroll
                for (int e = 0; e < 8; ++e) { const float y = acc[q][e] * rstd * lg[e] + lb[e]; const float sw = y * fast_sigmoid(y); acc[q][e] = sw; s3 += sw * sw; }
                const float rr = 1.0f / sqrtf(wave_sum(s3) * (1.0f / DCONV) + EPS);
                v4u o; o.x = pk2(acc[q][0] * rr, acc[q][1] * rr); o.y = pk2(acc[q][2] * rr, acc[q][3] * rr); o.z = pk2(acc[q][4] * rr, acc[q][5] * rr); o.w = pk2(acc[q][6] * rr, acc[q][7] * rr);
                *(GAS v4u*)(Y + ((size_t)b * SEQ + s0 + sb + q) * DMODEL + DATT + 8 * F.lane) = o;
            }
        }
    }
    __syncthreads();
}

namespace topk {
typedef float f32x16 __attribute__((ext_vector_type(16)));
typedef short bf16x8 __attribute__((ext_vector_type(8)));
constexpr int SKL_OFF = 0, LUT_OFF = 65536, TOPK_LDS = LUT_OFF + NWAVES * 64 * 32;
static_assert(TOPK_LDS <= RING_BYTES, "topk LDS");
__device__ __forceinline__ float vmaxf(float a, float b) { float r; asm("v_max_f32_e32 %0, %1, %2" : "=v"(r) : "v"(a), "v"(b)); return r; }
__device__ __forceinline__ float vminf(float a, float b) { float r; asm("v_min_f32_e32 %0, %1, %2" : "=v"(r) : "v"(a), "v"(b)); return r; }
#define TK_CE(x, y) do { const float hi_ = vmaxf(x, y), lo_ = vminf(x, y); x = hi_; y = lo_; } while (0)
constexpr int SA[63] = {0,2,4,6,8,10,12,14,0,1,4,5,8,9,12,13,1,5,9,13,0,1,2,3,8,9,10,11,2,3,10,11,1,3,5,9,11,13,0,1,2,3,4,5,6,7,4,5,6,7,2,3,6,7,10,11,1,3,5,7,9,11,13};
constexpr int SB[63] = {1,3,5,7,9,11,13,15,2,3,6,7,10,11,14,15,2,6,10,14,4,5,6,7,12,13,14,15,4,5,12,13,2,4,6,10,12,14,8,9,10,11,12,13,14,15,8,9,10,11,4,5,8,9,12,13,2,4,6,8,10,12,14};
constexpr int MA[32] = {0,1,2,3,4,5,6,7,0,1,2,3,8,9,10,11,0,1,4,5,8,9,12,13,0,2,4,6,8,10,12,14};
constexpr int MB[32] = {8,9,10,11,12,13,14,15,4,5,6,7,12,13,14,15,2,3,6,7,10,11,14,15,1,3,5,7,9,11,13,15};
constexpr int CAND_A[50] = {0,0,0,0,0,0,0,0,0,0,0,0,0,0,0,0,1,1,1,1,1,1,1,1,2,2,2,2,2,3,3,3,3,4,4,4,5,5,6,6,7,7,8,9,10,11,12,13,14,15};
constexpr int CAND_B[50] = {0,1,2,3,4,5,6,7,8,9,10,11,12,13,14,15,0,1,2,3,4,5,6,7,0,1,2,3,4,0,1,2,3,0,1,2,0,1,0,1,0,1,0,0,0,0,0,0,0,0};
__device__ __forceinline__ void sort16(float (&v)[16]) {
#pragma unroll
    for (int i = 0; i < 63; ++i) TK_CE(v[SA[i]], v[SB[i]]);
}
__device__ __forceinline__ void bitonic16(float (&v)[16]) {
#pragma unroll
    for (int i = 0; i < 32; ++i) TK_CE(v[MA[i]], v[MB[i]]);
}
__device__ __forceinline__ void merge16(float (&a)[16], const float (&b)[16]) {
#pragma unroll
    for (int i = 0; i < 16; ++i) a[i] = vmaxf(a[i], b[15 - i]);
    bitonic16(a);
}
__device__ __forceinline__ void top16_of_tiles(const f32x16 (&acc)[4], int hi, float (&top)[16]) {
    float w[16];
#pragma unroll
    for (int blk = 0; blk < 4; ++blk) {
#pragma unroll
        for (int r = 0; r < 16; ++r) { const unsigned key = (unsigned)(blk * 32 + (r & 3) + 8 * (r >> 2)) + 4u * (unsigned)hi;
            const float pv = __uint_as_float((__float_as_uint(acc[blk][r]) & 0xffffff80u) | key);
            if (blk == 0) top[r] = pv; else w[r] = pv; }
        if (blk == 0) sort16(top); else { sort16(w); merge16(top, w); }
    }
    float lo[16], hi_[16];
#pragma unroll
    for (int i = 0; i < 16; ++i) { const auto rr = __builtin_amdgcn_permlane32_swap(__float_as_uint(top[i]), __float_as_uint(top[i]), false, false); lo[i] = __uint_as_float(rr[0]); hi_[i] = __uint_as_float(rr[1]); }
#pragma unroll
    for (int i = 0; i < 16; ++i) top[i] = vmaxf(lo[i], hi_[15 - i]);
    bitonic16(top);
}
}

__device__ __forceinline__ void p5_topk(Frame& F) {
    using namespace topk;
    const bf16* QP = (const bf16*)(F.ws + WS_QP); const bf16* SK = (const bf16*)(F.ws + WS_SK);
    unsigned short* SEL = (unsigned short*)(F.ws + WS_SEL); float* GATE = (float*)(F.ws + WS_GATE);
    LAS unsigned char* skl = F.lds + RING_OFF + SKL_OFF; LAS unsigned char* lut = F.lds + RING_OFF + LUT_OFF + F.tid * 32;
    for (int i = F.tid; i < 2 * NKEY * 16; i += NWAVES * 64) { const int row = i >> 4, c = i & 15;
        *(LAS v4u*)(skl + row * 256 + ((c ^ (row & 15)) << 4)) = *(const GAS v4u*)(SK + (size_t)row * PHALF + c * 8); }
    __syncthreads();
    const int gw = F.vcu * NWAVES + F.wave, NGW = F.G * NWAVES, tok = F.lane & 31, hi = F.lane >> 5;
#pragma unroll 1
    for (int un = gw; un < (T / 32) * PH; un += NGW) {
        const int tg = un >> 3, h = un & 7; const size_t trow = (size_t)tg * 32 + tok;
        const bf16* qrow = QP + trow * (PH * PQ) + h * PQ + 8 * hi;
        float v1[16], v2[16];
#pragma unroll
        for (int half = 0; half < 2; ++half) {
            bf16x8 bq[8];
#pragma unroll
            for (int ks = 0; ks < 8; ++ks) bq[ks] = *(const GAS bf16x8*)(qrow + half * PHALF + ks * 16);
            f32x16 acc[4];
#pragma unroll
            for (int blk = 0; blk < 4; ++blk) { acc[blk] = f32x16{};
                const int key = blk * 32 + tok;
#pragma unroll
                for (int ks = 0; ks < 8; ++ks) { const bf16x8 a = *(const LAS bf16x8*)(skl + half * 32768 + key * 256 + (((2 * ks + hi) ^ (key & 15)) << 4));
                    acc[blk] = __builtin_amdgcn_mfma_f32_32x32x16_bf16(a, bq[ks], acc[blk], 0, 0, 0); } }
            if (half == 0) top16_of_tiles(acc, hi, v1); else top16_of_tiles(acc, hi, v2);
        }
#pragma unroll
        for (int i = 0; i < 16; ++i) { lut[i] = (unsigned char)(__float_as_uint(v1[i]) & 0x7fu); lut[16 + i] = (unsigned char)(__float_as_uint(v2[i]) & 0x7fu); }
        float c[4][16];
#pragma unroll
        for (int n = 0; n < 64; ++n) {
            if (n < 50) { const int a = CAND_A[n], b = CAND_B[n];
                const float s = __uint_as_float(__float_as_uint(v1[a]) & 0xffffff80u) + __uint_as_float(__float_as_uint(v2[b]) & 0xffffff80u);
                c[n >> 4][n & 15] = __uint_as_float((__float_as_uint(s) & 0xffffff00u) | (unsigned)((a << 4) | b)); }
            else c[n >> 4][n & 15] = -INFINITY;
        }
        sort16(c[0]); sort16(c[1]); merge16(c[0], c[1]); sort16(c[2]); merge16(c[0], c[2]); sort16(c[3]); merge16(c[0], c[3]);
        float g[16]; float sum = 0.f; const float m0 = __uint_as_float(__float_as_uint(c[0][0]) & 0xffffff00u);
#pragma unroll
        for (int i = 0; i < 16; ++i) { g[i] = __builtin_amdgcn_exp2f((__uint_as_float(__float_as_uint(c[0][i]) & 0xffffff00u) - m0) * LOG2E); sum += g[i]; }
        const float inv = __builtin_amdgcn_rcpf(sum);
        asm volatile("s_waitcnt lgkmcnt(0)" ::: "memory");
        unsigned ids[16];
#pragma unroll
        for (int i = 0; i < 16; ++i) { const unsigned code = __float_as_uint(c[0][i]) & 0xffu; ids[i] = (unsigned)lut[code >> 4] * NKEY + (unsigned)lut[16 + (code & 15)]; }
        if (hi == 0) {
            v4u s0, s1; s0.x = ids[0] | (ids[1] << 16); s0.y = ids[2] | (ids[3] << 16); s0.z = ids[4] | (ids[5] << 16); s0.w = ids[6] | (ids[7] << 16);
            s1.x = ids[8] | (ids[9] << 16); s1.y = ids[10] | (ids[11] << 16); s1.z = ids[12] | (ids[13] << 16); s1.w = ids[14] | (ids[15] << 16);
            GAS v4u* sp = (GAS v4u*)(SEL + trow * NSEL + h * PK); sp[0] = s0; sp[1] = s1;
        } else {
            GAS f32x4* gp = (GAS f32x4*)(GATE + trow * NSEL + h * PK);
#pragma unroll
            for (int i = 0; i < 4; ++i) gp[i] = (f32x4){g[4 * i] * inv, g[4 * i + 1] * inv, g[4 * i + 2] * inv, g[4 * i + 3] * inv};
        }
        asm volatile("s_waitcnt lgkmcnt(0)" ::: "memory");
    }
    __syncthreads();
}

__device__ __forceinline__ float gelu_tanh(float x) {
    const float u = 1.5957691216057308f * (x + 0.044715f * x * x * x);
    return x * __builtin_amdgcn_rcpf(1.0f + __builtin_amdgcn_exp2f(-u * LOG2E));
}
__device__ __forceinline__ float dot8(const v4u a, const v4u b, float acc) {
#pragma unroll
    for (int i = 0; i < 4; ++i) { acc += __uint_as_float(a[i] << 16) * __uint_as_float(b[i] << 16); acc += __uint_as_float(a[i] & 0xffff0000u) * __uint_as_float(b[i] & 0xffff0000u); }
    return acc;
}
__device__ __forceinline__ void p6_experts_u(Frame& F) {
    const bf16* H1B = (const bf16*)(F.ws + WS_H1B); const bf16* EU = (const bf16*)(F.ws + WS_EU);
    const unsigned short* SEL = (const unsigned short*)(F.ws + WS_SEL); const float* GATE = (const float*)(F.ws + WS_GATE); const float* SS1P = (const float*)(F.ws + WS_SS1P);
    float* WACT = (float*)(F.ws + WS_WACT);
    const int gw = F.vcu * NWAVES + F.wave, NGW = F.G * NWAVES;
#pragma unroll 1
    for (int t = gw; t < T; t += NGW) {
        const v4u ha = *(const GAS v4u*)(H1B + (size_t)t * DMODEL + 8 * F.lane), hb = *(const GAS v4u*)(H1B + (size_t)t * DMODEL + 512 + 8 * F.lane);
        float ssv = F.lane < 16 ? SS1P[(size_t)t * 16 + F.lane] : 0.f; ssv = wave_sum(ssv);
        const float rs2 = 1.0f / sqrtf(ssv * (1.0f / DMODEL) + EPS);
        const unsigned e0 = SEL[(size_t)t * NSEL + F.lane], e1 = SEL[(size_t)t * NSEL + 64 + F.lane];
        const float g0 = GATE[(size_t)t * NSEL + F.lane], g1 = GATE[(size_t)t * NSEL + 64 + F.lane];
        float w0 = 0.f, w1 = 0.f;
#pragma unroll 1
        for (int jb = 0; jb < NSEL; jb += 8) {
            float p[8];
#pragma unroll
            for (int i = 0; i < 8; ++i) { const int j = jb + i; const unsigned e = (unsigned)__builtin_amdgcn_readlane((int)(j < 64 ? e0 : e1), j & 63);
                const bf16* row = EU + (size_t)e * DMODEL + 8 * F.lane;
                p[i] = dot8(*(const GAS v4u*)(row + 512), hb, dot8(*(const GAS v4u*)row, ha, 0.f)); }
#pragma unroll
            for (int i = 0; i < 4; ++i) { const bool up = (F.lane & 32) != 0; const float keep = up ? p[i + 4] : p[i], send = up ? p[i] : p[i + 4]; p[i] = keep + __shfl_xor(send, 32); }
#pragma unroll
            for (int i = 0; i < 2; ++i) { const bool up = (F.lane & 16) != 0; const float keep = up ? p[i + 2] : p[i], send = up ? p[i] : p[i + 2]; p[i] = keep + __shfl_xor(send, 16); }
            { const bool up = (F.lane & 8) != 0; const float keep = up ? p[1] : p[0], send = up ? p[0] : p[1]; p[0] = keep + __shfl_xor(send, 8); }
            p[0] += __shfl_xor(p[0], 4); p[0] += __shfl_xor(p[0], 2); p[0] += __shfl_xor(p[0], 1);
            const float act = gelu_tanh(p[0] * rs2);
            const int r = F.lane & 7, src = ((r >> 2) & 1) * 32 + ((r >> 1) & 1) * 16 + (r & 1) * 8;
            const float got = __shfl(act, src);
            if ((F.lane >> 3) == ((jb >> 3) & 7)) { if (jb < 64) w0 = got; else w1 = got; }
        }
        WACT[(size_t)t * NSEL + F.lane] = w0 * g0; WACT[(size_t)t * NSEL + 64 + F.lane] = w1 * g1;
    }
}

__device__ __forceinline__ void p7_experts_v(Frame& F) {
    const bf16* H1B = (const bf16*)(F.ws + WS_H1B); const bf16* EV = (const bf16*)(F.ws + WS_EV);
    const unsigned short* SEL = (const unsigned short*)(F.ws + WS_SEL); const float* WACT = (const float*)(F.ws + WS_WACT);
    bf16* H2B = (bf16*)(F.ws + WS_H2B); float* SS2 = (float*)(F.ws + WS_SS2);
    const int gw = F.vcu * NWAVES + F.wave, NGW = F.G * NWAVES;
#pragma unroll 1
    for (int t = gw; t < T; t += NGW) {
        const v4u ha = *(const GAS v4u*)(H1B + (size_t)t * DMODEL + 8 * F.lane), hb = *(const GAS v4u*)(H1B + (size_t)t * DMODEL + 512 + 8 * F.lane);
        float o[16];
#pragma unroll
        for (int i = 0; i < 4; ++i) { o[2 * i] = __uint_as_float(ha[i] << 16); o[2 * i + 1] = __uint_as_float(ha[i] & 0xffff0000u); o[8 + 2 * i] = __uint_as_float(hb[i] << 16); o[9 + 2 * i] = __uint_as_float(hb[i] & 0xffff0000u); }
        const unsigned e0 = SEL[(size_t)t * NSEL + F.lane], e1 = SEL[(size_t)t * NSEL + 64 + F.lane];
        const float w0 = WACT[(size_t)t * NSEL + F.lane], w1 = WACT[(size_t)t * NSEL + 64 + F.lane];
#pragma unroll 1
        for (int jb = 0; jb < NSEL; jb += 8) {
#pragma unroll
            for (int i = 0; i < 8; ++i) { const int j = jb + i; const unsigned e = (unsigned)__builtin_amdgcn_readlane((int)(j < 64 ? e0 : e1), j & 63);
                const float w = __uint_as_float((unsigned)__builtin_amdgcn_readlane((int)__float_as_uint(j < 64 ? w0 : w1), j & 63));
                const bf16* row = EV + (size_t)e * DMODEL + 8 * F.lane; const v4u va = *(const GAS v4u*)row, vb = *(const GAS v4u*)(row + 512);
#pragma unroll
                for (int q = 0; q < 4; ++q) { o[2 * q] += w * __uint_as_float(va[q] << 16); o[2 * q + 1] += w * __uint_as_float(va[q] & 0xffff0000u);
                    o[8 + 2 * q] += w * __uint_as_float(vb[q] << 16); o[9 + 2 * q] += w * __uint_as_float(vb[q] & 0xffff0000u); } }
        }
        float ss = 0.f;
#pragma unroll
        for (int i = 0; i < 16; ++i) ss += o[i] * o[i];
        ss = wave_sum(ss);
        v4u oa, ob; oa.x = pk2(o[0], o[1]); oa.y = pk2(o[2], o[3]); oa.z = pk2(o[4], o[5]); oa.w = pk2(o[6], o[7]); ob.x = pk2(o[8], o[9]); ob.y = pk2(o[10], o[11]); ob.z = pk2(o[12], o[13]); ob.w = pk2(o[14], o[15]);
        *(GAS v4u*)(H2B + (size_t)t * DMODEL + 8 * F.lane) = oa; *(GAS v4u*)(H2B + (size_t)t * DMODEL + 512 + 8 * F.lane) = ob;
        if (F.lane == 0) SS2[t] = ss;
    }
}

constexpr int N_PHASES = 9;
struct Args { const float* in[23]; float* out; unsigned char* ws; int ph_lo, ph_hi; };
__global__ void __launch_bounds__(NWAVES * 64, 2) mega_fwd(Args args) {
    extern __shared__ __attribute__((aligned(16))) unsigned char lds[];
    Frame F;
    F.lds = (LAS unsigned char*)lds;
    F.MISC = (volatile LAS unsigned*)(F.lds + MISC_OFF);
    F.tid = threadIdx.x; F.lane = F.tid & 63; F.wave = __builtin_amdgcn_readfirstlane(F.tid >> 6);
    F.G = gridDim.x; { const int bx = blockIdx.x; F.vcu = (F.G % 8 == 0) ? (bx % 8) * (F.G / 8) + bx / 8 : bx; }
    F.ws = args.ws; F.ctl = (gu32*)(args.ws + WS_CTL); F.out = args.out;
#pragma unroll
    for (int i = 0; i < 23; ++i) F.in[i] = args.in[i];
    for (int u = F.tid; u < (LDS_BYTES - LDSCTL_OFF) / 4; u += NWAVES * 64) ((LAS unsigned*)(F.lds + LDSCTL_OFF))[u] = 0u;
    __syncthreads();
    const int lo = args.ph_lo, hi = args.ph_hi;
    XcdBarrier bar; bar.bar = (unsigned*)(F.ctl + CW_BAR); bar.x = 0; bar.st = nullptr;
    if (hi - lo > 1) bar = xcd_barrier_post((unsigned*)(F.ctl + CW_BAR), F.MISC + 8);
#define IN(k) ((((PH_MASK) >> (k)) & 1) && lo <= (k) && (k) < hi)
#define SEAM(k) do { if (IN(k) && IN((k) + 1)) xcd_barrier(bar); } while (0)

    if (IN(0)) { p0_prologue(F); SEAM(0); }

    if (IN(1)) {
        p1_scan(F);
        pg8::Gemm g{(const pg8::bf16_t*)(F.ws + WS_XB), (const pg8::bf16_t*)(F.ws + WS_WI), T, NINP, DMODEL};
        pg8::StaticOrder S; S.init(T, NINP, F.G, (int)blockIdx.x);
        pg8::EpiInProj E{(pg8::bf16_t*)(F.ws + WS_QKV), (pg8::bf16_t*)(F.ws + WS_U), (const float*)(F.ws + WS_RS1), F.in[I_Q_NORM], F.in[I_K_NORM]};
        pg8::gemm_phase<pg8::EpiInProj, pg8::StaticOrder, true, true>(F.lds + RING_OFF, g, S, E);
        SEAM(1);
    }

    if (IN(2)) {
        static_assert(attn_body::LDS_BYTES <= RING_BYTES, "attention LDS");
        const attn_body::AttnTensors AT{(const attn_body::bf16*)(F.ws + WS_QKV), (const attn_body::bf16*)(F.ws + WS_QKV) + 512, (const attn_body::bf16*)(F.ws + WS_QKV) + 1024,
                                        (attn_body::bf16*)(F.ws + WS_Y), (const float*)(F.ws + WS_G), (float*)(F.ws + WS_SSA)};
        const attn_body::StaticOrder S((int)F.G, (int)blockIdx.x);
        attn_body::attn_phase<attn_body::StaticOrder>((char*)lds + RING_OFF, AT, S);
        p2_conv(F);
        SEAM(2);
    }

    if (IN(3)) {
        pg8::Gemm g{(const pg8::bf16_t*)(F.ws + WS_Y), (const pg8::bf16_t*)(F.ws + WS_WO), T, DMODEL, DMODEL};
        pg8::StaticOrder S; S.init(T, DMODEL, F.G, (int)blockIdx.x);
        { const float* SSA = (const float*)(F.ws + WS_SSA); LAS float* tab = (LAS float*)(F.lds + RSA_OFF); pg8::Unit u;
          for (int i = 0; i < 8 && S.next(i, u); ++i) if (F.tid < 256) { const int row = u.pm * 256 + F.tid;
              const f32x4 s0 = *(const f32x4*)(SSA + (size_t)row * 8), s1 = *(const f32x4*)(SSA + (size_t)row * 8 + 4);
              tab[i * 256 + F.tid] = 1.0f / sqrtf(((s0.x + s0.y) + (s0.z + s0.w) + (s1.x + s1.y) + (s1.z + s1.w)) * (1.0f / DATT) + EPS); }
          __syncthreads(); }
        pg8::EpiOutProj E{F.in[I_X], (pg8::bf16_t*)(F.ws + WS_H1B), (float*)(F.ws + WS_SS1P), (const float*)(F.ws + WS_SSA), RSA_OFF - RING_OFF};
        pg8::gemm_phase<pg8::EpiOutProj, pg8::StaticOrder, true, true>(F.lds + RING_OFF, g, S, E);
        SEAM(3);
    }
    if (IN(4)) {
        pg8::Gemm g{(const pg8::bf16_t*)(F.ws + WS_H1B), (const pg8::bf16_t*)(F.ws + WS_WQ), T, PH * PQ, DMODEL};
        pg8::StaticOrder S; S.init(T, PH * PQ, F.G, (int)blockIdx.x);
        pg8::EpiRowScale E{(pg8::bf16_t*)(F.ws + WS_QP), PH * PQ, (const float*)(F.ws + WS_SS1P), 16, 1.0f / DMODEL};
        pg8::gemm_phase<pg8::EpiRowScale, pg8::StaticOrder, true, true>(F.lds + RING_OFF, g, S, E);
        SEAM(4);
    }
    if (IN(5)) { p5_topk(F); SEAM(5); }
    if (IN(6)) {
        pg8::Gemm g{(const pg8::bf16_t*)(F.ws + WS_PB), (const pg8::bf16_t*)(F.ws + WS_WP), T, DMODEL, DPLE};
        pg8::StaticOrder S; S.init(T, DMODEL, F.G, (int)blockIdx.x);
        pg8::EpiRowScale E{(pg8::bf16_t*)(F.ws + WS_PLE), DMODEL, nullptr, 0, 0.f};
        pg8::gemm_phase<pg8::EpiRowScale, pg8::StaticOrder, true, true>(F.lds + RING_OFF, g, S, E);
        p6_experts_u(F);
        SEAM(6);
    }
    if (IN(7)) { p7_experts_v(F); SEAM(7); }
    if (IN(8)) {
        pg8::Gemm g{(const pg8::bf16_t*)(F.ws + WS_H2B), (const pg8::bf16_t*)(F.ws + WS_WG), T, DMODEL, DMODEL};
        pg8::StaticOrder S; S.init(T, DMODEL, F.G, (int)blockIdx.x);
        pg8::EpiFinal E{(const pg8::bf16_t*)(F.ws + WS_H2B), (const pg8::bf16_t*)(F.ws + WS_PLE), (const float*)(F.ws + WS_SS2), F.out};
        pg8::gemm_phase<pg8::EpiFinal, pg8::StaticOrder, true, true>(F.lds + RING_OFF, g, S, E);
    }

#undef IN
#undef SEAM
}

#if SELFCHECK
namespace chk {
constexpr int NS = 64;
__device__ __forceinline__ int sample_token(int i) {
    switch (i) { case 0: return 0; case 1: return 2047; case 2: return 2048; case 3: return T - 1; case 4: return 255; case 5: return 256; case 6: return 31; case 7: return 2048 * 7 + 1000; default: break; }
    return (int)(((long)i * 7919 + 13) % T);
}
__device__ __forceinline__ float bf2f(unsigned short v) { return __uint_as_float((unsigned)v << 16); }
__device__ float block_sum(float v, float* red) {
    for (int o = 1; o < 64; o <<= 1) v += __shfl_xor(v, o);
    const int w = threadIdx.x >> 6, nw = blockDim.x >> 6;
    __syncthreads(); if ((threadIdx.x & 63) == 0) red[w] = v; __syncthreads();
    float t = 0.f; for (int i = 0; i < nw; ++i) t += red[i];
    return t;
}
__device__ float block_max(float v, float* red) {
    for (int o = 1; o < 64; o <<= 1) v = fmaxf(v, __shfl_xor(v, o));
    const int w = threadIdx.x >> 6, nw = blockDim.x >> 6;
    __syncthreads(); if ((threadIdx.x & 63) == 0) red[w] = v; __syncthreads();
    float t = red[0]; for (int i = 1; i < nw; ++i) t = fmaxf(t, red[i]);
    return t;
}
__device__ void verdict(unsigned* code, int bit, float d2, float r2, float tol) { if (threadIdx.x == 0 && !(d2 <= tol * tol * r2 + 1e-10f)) atomicOr(code, 1u << bit); }

__global__ void __launch_bounds__(256) chk_inproj(Args a) {
    __shared__ float zs[NIN]; __shared__ float xs[DMODEL]; __shared__ float msq[16]; __shared__ float red[8];
    const int t = sample_token(blockIdx.x), tid = threadIdx.x; unsigned* code = (unsigned*)(a.ws + WS_CTL) + CW_CODE;
    const float* x = a.in[I_X] + (size_t)t * DMODEL; float s = 0.f;
    for (int k = tid; k < DMODEL; k += 256) s += x[k] * x[k];
    const float rs = 1.0f / sqrtf(block_sum(s, red) / DMODEL + EPS);
    for (int k = tid; k < DMODEL; k += 256) xs[k] = x[k] * rs * a.in[I_LN_MIX][k];
    __syncthreads();
    for (int c = tid; c < NIN; c += 256) { float acc = 0.f; const float* w = a.in[I_W_IN] + c; for (int k = 0; k < DMODEL; ++k) acc += xs[k] * w[(size_t)k * NIN]; zs[c] = acc; }
    __syncthreads();
    if (tid < 16) { float m = 0.f; for (int d = 0; d < 64; ++d) { const float v = zs[64 * tid + d]; m += v * v; } msq[tid] = m / 64.f; }
    __syncthreads();
    const unsigned short* QKV = (const unsigned short*)(a.ws + WS_QKV) + (size_t)t * 1536; const unsigned short* U = (const unsigned short*)(a.ws + WS_U) + (size_t)t * 512;
    float d2[5] = {0, 0, 0, 0, 0}, r2[5] = {0, 0, 0, 0, 0};
    for (int i = tid; i < 512; i += 256) { const int h = i >> 6, d = i & 63;
        float e = zs[i] / sqrtf(msq[h] + EPS) * a.in[I_Q_NORM][d] * pg8::ATT_C2, v = bf2f(QKV[i]); d2[0] += (e - v) * (e - v); r2[0] += e * e;
        e = zs[512 + i] / sqrtf(msq[8 + h] + EPS) * a.in[I_K_NORM][d]; v = bf2f(QKV[512 + i]); d2[1] += (e - v) * (e - v); r2[1] += e * e;
        e = zs[1024 + i]; v = bf2f(QKV[1024 + i]); d2[2] += (e - v) * (e - v); r2[2] += e * e;
        e = zs[COL_A + i] / (1.f + expf(-zs[COL_G + i])); v = bf2f(U[i]); d2[3] += (e - v) * (e - v); r2[3] += e * e; }
    if (tid < 8) { const float z = zs[COL_F + tid] + a.in[I_B_FGATE][tid]; const float e = (fminf(z, 0.f) - log1pf(expf(-fabsf(z)))) * LOG2E, v = ((const float*)(a.ws + WS_LF))[(size_t)t * 8 + tid]; d2[4] += (e - v) * (e - v); r2[4] += e * e; }
    for (int g = 0; g < 5; ++g) { const float dd = block_sum(d2[g], red), rr = block_sum(r2[g], red); verdict(code, g, dd, rr, 2e-2f); }
}
__global__ void chk_scan(Args a) {
    const int i = threadIdx.x; unsigned* code = (unsigned*)(a.ws + WS_CTL) + CW_CODE;
    const int bh = (i * 5) % (BATCH * NH), s = i == 0 ? 0 : (i == 1 ? SEQ - 1 : (i * 331 + 77) % SEQ), b = bh >> 3, h = bh & 7;
    const float* LF = (const float*)(a.ws + WS_LF); double acc = 0.0; for (int u = 0; u <= s; ++u) acc += LF[((size_t)b * SEQ + u) * 8 + h];
    const float v = ((const float*)(a.ws + WS_G))[(size_t)bh * SEQ + s];
    if (!(fabsf(v - (float)acc) <= 2e-3f * (1.f + fabsf((float)acc)))) atomicOr(code, 1u << 5);
}
__global__ void __launch_bounds__(256) chk_attn(Args a) {
    __shared__ float l[SEQ]; __shared__ float qs[64]; __shared__ float part[4][64]; __shared__ float red[8];
    const int t = sample_token(blockIdx.x), h = blockIdx.x & 7, tid = threadIdx.x, b = t / SEQ, st = t % SEQ; unsigned* code = (unsigned*)(a.ws + WS_CTL) + CW_CODE;
    const unsigned short* QKV = (const unsigned short*)(a.ws + WS_QKV); const float* G = (const float*)(a.ws + WS_G) + (size_t)(b * NH + h) * SEQ;
    if (tid < 64) qs[tid] = bf2f(QKV[(size_t)t * 1536 + 64 * h + tid]);
    __syncthreads();
    float mx = -INFINITY;
    for (int s = tid; s <= st; s += 256) { const unsigned short* kr = QKV + ((size_t)b * SEQ + s) * 1536 + 512 + 64 * h; float acc = 0.f; for (int d = 0; d < 64; ++d) acc += qs[d] * bf2f(kr[d]);
        acc += G[st] - G[s]; l[s] = acc; mx = fmaxf(mx, acc); }
    mx = block_max(mx, red);
    float sm = 0.f; for (int s = tid; s <= st; s += 256) { const float p = exp2f(l[s] - mx); l[s] = p; sm += p; }
    sm = block_sum(sm, red);
    { const int d = tid & 63, pt = tid >> 6; float acc = 0.f; for (int s = pt; s <= st; s += 4) acc += l[s] * bf2f(QKV[((size_t)b * SEQ + s) * 1536 + 1024 + 64 * h + d]); part[pt][d] = acc; }
    __syncthreads();
    float d2 = 0.f, r2 = 0.f, e2 = 0.f;
    if (tid < 64) { const float e = (part[0][tid] + part[1][tid] + part[2][tid] + part[3][tid]) / sm, v = bf2f(((const unsigned short*)(a.ws + WS_Y))[(size_t)t * 1024 + 64 * h + tid]); d2 = (e - v) * (e - v); r2 = e * e; e2 = e * e; }
    d2 = block_sum(d2, red); r2 = block_sum(r2, red); verdict(code, 6, d2, r2, 3e-2f);
    if (tid == 0) { const float v = ((const float*)(a.ws + WS_SSA))[(size_t)t * 8 + h]; if (!(fabsf(v - r2) <= 0.05f * r2 + 1e-6f)) atomicOr(code, 1u << 7); }
}
__global__ void __launch_bounds__(512) chk_conv(Args a) {
    __shared__ float red[8];
    const int t = sample_token(blockIdx.x), c = threadIdx.x, b = t / SEQ, st = t % SEQ; unsigned* code = (unsigned*)(a.ws + WS_CTL) + CW_CODE;
    const unsigned short* U = (const unsigned short*)(a.ws + WS_U);
    float y = a.in[I_CONV_B][c];
    for (int j = 0; j < CW; ++j) { const int s = st - 30 + j; if (s >= 0) y += a.in[I_CONV_W][j * DCONV + c] * bf2f(U[((size_t)b * SEQ + s) * DCONV + c]); }
    const float mu = block_sum(y, red) / DCONV; const float var = block_sum((y - mu) * (y - mu), red) / DCONV;
    const float ln = (y - mu) / sqrtf(var + LN_EPS) * a.in[I_CONV_LN_G][c] + a.in[I_CONV_LN_B][c]; const float sw = ln / (1.f + expf(-ln));
    const float ss = block_sum(sw * sw, red) / DCONV; const float e = sw / sqrtf(ss + EPS);
    const float v = bf2f(((const unsigned short*)(a.ws + WS_Y))[(size_t)t * 1024 + 512 + c]);
    const float d2 = block_sum((e - v) * (e - v), red), r2 = block_sum(e * e, red); verdict(code, 8, d2, r2, 2e-2f);
}
__device__ void dense_row(const float* a, int K, const float* W, int ldw, int N, float* out) {
    for (int n = threadIdx.x; n < N; n += blockDim.x) { float acc = 0.f; for (int k = 0; k < K; ++k) acc += a[k] * W[(size_t)k * ldw + n]; out[n] = acc; }
}
__global__ void __launch_bounds__(256) chk_outproj(Args a) {
    __shared__ float ys[DMODEL]; __shared__ float hs[DMODEL]; __shared__ float red[8];
    const int t = sample_token(blockIdx.x), tid = threadIdx.x; unsigned* code = (unsigned*)(a.ws + WS_CTL) + CW_CODE;
    const unsigned short* Y = (const unsigned short*)(a.ws + WS_Y) + (size_t)t * DMODEL;
    float s = 0.f; for (int c = tid; c < DATT; c += 256) { const float v = bf2f(Y[c]); s += v * v; }
    const float rsa = 1.0f / sqrtf(block_sum(s, red) / DATT + EPS);
    for (int c = tid; c < DMODEL; c += 256) ys[c] = c < DATT ? bf2f(Y[c]) * rsa * a.in[I_ATTN_OUT_NORM][c] : bf2f(Y[c]) * a.in[I_CONV_OUT_NORM][c - DATT];
    __syncthreads();
    dense_row(ys, DMODEL, a.in[I_W_OUT], DMODEL, DMODEL, hs);
    __syncthreads();
    float d2 = 0.f, r2 = 0.f;
    for (int n = tid; n < DMODEL; n += 256) { const float e = a.in[I_X][(size_t)t * DMODEL + n] + hs[n], v = bf2f(((const unsigned short*)(a.ws + WS_H1B))[(size_t)t * DMODEL + n]); d2 += (e - v) * (e - v); r2 += e * e; }
    d2 = block_sum(d2, red); r2 = block_sum(r2, red); verdict(code, 9, d2, r2, 2e-2f);
    if (tid == 0) { float ss = 0.f; for (int i = 0; i < 16; ++i) ss += ((const float*)(a.ws + WS_SS1P))[(size_t)t * 16 + i]; if (!(fabsf(ss - r2) <= 0.03f * r2)) atomicOr(code, 1u << 10); }
}
__global__ void __launch_bounds__(256) chk_peerq(Args a) {
    __shared__ float xs[DMODEL]; __shared__ float qs[PH * PQ]; __shared__ float red[8];
    const int t = sample_token(blockIdx.x), tid = threadIdx.x; unsigned* code = (unsigned*)(a.ws + WS_CTL) + CW_CODE;
    const unsigned short* H = (const unsigned short*)(a.ws + WS_H1B) + (size_t)t * DMODEL;
    float s = 0.f; for (int c = tid; c < DMODEL; c += 256) { const float v = bf2f(H[c]); s += v * v; }
    const float rs = 1.0f / sqrtf(block_sum(s, red) / DMODEL + EPS);
    for (int c = tid; c < DMODEL; c += 256) xs[c] = bf2f(H[c]) * rs * a.in[I_LN_FFN][c];
    __syncthreads();
    dense_row(xs, DMODEL, a.in[I_W_PEER_Q], PH * PQ, PH * PQ, qs);
    __syncthreads();
    float d2 = 0.f, r2 = 0.f;
    for (int n = tid; n < PH * PQ; n += 256) { const float e = qs[n], v = bf2f(((const unsigned short*)(a.ws + WS_QP))[(size_t)t * PH * PQ + n]); d2 += (e - v) * (e - v); r2 += e * e; }
    d2 = block_sum(d2, red); r2 = block_sum(r2, red); verdict(code, 11, d2, r2, 2e-2f);
}
__global__ void __launch_bounds__(256) chk_topk(Args a) {
    __shared__ float s1[NKEY], s2[NKEY]; __shared__ float red[8]; __shared__ int bad;
    const int t = sample_token(blockIdx.x), h = (blockIdx.x * 3) & 7, tid = threadIdx.x; unsigned* code = (unsigned*)(a.ws + WS_CTL) + CW_CODE;
    const unsigned short* q = (const unsigned short*)(a.ws + WS_QP) + (size_t)t * PH * PQ + h * PQ;
    if (tid == 0) bad = 0;
    { const int k = tid & 127, half = tid >> 7; const float* sk = (half ? a.in[I_SUB_KEYS2] : a.in[I_SUB_KEYS1]) + (size_t)k * PHALF; float acc = 0.f;
      for (int d = 0; d < PHALF; ++d) acc += bf2f(q[half * PHALF + d]) * sk[d];
      if (half) s2[k] = acc; else s1[k] = acc; }
    __syncthreads();
    const unsigned short* sel = (const unsigned short*)(a.ws + WS_SEL) + (size_t)t * NSEL + h * PK; const float* gate = (const float*)(a.ws + WS_GATE) + (size_t)t * NSEL + h * PK;
    float cs[PK]; float mx = -INFINITY;
    for (int i = 0; i < PK; ++i) { const int e = sel[i]; cs[i] = s1[e >> 7] + s2[e & 127]; mx = fmaxf(mx, cs[i]); }
    for (int i = 0; i < PK; ++i) {
        int cnt = 0; for (int c = tid; c < NKEY * NKEY; c += 256) cnt += (s1[c >> 7] + s2[c & 127] > cs[i] + 2e-2f) ? 1 : 0;
        const float tot = block_sum((float)cnt, red); if (tid == 0 && tot >= 16.f) bad = 1;
        for (int j = 0; j < i; ++j) if (tid == 0 && sel[j] == sel[i]) bad = 1;
    }
    if (tid == 0) { float sum = 0.f; for (int i = 0; i < PK; ++i) sum += expf(cs[i] - mx);
        for (int i = 0; i < PK; ++i) { const float e = expf(cs[i] - mx) / sum; if (!(fabsf(gate[i] - e) <= 0.02f * e + 1e-4f)) bad = 1; }
        if (bad) atomicOr(code, 1u << 12); }
}
__global__ void __launch_bounds__(256) chk_experts(Args a) {
    __shared__ float xs[DMODEL]; __shared__ float ws_[NSEL]; __shared__ float red[8];
    const int t = sample_token(blockIdx.x), tid = threadIdx.x; unsigned* code = (unsigned*)(a.ws + WS_CTL) + CW_CODE;
    const unsigned short* H = (const unsigned short*)(a.ws + WS_H1B) + (size_t)t * DMODEL;
    float s = 0.f; for (int c = tid; c < DMODEL; c += 256) { const float v = bf2f(H[c]); s += v * v; }
    const float rs = 1.0f / sqrtf(block_sum(s, red) / DMODEL + EPS);
    for (int c = tid; c < DMODEL; c += 256) xs[c] = bf2f(H[c]) * rs * a.in[I_LN_FFN][c];
    __syncthreads();
    const unsigned short* sel = (const unsigned short*)(a.ws + WS_SEL) + (size_t)t * NSEL; const float* gate = (const float*)(a.ws + WS_GATE) + (size_t)t * NSEL;
    float d2 = 0.f, r2 = 0.f;
    if (tid < NSEL) { const float* u = a.in[I_EXPERT_U] + (size_t)sel[tid] * DMODEL; float acc = 0.f; for (int d = 0; d < DMODEL; ++d) acc += u[d] * xs[d];
        const float act = 0.5f * acc * (1.f + tanhf(0.7978845608028654f * (acc + 0.044715f * acc * acc * acc))); const float e = gate[tid] * act, v = ((const float*)(a.ws + WS_WACT))[(size_t)t * NSEL + tid];
        ws_[tid] = e; d2 = (e - v) * (e - v); r2 = e * e; }
    d2 = block_sum(d2, red); r2 = block_sum(r2, red); verdict(code, 13, d2, r2, 3e-2f);
    __syncthreads();
    d2 = 0.f; r2 = 0.f;
    for (int d = tid; d < DMODEL; d += 256) { float acc = bf2f(H[d]); for (int j = 0; j < NSEL; ++j) acc += ws_[j] * a.in[I_EXPERT_V][(size_t)sel[j] * DMODEL + d];
        const float v = bf2f(((const unsigned short*)(a.ws + WS_H2B))[(size_t)t * DMODEL + d]); d2 += (acc - v) * (acc - v); r2 += acc * acc; }
    d2 = block_sum(d2, red); r2 = block_sum(r2, red); verdict(code, 14, d2, r2, 1e-2f);
    if (tid == 0) { const float ss = ((const float*)(a.ws + WS_SS2))[t]; if (!(fabsf(ss - r2) <= 0.03f * r2)) atomicOr(code, 1u << 15); }
}
__global__ void __launch_bounds__(256) chk_ple(Args a) {
    __shared__ float ps[DPLE]; __shared__ float os[DMODEL]; __shared__ float red[8];
    const int t = sample_token(blockIdx.x), tid = threadIdx.x; unsigned* code = (unsigned*)(a.ws + WS_CTL) + CW_CODE;
    for (int c = tid; c < DPLE; c += 256) ps[c] = a.in[I_P][(size_t)t * DPLE + c];
    __syncthreads();
    dense_row(ps, DPLE, a.in[I_W_PL_PROJ], DMODEL, DMODEL, os);
    __syncthreads();
    float d2 = 0.f, r2 = 0.f;
    for (int n = tid; n < DMODEL; n += 256) { const float e = os[n], v = bf2f(((const unsigned short*)(a.ws + WS_PLE))[(size_t)t * DMODEL + n]); d2 += (e - v) * (e - v); r2 += e * e; }
    d2 = block_sum(d2, red); r2 = block_sum(r2, red); verdict(code, 16, d2, r2, 2e-2f);
}
__global__ void __launch_bounds__(256) chk_final(Args a) {
    __shared__ float xs[DMODEL]; __shared__ float gs[DMODEL]; __shared__ float red[8];
    const int t = sample_token(blockIdx.x), tid = threadIdx.x; unsigned* code = (unsigned*)(a.ws + WS_CTL) + CW_CODE;
    const unsigned short* H = (const unsigned short*)(a.ws + WS_H2B) + (size_t)t * DMODEL;
    float s = 0.f; for (int c = tid; c < DMODEL; c += 256) { const float v = bf2f(H[c]); s += v * v; }
    const float rs = 1.0f / sqrtf(block_sum(s, red) / DMODEL + EPS);
    for (int c = tid; c < DMODEL; c += 256) xs[c] = bf2f(H[c]) * rs * a.in[I_LN_PL][c];
    __syncthreads();
    dense_row(xs, DMODEL, a.in[I_W_PL_GATE], DMODEL, DMODEL, gs);
    __syncthreads();
    float d2 = 0.f, r2 = 0.f;
    for (int n = tid; n < DMODEL; n += 256) { const float e = bf2f(H[n]) + bf2f(((const unsigned short*)(a.ws + WS_PLE))[(size_t)t * DMODEL + n]) / (1.f + expf(-gs[n])), v = a.out[(size_t)t * DMODEL + n]; d2 += (e - v) * (e - v); r2 += e * e; }
    d2 = block_sum(d2, red); r2 = block_sum(r2, red); verdict(code, 17, d2, r2, 1e-2f);
}

__global__ void finish(Args a, int complete) {
    const unsigned code = ((const unsigned*)(a.ws + WS_CTL))[CW_CODE];
    const float add = code ? 1000.f * (float)(1 + __builtin_ctz(code)) : 0.f;
    for (size_t i = (size_t)blockIdx.x * blockDim.x + threadIdx.x; i < (size_t)T * DMODEL; i += (size_t)gridDim.x * blockDim.x) a.out[i] = (complete ? a.out[i] : 0.f) + add;
}
}
#endif

extern "C" void kernel_launch(void* const* d_in, const int* in_sizes, int n_in, void* d_out, int out_size, void* d_ws, size_t ws_size, hipStream_t stream) {
    static int grid = 0;
    if (grid == 0) {
        if (n_in != 23 || in_sizes[0] != T * DMODEL || out_size != T * DMODEL || ws_size < WS_END) { fprintf(stderr, "kernel_launch: unexpected problem (n_in %d, in0 %d, out %d, ws %zu); nothing launched\n", n_in, n_in > 0 ? in_sizes[0] : -1, out_size, ws_size); grid = -1; return; }
        int dev = 0, cus = 0, per_cu = 0;
        if (hipGetDevice(&dev) != hipSuccess || hipDeviceGetAttribute(&cus, hipDeviceAttributeMultiprocessorCount, dev) != hipSuccess) { grid = -1; return; }
        if (hipFuncSetAttribute((const void*)mega_fwd, hipFuncAttributeMaxDynamicSharedMemorySize, LDS_BYTES) != hipSuccess) { fprintf(stderr, "kernel_launch: hipFuncSetAttribute failed\n"); grid = -1; return; }
        if (hipOccupancyMaxActiveBlocksPerMultiprocessor(&per_cu, (const void*)mega_fwd, NWAVES * 64, LDS_BYTES) != hipSuccess || per_cu < 1) { fprintf(stderr, "kernel_launch: occupancy query says %d\n", per_cu); per_cu = 1; }
        (void)hipGetLastError();
        grid = cus;
    }
    if (grid < 0) return;
    (void)hipMemsetAsync((char*)d_ws + WS_CTL, 0, CTL_ZERO_BYTES, stream);
    Args a{};
    for (int i = 0; i < 23; ++i) a.in[i] = (const float*)d_in[i];
    a.out = (float*)d_out; a.ws = (unsigned char*)d_ws;
    constexpr int LASTP = LAST_PHASE < N_PHASES - 1 ? LAST_PHASE : N_PHASES - 1;
#if MK_ONE_LAUNCH
    a.ph_lo = 0; a.ph_hi = LASTP + 1;
    void* kargs[] = {&a};
    hipError_t e = hipLaunchCooperativeKernel((const void*)mega_fwd, dim3(grid), dim3(NWAVES * 64), kargs, LDS_BYTES, stream);
    if (e != hipSuccess) fprintf(stderr, "kernel_launch: cooperative launch failed: %s (grid %d)\n", hipGetErrorString(e), grid);
#else
    for (int ph = 0; ph <= LASTP; ++ph) {
        a.ph_lo = ph; a.ph_hi = ph + 1;
        hipLaunchKernelGGL(mega_fwd, dim3(grid), dim3(NWAVES * 64), LDS_BYTES, stream, a);
#if SELFCHECK
        if (ph == 1) { hipLaunchKernelGGL(chk::chk_inproj, dim3(chk::NS), dim3(256), 0, stream, a); hipLaunchKernelGGL(chk::chk_scan, dim3(1), dim3(64), 0, stream, a); }
        if (ph == 2) { hipLaunchKernelGGL(chk::chk_attn, dim3(chk::NS), dim3(256), 0, stream, a); hipLaunchKernelGGL(chk::chk_conv, dim3(chk::NS), dim3(512), 0, stream, a); }
                if (ph == 3) hipLaunchKernelGGL(chk::chk_outproj, dim3(chk::NS), dim3(256), 0, stream, a);
        if (ph == 4) hipLaunchKernelGGL(chk::chk_peerq, dim3(chk::NS), dim3(256), 0, stream, a);
        if (ph == 5) hipLaunchKernelGGL(chk::chk_topk, dim3(chk::NS), dim3(256), 0, stream, a);
        if (ph == 6) hipLaunchKernelGGL(chk::chk_ple, dim3(chk::NS), dim3(256), 0, stream, a);
        if (ph == 7) hipLaunchKernelGGL(chk::chk_experts, dim3(chk::NS), dim3(256), 0, stream, a);
        if (ph == 8) hipLaunchKernelGGL(chk::chk_final, dim3(chk::NS), dim3(256), 0, stream, a);

#endif
    }
#endif
#if SELFCHECK
    hipLaunchKernelGGL(chk::finish, dim3(2048), dim3(256), 0, stream, a, (int)(LASTP == N_PHASES - 1));
#endif
}
```

```cpp
#include <hip/hip_runtime.h>
#include <hip/hip_bf16.h>
#include <cstdio>
#include <cstdint>
#include <cmath>

#define MK_ONE_LAUNCH 1
#define SELFCHECK 0
#ifndef LAST_PHASE
#define LAST_PHASE 99
#endif

#ifndef SLICE_BY_XCC
#define SLICE_BY_XCC 1
#endif
#ifndef ATTN_REPS
#define ATTN_REPS 1
#endif
#ifndef CONV_REPS
#define CONV_REPS 1
#endif
#ifndef PROBE_U
#define PROBE_U 0
#endif
#ifndef PROBE_U_MASK
#define PROBE_U_MASK 0xffffu
#endif
#ifndef REPEAT_MASK
#define REPEAT_MASK 0
#endif
#ifndef REPEAT_N
#define REPEAT_N 2
#endif
#ifndef PH_MASK
#define PH_MASK 0x3ff
#endif

constexpr int BATCH = 16, SEQ = 2048, DMODEL = 1024, T = BATCH * SEQ;
constexpr int DATT = 512, NH = 8, HD = 64, DCONV = 512, CW = 31;
constexpr int NIN = 2568, NINP = 2560;
constexpr int COL_F = 1536, COL_A = 1544, COL_G = 2056;
constexpr int NKEY = 128, NEXP = 16384, PH = 8, PQ = 256, PHALF = 128, PK = 16, NSEL = PH * PK;
constexpr int DPLE = 256;
constexpr float EPS = 1e-6f, LN_EPS = 1e-5f;
constexpr float LOG2E = 1.4426950408889634f;

namespace pg8 {
#define PG8_LAS __attribute__((address_space(3)))
typedef unsigned short bf16_t;
typedef short bf16x8 __attribute__((ext_vector_type(8)));
typedef float f32x4 __attribute__((ext_vector_type(4)));
typedef unsigned u32x4 __attribute__((ext_vector_type(4)));
constexpr int BM = 256, BK = 64, HALF = 128, HTB = HALF * BK * 2  , STAGE_BYTES = 8 * HTB, NXCD = 8, WGM = 8;

__host__ __device__ __forceinline__ int lds_byte(int r, int c) { const int st = (r >> 4) * 2 + (c >> 5), rr = r & 15, cc = c & 31, ob = rr * 64 + cc * 2; return st * 1024 + (ob ^ (((ob >> 9) & 1) << 5)); }
__host__ __device__ __forceinline__ void stage_rc(int b, int& R, int& C) { const int st = b / 1024, sb = b % 1024, swz = sb ^ (((sb >> 9) & 1) << 5); R = (st >> 1) * 16 + swz / 64; C = (st & 1) * 32 + (swz % 64) / 2; }
__host__ __device__ __forceinline__ int perm32(int rho) { const int n = rho >> 4, i = rho & 15; return 8 * (i >> 2) + 4 * n + (i & 3); }

struct Unit { int pm, pn; };
struct Gemm { const bf16_t* A; const bf16_t* Bt; int M, N, K; };

struct StaticOrder {
    int nM, nN, nwg, G, c;
    __host__ __device__ __forceinline__ void init(int M, int N, int G_, int c_) { nM = M / BM; nN = N / BM; nwg = nM * nN; G = G_; c = c_; }
    __host__ __device__ __forceinline__ bool next(int i, Unit& u) const {
        const long L = (long)i * G + c; if (L >= nwg) return false;
        int wgid = (int)L; { const int q = nwg / NXCD, r = nwg % NXCD, xcd = wgid % NXCD, off = wgid / NXCD; wgid = (xcd < r ? xcd * (q + 1) : r * (q + 1) + (xcd - r) * q) + off; }
        const int nig = WGM * nN, gid = wgid / nig, fm = gid * WGM, gsz = (nM - fm) < WGM ? (nM - fm) : WGM;
        u.pm = fm + ((wgid % nig) % gsz); u.pn = (wgid % nig) / gsz; return true;
    }
    __device__ __forceinline__ void a_ready(const Unit&) const {}
    __device__ __forceinline__ void done(const Unit&) const {}
};

template <class Epi, class Sched, bool ALIGN_EPI = false, bool SP2 = false>
__device__ __forceinline__ void gemm_phase(PG8_LAS unsigned char* lds, const Gemm g, const Sched& S, const Epi& E) {
    int tid_ = threadIdx.x; asm volatile("" : "+v"(tid_));
    const int tid = tid_, wid = __builtin_amdgcn_readfirstlane(tid >> 6), lane = tid & 63, wr = wid >> 2, wc = wid & 3, fr = lane & 15, fq = lane >> 4;
    const int K = g.K, nt = K / BK;
    unsigned voffA[2], voffB[2];
#pragma unroll
    for (int i = 0; i < 2; ++i) { int R, C; stage_rc(tid * 16 + i * 8192, R, C); const int Rb = Epi::PERM ? ((R & ~31) + perm32(R & 31)) : R;
        voffA[i] = (unsigned)(R * K + C) * 2u; voffB[i] = (unsigned)(Rb * K + C) * 2u; }
    const size_t kstep = (size_t)(BK * 2);
    const size_t hstep = (size_t)HALF * K * 2;
    const size_t tstep = 2 * hstep;
    const unsigned ldsw = (unsigned)wid * 1024u;
    const int aoff = lds_byte(wr * 64 + fr, fq * 8), boff = lds_byte(wc * 32 + fr, fq * 8);
#define PG8_SA(b, h) (((b) * 2 + (h)) * HTB)
#define PG8_SB(b, h) ((4 + (b) * 2 + (h)) * HTB)
#define PG8_STAGE(bufoff, gbase, voff) do { _Pragma("unroll") for (int _i = 0; _i < 2; ++_i) \
        __builtin_amdgcn_global_load_lds((const unsigned*)((const char*)(gbase) + (voff)[_i]), (PG8_LAS unsigned*)(lds + (bufoff) + ldsw + _i * 8192), 16, 0, 0); } while (0)
#define PG8_LDA(dst, b, h) do { _Pragma("unroll") for (int m = 0; m < 4; ++m) _Pragma("unroll") for (int k = 0; k < 2; ++k) dst[m][k] = *(const PG8_LAS bf16x8*)(lds + PG8_SA(b, h) + aoff + m * 2048 + k * 1024); } while (0)
#define PG8_LDB(dst, b, h) do { _Pragma("unroll") for (int n = 0; n < 2; ++n) _Pragma("unroll") for (int k = 0; k < 2; ++k) dst[n][k] = *(const PG8_LAS bf16x8*)(lds + PG8_SB(b, h) + boff + n * 2048 + k * 1024); } while (0)
#define PG8_MMA(ai, bj, At, Bt) do { __builtin_amdgcn_s_setprio(1); _Pragma("unroll") for (int m = 0; m < 4; ++m) _Pragma("unroll") for (int n = 0; n < 2; ++n) _Pragma("unroll") for (int k = 0; k < 2; ++k) \
        acc[ai][bj][m][n] = __builtin_amdgcn_mfma_f32_16x16x32_bf16(Bt[n][k], At[m][k], acc[ai][bj][m][n], 0, 0, 0); __builtin_amdgcn_s_setprio(0); } while (0)
#define PG8_WAIT_V(n) asm volatile("s_waitcnt vmcnt(" #n ")" ::: "memory")
#define PG8_WAIT_L(n) asm volatile("s_waitcnt lgkmcnt(" #n ")" ::: "memory")
#define PG8_BAR __builtin_amdgcn_s_barrier()
#define PG8_SCHED __builtin_amdgcn_sched_barrier(0)
    Unit cur, nxt; int ui = 0;
    if (!S.next(0, cur)) return;
    f32x4 acc[2][2][4][2];
#pragma unroll
    for (int a = 0; a < 2; ++a)
#pragma unroll
        for (int b = 0; b < 2; ++b)
#pragma unroll
            for (int m = 0; m < 4; ++m)
#pragma unroll
                for (int n = 0; n < 2; ++n) acc[a][b][m][n] = (f32x4){0.f, 0.f, 0.f, 0.f};
    bf16x8 At[4][2], B0[2][2], B1[2][2];
    const char* cA = (const char*)g.A + (size_t)cur.pm * tstep; const char* cB = (const char*)g.Bt + (size_t)cur.pn * tstep;
    S.a_ready(cur);
    if constexpr (SP2) {
        PG8_STAGE(PG8_SB(0, 0), cB, voffB); PG8_STAGE(PG8_SB(0, 1), cB + hstep, voffB); PG8_STAGE(PG8_SA(0, 0), cA, voffA); PG8_STAGE(PG8_SA(0, 1), cA + hstep, voffA);
        if (wr == 1) PG8_BAR;
        PG8_WAIT_V(2); PG8_BAR;
        PG8_STAGE(PG8_SB(1, 0), cB + kstep, voffB); PG8_STAGE(PG8_SA(1, 0), cA + kstep, voffA); PG8_STAGE(PG8_SB(1, 1), cB + hstep + kstep, voffB);
        PG8_WAIT_V(6); PG8_BAR;
    } else {
        PG8_STAGE(PG8_SB(0, 0), cB, voffB); PG8_STAGE(PG8_SA(0, 0), cA, voffA); PG8_STAGE(PG8_SB(0, 1), cB + hstep, voffB); PG8_STAGE(PG8_SA(0, 1), cA + hstep, voffA);
        if (wr == 1) PG8_BAR;
        PG8_WAIT_V(4); PG8_BAR;
        PG8_STAGE(PG8_SB(1, 0), cB + kstep, voffB); PG8_STAGE(PG8_SA(1, 0), cA + kstep, voffA); PG8_STAGE(PG8_SB(1, 1), cB + hstep + kstep, voffB);
        PG8_WAIT_V(6); PG8_BAR;
    }
    for (;;) {
        const bool has_next = S.next(ui + 1, nxt);
        const char* nA = has_next ? (const char*)g.A + (size_t)nxt.pm * tstep : cA; const char* nB = has_next ? (const char*)g.Bt + (size_t)nxt.pn * tstep : cB;
        for (int t = 0; t < nt; t += 2) {
            if constexpr (Epi::MIDK > 0) { if (t == Epi::MIDK) E.mid(acc, cur, ui, lds, wr, wc, fr, fq); }
            const bool last = (t == nt - 2);
            const char* a1 = cA + (size_t)(t + 1) * kstep;
            const char* a2 = last ? nA : cA + (size_t)(t + 2) * kstep; const char* b2 = last ? nB : cB + (size_t)(t + 2) * kstep;
            const char* a3 = a2 + kstep; const char* b3 = b2 + kstep;
            if (last && has_next) S.a_ready(nxt);
            if constexpr (SP2) {
            PG8_LDB(B0, 0, 0); PG8_LDB(B1, 0, 1); PG8_SCHED; PG8_LDA(At, 0, 0); PG8_STAGE(PG8_SA(1, 1), a1 + hstep, voffA);
            PG8_WAIT_V(8); PG8_WAIT_L(0); PG8_BAR; PG8_MMA(0, 0, At, B0); PG8_MMA(0, 1, At, B1); PG8_BAR; PG8_SCHED;
            PG8_LDA(At, 0, 1); PG8_STAGE(PG8_SB(0, 0), b2, voffB); PG8_STAGE(PG8_SB(0, 1), b2 + hstep, voffB); PG8_STAGE(PG8_SA(0, 0), a2, voffA);
            PG8_WAIT_V(8); PG8_WAIT_L(0); PG8_BAR; PG8_MMA(1, 0, At, B0); PG8_MMA(1, 1, At, B1); PG8_BAR; PG8_SCHED;
            PG8_LDB(B0, 1, 0); PG8_LDB(B1, 1, 1); PG8_SCHED; PG8_LDA(At, 1, 0); PG8_STAGE(PG8_SA(0, 1), a2 + hstep, voffA);
            PG8_WAIT_V(8); PG8_WAIT_L(0); PG8_BAR; PG8_MMA(0, 0, At, B0); PG8_MMA(0, 1, At, B1); PG8_BAR; PG8_SCHED;
            PG8_LDA(At, 1, 1); PG8_STAGE(PG8_SB(1, 0), b3, voffB); PG8_STAGE(PG8_SB(1, 1), b3 + hstep, voffB); PG8_STAGE(PG8_SA(1, 0), a3, voffA);
            PG8_WAIT_V(8); PG8_WAIT_L(0); PG8_BAR; PG8_MMA(1, 0, At, B0); PG8_MMA(1, 1, At, B1); PG8_BAR; PG8_SCHED;
            } else {
            PG8_LDB(B0, 0, 0); PG8_SCHED; PG8_LDA(At, 0, 0); PG8_STAGE(PG8_SA(1, 1), a1 + hstep, voffA);
            PG8_WAIT_L(8); PG8_BAR; PG8_WAIT_L(0); PG8_MMA(0, 0, At, B0); PG8_BAR; PG8_SCHED;
            PG8_LDB(B1, 0, 1); PG8_STAGE(PG8_SB(0, 0), b2, voffB);
            PG8_BAR; PG8_WAIT_L(0); PG8_MMA(0, 1, At, B1); PG8_BAR;
            PG8_LDA(At, 0, 1); PG8_STAGE(PG8_SA(0, 0), a2, voffA);
            PG8_BAR; PG8_WAIT_L(0); PG8_MMA(1, 0, At, B0); PG8_BAR; PG8_SCHED;
            PG8_STAGE(PG8_SB(0, 1), b2 + hstep, voffB);
            PG8_WAIT_V(6); PG8_BAR; PG8_MMA(1, 1, At, B1); PG8_BAR;
            PG8_LDB(B0, 1, 0); PG8_SCHED; PG8_LDA(At, 1, 0); PG8_STAGE(PG8_SA(0, 1), a2 + hstep, voffA);
            PG8_WAIT_L(8); PG8_BAR; PG8_WAIT_L(0); PG8_MMA(0, 0, At, B0); PG8_BAR; PG8_SCHED;
            PG8_LDB(B1, 1, 1); PG8_STAGE(PG8_SB(1, 0), b3, voffB);
            PG8_BAR; PG8_WAIT_L(0); PG8_MMA(0, 1, At, B1); PG8_BAR;
            PG8_LDA(At, 1, 1); PG8_STAGE(PG8_SA(1, 0), a3, voffA);
            PG8_BAR; PG8_WAIT_L(0); PG8_MMA(1, 0, At, B0); PG8_BAR; PG8_SCHED;
            PG8_STAGE(PG8_SB(1, 1), b3 + hstep, voffB);
            PG8_WAIT_V(6); PG8_BAR; PG8_MMA(1, 1, At, B1); PG8_BAR;
            }
        }
        if constexpr (ALIGN_EPI) { if (wr == 0) PG8_BAR; }
        if constexpr (!Epi::AFTER_DRAIN) { E(acc, cur, ui, lds, wr, wc, fr, fq); S.done(cur); }
        if (!has_next) break;
#pragma unroll
        for (int a = 0; a < 2; ++a)
#pragma unroll
            for (int b = 0; b < 2; ++b)
#pragma unroll
                for (int m = 0; m < 4; ++m)
#pragma unroll
                    for (int n = 0; n < 2; ++n) acc[a][b][m][n] = (f32x4){0.f, 0.f, 0.f, 0.f};
        cur = nxt; cA = nA; cB = nB; ++ui;
        if constexpr (ALIGN_EPI) { if (wr == 1) PG8_BAR; }
    }
    PG8_WAIT_V(0);
    if constexpr (!ALIGN_EPI) { if (wr == 0) PG8_BAR; }
    PG8_BAR;
    if constexpr (Epi::AFTER_DRAIN) { E.fused(acc, cur, wr, wc, fr, fq, lds, wid, lane); S.done(cur); }
#undef PG8_SA
#undef PG8_SB
#undef PG8_STAGE
#undef PG8_LDA
#undef PG8_LDB
#undef PG8_MMA
#undef PG8_WAIT_V
#undef PG8_WAIT_L
#undef PG8_BAR
#undef PG8_SCHED
}
}
namespace pg8 {
typedef float f32x2_t __attribute__((ext_vector_type(2))); typedef __bf16 bf16x2_t __attribute__((ext_vector_type(2)));
__device__ __forceinline__ unsigned cvt_pk_bf16(float lo, float hi) { f32x2_t v = {lo, hi}; bf16x2_t b = __builtin_convertvector(v, bf16x2_t); return __builtin_bit_cast(unsigned, b); }
__device__ __forceinline__ u32x4 pack8(const f32x4 a, const f32x4 b) { u32x4 w; w.x = cvt_pk_bf16(a[0], a[1]); w.y = cvt_pk_bf16(a[2], a[3]); w.z = cvt_pk_bf16(b[0], b[1]); w.w = cvt_pk_bf16(b[2], b[3]); return w; }
__device__ __forceinline__ float bf_lo(unsigned w) { return __uint_as_float(w << 16); }
__device__ __forceinline__ float bf_hi(unsigned w) { return __uint_as_float(w & 0xffff0000u); }
__device__ __forceinline__ float sigmoidf_fast(float v) { return __builtin_amdgcn_rcpf(1.0f + __builtin_amdgcn_exp2f(-v * 1.4426950408889634f)); }
constexpr float ATT_C2 = 0.125f * 1.4426950408889634f;

struct EpiInProj {
    static constexpr bool PERM = true, AFTER_DRAIN = false; static constexpr int MIDK = 0;
    bf16_t* QKV; bf16_t* U; int tab_off; const float* qn; const float* kn;
    __device__ __forceinline__ void mid(f32x4 (&)[2][2][4][2], const Unit&, int, PG8_LAS unsigned char*, int, int, int, int) const {}
    __device__ __forceinline__ void operator()(const f32x4 (&acc)[2][2][4][2], const Unit& u, int ui, PG8_LAS unsigned char* lds, int wr, int wc, int fr, int fq) const {
        const int row0 = u.pm * BM + wr * 64 + fr; const PG8_LAS float* tab = (const PG8_LAS float*)(lds + tab_off) + ui * BM + wr * 64 + fr;
        if (u.pn < 6) {
            const int kind = u.pn >> 1, head = 4 * (u.pn & 1) + wc;
            f32x4 gs[2][2];
#pragma unroll
            for (int bj = 0; bj < 2; ++bj)
#pragma unroll
                for (int n = 0; n < 2; ++n) { const int d = 32 * bj + 8 * fq + 4 * n;
                    gs[bj][n] = kind == 0 ? *(const f32x4*)(qn + d) * ATT_C2 : (kind == 1 ? *(const f32x4*)(kn + d) : (f32x4){1.f, 1.f, 1.f, 1.f}); }
            bf16_t* base = QKV + kind * 512 + head * 64 + 8 * fq;
#pragma unroll
            for (int ai = 0; ai < 2; ++ai)
#pragma unroll
                for (int m = 0; m < 4; ++m) { const int row = row0 + ai * HALF + m * 16; const float rs = tab[ai * HALF + m * 16];
                    f32x4 z[2][2]; float ss = 0.f;
#pragma unroll
                    for (int bj = 0; bj < 2; ++bj)
#pragma unroll
                        for (int n = 0; n < 2; ++n) { z[bj][n] = acc[ai][bj][m][n] * rs; const f32x4 q = z[bj][n] * z[bj][n]; ss += (q[0] + q[1]) + (q[2] + q[3]); }
                    float inv = 1.f;
                    if (kind < 2) { ss += __shfl_xor(ss, 16); ss += __shfl_xor(ss, 32); inv = 1.0f / sqrtf(ss * (1.0f / 64.0f) + 1e-6f); }
#pragma unroll
                    for (int bj = 0; bj < 2; ++bj) *(u32x4*)(base + (size_t)row * 1536 + 32 * bj) = pack8(z[bj][0] * inv * gs[bj][0], z[bj][1] * inv * gs[bj][1]); }
        } else {
            bf16_t* base = U + 128 * (u.pn - 6) + 32 * wc + 8 * fq;
#pragma unroll
            for (int ai = 0; ai < 2; ++ai)
#pragma unroll
                for (int m = 0; m < 4; ++m) { const int row = row0 + ai * HALF + m * 16; const float rs = tab[ai * HALF + m * 16];
                    f32x4 uu[2];
#pragma unroll
                    for (int n = 0; n < 2; ++n) { const f32x4 a = acc[ai][0][m][n] * rs, g = acc[ai][1][m][n] * rs;
                        uu[n] = (f32x4){a[0] * sigmoidf_fast(g[0]), a[1] * sigmoidf_fast(g[1]), a[2] * sigmoidf_fast(g[2]), a[3] * sigmoidf_fast(g[3])}; }
                    *(u32x4*)(base + (size_t)row * 512) = pack8(uu[0], uu[1]); }
        }
    }
};

struct EpiOutProj {
    static constexpr bool PERM = true, AFTER_DRAIN = false; static constexpr int MIDK = 8;
    const float* x; bf16_t* H1B; float* SS1P; const float* SSA; unsigned char* H1Q;
    int rsa_off;
    __device__ __forceinline__ void mid(f32x4 (&acc)[2][2][4][2], const Unit& u, int ui, PG8_LAS unsigned char* lds, int wr, int wc, int fr, int fq) const {
        const PG8_LAS float* tab = (const PG8_LAS float*)(lds + rsa_off) + ui * BM + wr * 64 + fr;
#pragma unroll
        for (int ai = 0; ai < 2; ++ai)
#pragma unroll
            for (int m = 0; m < 4; ++m) { const float rsa = tab[ai * HALF + m * 16];
#pragma unroll
                for (int bj = 0; bj < 2; ++bj)
#pragma unroll
                    for (int n = 0; n < 2; ++n) acc[ai][bj][m][n] *= rsa; }
    }
    __device__ __forceinline__ void operator()(const f32x4 (&acc)[2][2][4][2], const Unit& u, int ui, PG8_LAS unsigned char* lds, int wr, int wc, int fr, int fq) const {
        const int row0 = u.pm * BM + wr * 64 + fr, col0 = u.pn * BM + wc * 32 + 8 * fq;
#pragma unroll
        for (int ai = 0; ai < 2; ++ai) {
            f32x4 xv[4][2][2];
#pragma unroll
            for (int m = 0; m < 4; ++m)
#pragma unroll
                for (int bj = 0; bj < 2; ++bj) { const size_t off = (size_t)(row0 + ai * HALF + m * 16) * 1024 + col0 + bj * HALF; xv[m][bj][0] = *(const f32x4*)(x + off); xv[m][bj][1] = *(const f32x4*)(x + off + 4); }
#pragma unroll
            for (int m = 0; m < 4; ++m) { const int row = row0 + ai * HALF + m * 16; float ss = 0.f;
#pragma unroll
                for (int bj = 0; bj < 2; ++bj) { const size_t off = (size_t)row * 1024 + col0 + bj * HALF;
                    const f32x4 h0 = xv[m][bj][0] + acc[ai][bj][m][0], h1 = xv[m][bj][1] + acc[ai][bj][m][1];
                    ss += (h0[0] * h0[0] + h0[1] * h0[1]) + (h0[2] * h0[2] + h0[3] * h0[3]) + (h1[0] * h1[0] + h1[1] * h1[1]) + (h1[2] * h1[2] + h1[3] * h1[3]);
                    *(u32x4*)(H1B + off) = pack8(h0, h1);
                    { const f32x4 g0 = h0 * 14.0f, g1 = h1 * 14.0f;
#define Q8(v) ((unsigned)((int)__builtin_rintf(__builtin_amdgcn_fmed3f((v), -127.0f, 127.0f)) & 0xff))
                      const unsigned ev = Q8(g0[0]) | (Q8(g0[2]) << 8) | (Q8(g1[0]) << 16) | (Q8(g1[2]) << 24), od = Q8(g0[1]) | (Q8(g0[3]) << 8) | (Q8(g1[1]) << 16) | (Q8(g1[3]) << 24);
#undef Q8
                      *(unsigned long long*)(H1Q + off) = (unsigned long long)ev | ((unsigned long long)od << 32); } }
                ss += __shfl_xor(ss, 16); ss += __shfl_xor(ss, 32);
                if (fq == 0) SS1P[(size_t)row * 16 + u.pn * 4 + wc] = ss; }
        }
    }
};

__host__ __device__ __forceinline__ size_t qpf_byte(int row, int head, int half, int ks, int hi) { return ((((size_t)(row >> 5) * 8 + head) * 2 + half) * 8 + ks) * 1024 + (size_t)(hi * 32 + (row & 31)) * 16; }
struct EpiRowScale {
    static constexpr bool PERM = true, AFTER_DRAIN = false; static constexpr int MIDK = 0;
    bf16_t* O; int ldc; int tab_off;
    __device__ __forceinline__ void mid(f32x4 (&)[2][2][4][2], const Unit&, int, PG8_LAS unsigned char*, int, int, int, int) const {}
    __device__ __forceinline__ void operator()(const f32x4 (&acc)[2][2][4][2], const Unit& u, int ui, PG8_LAS unsigned char* lds, int wr, int wc, int fr, int fq) const {
        const int row0 = u.pm * BM + wr * 64 + fr, col0 = u.pn * BM + wc * 32 + 8 * fq; const PG8_LAS float* tab = (const PG8_LAS float*)(lds + (tab_off < 0 ? 0 : tab_off)) + ui * BM + wr * 64 + fr;
#pragma unroll
        for (int ai = 0; ai < 2; ++ai)
#pragma unroll
            for (int m = 0; m < 4; ++m) { const int row = row0 + ai * HALF + m * 16; const float rs = tab_off < 0 ? 1.0f : tab[ai * HALF + m * 16];
#pragma unroll
                for (int bj = 0; bj < 2; ++bj) { const u32x4 w = pack8(acc[ai][bj][m][0] * rs, acc[ai][bj][m][1] * rs);
                    if (ldc > 0) *(u32x4*)(O + (size_t)row * ldc + col0 + bj * HALF) = w;
                    else *(u32x4*)((unsigned char*)O + qpf_byte(row, u.pn, bj, 2 * wc + (fq >> 1), fq & 1)) = w; } }
    }
};

struct EpiFinal {
    static constexpr bool PERM = true, AFTER_DRAIN = false; static constexpr int MIDK = 0;
    const bf16_t* H2B; const bf16_t* PLE; int tab_off; float* out;
    __device__ __forceinline__ void mid(f32x4 (&)[2][2][4][2], const Unit&, int, PG8_LAS unsigned char*, int, int, int, int) const {}
    __device__ __forceinline__ void operator()(const f32x4 (&acc)[2][2][4][2], const Unit& u, int ui, PG8_LAS unsigned char* lds, int wr, int wc, int fr, int fq) const {
        const int row0 = u.pm * BM + wr * 64 + fr, col0 = u.pn * BM + wc * 32 + 8 * fq; const PG8_LAS float* tab = (const PG8_LAS float*)(lds + tab_off) + ui * BM + wr * 64 + fr;
#pragma unroll
        for (int ai = 0; ai < 2; ++ai) {
            u32x4 hh[4][2], pp[4][2];
#pragma unroll
            for (int m = 0; m < 4; ++m)
#pragma unroll
                for (int bj = 0; bj < 2; ++bj) { const size_t off = (size_t)(row0 + ai * HALF + m * 16) * 1024 + col0 + bj * HALF; hh[m][bj] = *(const u32x4*)(H2B + off); pp[m][bj] = *(const u32x4*)(PLE + off); }
#pragma unroll
            for (int m = 0; m < 4; ++m) { const int row = row0 + ai * HALF + m * 16; const float rs = tab[ai * HALF + m * 16];
#pragma unroll
                for (int bj = 0; bj < 2; ++bj) { const size_t off = (size_t)row * 1024 + col0 + bj * HALF;
                    const u32x4 h = hh[m][bj], p = pp[m][bj];
                    const f32x4 a0 = acc[ai][bj][m][0] * rs, a1 = acc[ai][bj][m][1] * rs;
                    f32x4 o0, o1;
                    o0[0] = bf_lo(h.x) + sigmoidf_fast(a0[0]) * bf_lo(p.x); o0[1] = bf_hi(h.x) + sigmoidf_fast(a0[1]) * bf_hi(p.x);
                    o0[2] = bf_lo(h.y) + sigmoidf_fast(a0[2]) * bf_lo(p.y); o0[3] = bf_hi(h.y) + sigmoidf_fast(a0[3]) * bf_hi(p.y);
                    o1[0] = bf_lo(h.z) + sigmoidf_fast(a1[0]) * bf_lo(p.z); o1[1] = bf_hi(h.z) + sigmoidf_fast(a1[1]) * bf_hi(p.z);
                    o1[2] = bf_lo(h.w) + sigmoidf_fast(a1[2]) * bf_lo(p.w); o1[3] = bf_hi(h.w) + sigmoidf_fast(a1[3]) * bf_hi(p.w);
                    *(f32x4*)(out + off) = o0; *(f32x4*)(out + off + 4) = o1; } }
        }
    }
};
}

#include <hip/hip_bf16.h>
namespace attn_body {
using bf16=__hip_bfloat16;
using bf16x8=__attribute__((ext_vector_type(8)))short;
using s16x4=__attribute__((ext_vector_type(4)))short;
using f32x16=__attribute__((ext_vector_type(16)))float;
using u32x4=__attribute__((ext_vector_type(4)))unsigned;
typedef float f32x4_t __attribute__((ext_vector_type(4)));
constexpr int BATCH=16,NHEAD=8,SEQ=2048,D=64,DMI=1536,DMO=1024;
constexpr int NW=8,QBLK=32,QB=QBLK*NW,KVBLK=64,NQB=SEQ/QB;
constexpr int ATTN_UNIT_ROWS=QB;
__device__ __forceinline__ int crow(int r,int hi){return (r&3)+8*(r>>2)+4*hi;}
#define SBAR() __builtin_amdgcn_sched_barrier(0)
__device__ __forceinline__ void cmask(f32x16&p0,f32x16&p1,int jb,int qrel,int hi){
  const float NEG=-INFINITY; int kb=64*jb+4*hi;
  #pragma unroll
  for(int r=0;r<16;++r){int kv=kb+(r&3)+8*(r>>2); if(kv>qrel)p0[r]=NEG; if(kv+32>qrel)p1[r]=NEG;}
}

constexpr int NSLOT=3, SLOTB=8192;
constexpr int LDS_K=0, LDS_V=NSLOT*SLOTB, LDS_WS=2*NSLOT*SLOTB, LDS_OST=LDS_WS+NW*64*4, LDS_GB=LDS_OST+NW*4096, LDS_BYTES=LDS_GB+SEQ*4;
constexpr float SKIP_THR=-100.0f;
constexpr float C2=0.125f*1.4426950408889634f;
__device__ __forceinline__ void glds16(const void*gsrc,unsigned lds_dst){unsigned keep;
  asm volatile("s_mov_b32 %0, m0\n\ts_mov_b32 m0, %2\n\ts_nop 0\n\tglobal_load_lds_dwordx4 %1, off\n\ts_mov_b32 m0, %0":"=&s"(keep):"v"(gsrc),"s"(lds_dst):"memory");}
__device__ __forceinline__ float max3f(float a,float b,float c){float r;asm("v_max3_f32 %0, %1, %2, %3":"=v"(r):"v"(a),"v"(b),"v"(c));return r;}
__device__ __forceinline__ float max2f(float a,float b){float r;asm("v_max_f32_e32 %0, %1, %2":"=v"(r):"v"(a),"v"(b));return r;}
__device__ __forceinline__ float fadd_s(float a,float b){float r;asm("v_add_f32_e32 %0, %1, %2":"=v"(r):"v"(a),"v"(b));return r;}
__device__ __forceinline__ float fsub_s(float a,float b){float r;asm("v_sub_f32_e32 %0, %1, %2":"=v"(r):"v"(a),"v"(b));return r;}
typedef float f32x2_t __attribute__((ext_vector_type(2))); typedef __bf16 bf16x2_t __attribute__((ext_vector_type(2)));
__device__ __forceinline__ unsigned cvtpk_s(float lo,float hi){f32x2_t v={lo,hi};bf16x2_t b=__builtin_convertvector(v,bf16x2_t);return __builtin_bit_cast(unsigned,b);}
#define WAIT_BAR(N) asm volatile("s_waitcnt vmcnt(" #N ") lgkmcnt(0)\n\ts_barrier":::"memory")

__device__ __forceinline__ void qkt(f32x16&p0,f32x16&p1,const char*Kslot,const bf16x8*qr,const f32x16&c0,const f32x16&c1,int r32,int hi){
  const char*kb=Kslot+hi*1024+r32*16;
  #pragma unroll
  for(int d0=0;d0<4;++d0){
    const bf16x8 b0=*reinterpret_cast<const bf16x8*>(kb+d0*2048);
    const bf16x8 b1=*reinterpret_cast<const bf16x8*>(kb+d0*2048+512);
    if(d0==0){p0=__builtin_amdgcn_mfma_f32_32x32x16_bf16(b0,qr[0],c0,0,0,0);p1=__builtin_amdgcn_mfma_f32_32x32x16_bf16(b1,qr[0],c1,0,0,0);}
    else{p0=__builtin_amdgcn_mfma_f32_32x32x16_bf16(b0,qr[d0],p0,0,0,0);p1=__builtin_amdgcn_mfma_f32_32x32x16_bf16(b1,qr[d0],p1,0,0,0);}}
}
typedef __attribute__((address_space(3))) const char* lds_cptr;
typedef short v4i16_t __attribute__((ext_vector_type(4)));
__device__ __forceinline__ void kload8(bf16x8*kf,lds_cptr kp){
  kf[0]=*(const __attribute__((address_space(3))) bf16x8*)(kp);      kf[1]=*(const __attribute__((address_space(3))) bf16x8*)(kp+512);
  kf[2]=*(const __attribute__((address_space(3))) bf16x8*)(kp+2048); kf[3]=*(const __attribute__((address_space(3))) bf16x8*)(kp+2560);
  kf[4]=*(const __attribute__((address_space(3))) bf16x8*)(kp+4096); kf[5]=*(const __attribute__((address_space(3))) bf16x8*)(kp+4608);
  kf[6]=*(const __attribute__((address_space(3))) bf16x8*)(kp+6144); kf[7]=*(const __attribute__((address_space(3))) bf16x8*)(kp+6656);
}
__device__ __forceinline__ void kload2(bf16x8*kf,lds_cptr kp,int j){ kf[2*j]=*(const __attribute__((address_space(3))) bf16x8*)(kp+j*2048); kf[2*j+1]=*(const __attribute__((address_space(3))) bf16x8*)(kp+j*2048+512); }
__device__ __forceinline__ s16x4 vtr(lds_cptr p){ return __builtin_bit_cast(s16x4,__builtin_amdgcn_ds_read_tr16_b64_v4i16((__attribute__((address_space(3))) v4i16_t*)p)); }
__device__ __forceinline__ float rowmax(const f32x16&p0,const f32x16&p1){
  float a=max3f(p0[0],p0[1],p1[0]),b=max3f(p0[2],p0[3],p1[1]);a=max3f(a,p1[2],p1[3]);
  #pragma unroll
  for(int r=4;r<16;r+=4){a=max3f(a,p0[r],p0[r+1]);b=max3f(b,p0[r+2],p0[r+3]);a=max3f(a,p1[r],p1[r+1]);b=max3f(b,p1[r+2],p1[r+3]);}
  const float m=max2f(a,b);
  auto rr=__builtin_amdgcn_permlane32_swap(__float_as_uint(m),__float_as_uint(m),false,false);
  return max2f(__uint_as_float(rr[0]),__uint_as_float(rr[1]));
}
__device__ __forceinline__ void pv(f32x16*o,int vb,bf16x8 pa0,bf16x8 pa1,bf16x8 pa2,bf16x8 pa3){
  #pragma unroll
  for(int d0=0;d0<2;++d0){s16x4 lo[4],hi[4];
    #pragma unroll
    for(int ks=0;ks<4;++ks){
      asm volatile("ds_read_b64_tr_b16 %0,%1 offset:%c2":"=&v"(lo[ks]):"v"(vb),"i"(d0*4096+ks*1024):"memory");
      asm volatile("ds_read_b64_tr_b16 %0,%1 offset:%c2":"=&v"(hi[ks]):"v"(vb),"i"(d0*4096+ks*1024+512):"memory");}
    asm volatile("s_waitcnt lgkmcnt(0)":::"memory");SBAR();
    #define PK(k) (bf16x8){lo[k][0],lo[k][1],lo[k][2],lo[k][3],hi[k][0],hi[k][1],hi[k][2],hi[k][3]}
    o[d0]=__builtin_amdgcn_mfma_f32_32x32x16_bf16(pa0,PK(0),o[d0],0,0,0);
    o[d0]=__builtin_amdgcn_mfma_f32_32x32x16_bf16(pa1,PK(1),o[d0],0,0,0);
    o[d0]=__builtin_amdgcn_mfma_f32_32x32x16_bf16(pa2,PK(2),o[d0],0,0,0);
    o[d0]=__builtin_amdgcn_mfma_f32_32x32x16_bf16(pa3,PK(3),o[d0],0,0,0);
    #undef PK
  }
}

#ifndef ATTN_STORE16
#define ATTN_STORE16(p,v) (*(u32x4*)(p)=(v))
#endif
template<int THRL> __device__ __forceinline__ void attn_unit(int b,int h,int qb,const bf16*Q,const bf16*__restrict__ K,const bf16*__restrict__ V,bf16*O,const float*Gf,float*SSA,char*shm){
  int tid_=threadIdx.x; asm volatile("":"+v"(tid_)); const int tid=tid_,lane=tid&63,r32=lane&31,hi=lane>>5; const int wid=__builtin_amdgcn_readfirstlane(tid>>6);
  const long rowbase=(long)b*SEQ; const int q0=qb*QB;
  const float*Gbh=Gf+((long)b*NHEAD+h)*SEQ; const float g0=Gbh[q0];
  float gv_[4];
  _Pragma("unroll") for(int k_=0;k_<4;++k_){const int s_=tid+k_*NW*64; gv_[k_]=Gbh[s_<q0+QB?s_:q0];}
  int ts; { const int ntf=(q0+QB)/KVBLK, j_=2*lane; const bool dead_=(j_+6<=ntf) && (g0-Gbh[(j_+6<=ntf)?64*(j_+1)+63:0]<SKIP_THR);
    ts=2*__builtin_popcountll(__ballot(dead_)); ts=__builtin_amdgcn_readfirstlane(ts); }
  const bf16*Qw=Q+(rowbase+q0+wid*QBLK)*DMI+h*D;
  const bf16*Kh=K+(rowbase+64*ts)*DMI+h*D,*Vh=V+(rowbase+64*ts)*DMI+h*D;
  typedef __attribute__((address_space(3))) char* lds_wptr; const lds_wptr shm3w=(lds_wptr)shm;
  const unsigned lds0=(unsigned)(uintptr_t)shm;
  float*wsf=(float*)(shm+LDS_WS)+wid*64;
  const bf16*ksrc=Kh+(long)lane*DMI+wid*8;
  const bf16*vsrc=Vh+(long)(16*(wid&3)+(lane>>2))*DMI+(wid>>2)*32+(lane&3)*8;
  const unsigned kdst=lds0+LDS_K+wid*1024, vdst=lds0+LDS_V+wid*1024;
  #define DMA_K(t,slot) glds16(ksrc+(long)(t)*KVBLK*DMI,(unsigned)__builtin_amdgcn_readfirstlane(kdst+(slot)))
  #define DMA_V(t,slot) glds16(vsrc+(long)(t)*KVBLK*DMI,(unsigned)__builtin_amdgcn_readfirstlane(vdst+(slot)))
  const int vb0=(int)(lds0+LDS_V)+((lane>>4)&1)*32+(lane&3)*8+(4*hi+((lane&15)>>2))*64;
  const char*Kbase=shm+LDS_K; bf16x8 kf[8];
  const lds_cptr shm3=(lds_cptr)shm; const lds_cptr kp0=shm3+LDS_K+hi*1024+r32*16; const lds_cptr vp0=shm3+LDS_V+((lane>>4)&1)*32+(lane&3)*8+(4*hi+((lane&15)>>2))*64;
  const int NT=(q0+QB)/KVBLK-ts;
  DMA_K(0,0);DMA_V(0,0);DMA_K(1,SLOTB);
  { __attribute__((address_space(3))) float*gbw=(__attribute__((address_space(3))) float*)(shm3w+LDS_GB);
    _Pragma("unroll") for(int k_=0;k_<4;++k_){const int s_=tid+k_*NW*64; if(s_<q0+QB)gbw[s_]=g0-gv_[k_];} }
  bf16x8 qr[4];
  #pragma unroll
  for(int d0=0;d0<4;++d0)qr[d0]=*reinterpret_cast<const bf16x8*>(&Qw[(long)r32*DMI+d0*16+hi*8]);
  float mhat=0.f,l_reg=0.f;f32x16 o[2];o[0]=f32x16{};o[1]=f32x16{};float nm=0.f; const f32x16 zero16=f32x16{};
  const __attribute__((address_space(3))) char*gbp0=(const __attribute__((address_space(3))) char*)(shm3w+LDS_GB)+hi*16+ts*256;
  #define CBIAS(CA,CB,t) do{ const __attribute__((address_space(3))) char*gp_=gbp0+(t)*256; _Pragma("unroll") for(int g_=0;g_<4;++g_){ \
      const f32x4_t a_=*(const __attribute__((address_space(3))) f32x4_t*)(gp_+g_*32), b_=*(const __attribute__((address_space(3))) f32x4_t*)(gp_+128+g_*32); \
      _Pragma("unroll") for(int j_=0;j_<4;++j_){ CA[4*g_+j_]+=a_[j_]+nm; CB[4*g_+j_]+=b_[j_]+nm; } } }while(0)
  const int qrel=wid*QBLK+r32;
  #define CMASK(P0,P1,t) do{int jb_=(t)-(NT-4); if(jb_>=0){int hm_=hi,qm_=qrel; asm volatile("":"+v"(hm_),"+v"(qm_)); cmask(P0,P1,jb_,qm_,hm_);}}while(0)
  bool resc=false;
  #define START(P0,P1) do{ const float rm=rowmax(P0,P1); resc=false; \
    { const float dl=rm; mhat=fadd_s(mhat,dl); \
      _Pragma("unroll") for(int r=0;r<16;++r){P0[r]=fsub_s(P0[r],dl);P1[r]=fsub_s(P1[r],dl);} \
      nm=-mhat; } \
    _Pragma("unroll") for(int r=0;r<16;++r)P0[r]=__builtin_amdgcn_exp2f(P0[r]); }while(0)
  #define RESC() do{ if(resc){ asm volatile("s_waitcnt lgkmcnt(0)":::"memory"); \
      _Pragma("unroll") for(int d_=0;d_<2;++d_) _Pragma("unroll") for(int r=0;r<16;++r)o[d_][r]*=wsf[crow(r,hi)]; } }while(0)
  f32x16 pA0,pA1,pB0,pB1;
  int sl_prev=0,sl_cur=0,sl_next=SLOTB;
  #define ROT() do{sl_prev=sl_cur;sl_cur=sl_next;sl_next=(sl_next==(NSLOT-1)*SLOTB)?0:sl_next+SLOTB;}while(0)
  DMA_K(2,2*SLOTB);
  WAIT_BAR(3);
  qkt(pA0,pA1,Kbase,qr,zero16,zero16,r32,hi);asm volatile("s_nop 15\n\ts_nop 7":"+v"(pA0),"+v"(pA1));CBIAS(pA0,pA1,0);CMASK(pA0,pA1,0);
  START(pA0,pA1);
  _Pragma("unroll") for(int r=0;r<16;++r)pA1[r]=__builtin_amdgcn_exp2f(pA1[r]);
  WAIT_BAR(0);
  DMA_K(3,0);DMA_V(1,SLOTB);
  ROT();
  kload8(kf,kp0+sl_cur);
  WAIT_BAR(2);
  s16x4 vlo[8],vhi[8]; u32x4 pw0,pw1,pw2,pw3;
  #define PKW(P,B) cvtpk_s(P[B],P[B+1])
  #define PAF(k) __builtin_bit_cast(bf16x8,pw##k)
  #define VFR(i) (bf16x8){vlo[i][0],vlo[i][1],vlo[i][2],vlo[i][3],vhi[i][0],vhi[i][1],vhi[i][2],vhi[i][3]}
  #define PIN(x) asm volatile("":"+v"(x))
  #define MX3(a,b,c) __builtin_fmaxf(__builtin_fmaxf((a),(b)),(c))
  #define GAPA(MF,A0,A1,A2,A3,W0,W1,PW) do{ MF; sacc+=A0; sacc+=A1; sacc+=A2; sacc+=A3; PIN(sacc); W0; W1; PIN(PW); SBAR(); }while(0)
  #define EX(v) __builtin_amdgcn_exp2f(v)
  #define GAPB(MF,X,B) do{ MF; X[B]=EX(X[B]); X[B+1]=EX(X[B+1]); X[B+2]=EX(X[B+2]); X[B+3]=EX(X[B+3]); PIN(X); SBAR(); }while(0)
  #define VRD(i) do{ vlo[i]=vtr(vp_+(((i)>>2)*4096+((i)&3)*1024)); vhi[i]=vtr(vp_+(((i)>>2)*4096+((i)&3)*1024+512)); }while(0)
  #define KRD(G,j) do{ if(G){ kload2(kf,kp0+sl_next,j); SBAR(); } }while(0)
  #define STEP(C0,C1,P0,P1,t,GK,GV,GL) do{ SBAR(); \
    const lds_cptr vp_=vp0+sl_prev; \
    VRD(0); SBAR(); float sacc=(P0[0]+P0[1]); \
    GAPA(C0=__builtin_amdgcn_mfma_f32_32x32x16_bf16(kf[0],qr[0],zero16,0,0,0), P0[2],P0[3],P0[4],P0[5],     pw0[0]=PKW(P0,0), pw0[1]=PKW(P0,2), pw0); \
    VRD(4); SBAR(); GAPA(C1=__builtin_amdgcn_mfma_f32_32x32x16_bf16(kf[1],qr[0],zero16,0,0,0), P0[6],P0[7],P0[8],P0[9],     pw0[2]=PKW(P0,4), pw0[3]=PKW(P0,6), pw0); \
    VRD(1); SBAR(); GAPA(C0=__builtin_amdgcn_mfma_f32_32x32x16_bf16(kf[2],qr[1],C0,0,0,0),   P0[10],P0[11],P0[12],P0[13], pw1[0]=PKW(P0,8), pw1[1]=PKW(P0,10), pw1); \
    VRD(5); SBAR(); GAPA(C1=__builtin_amdgcn_mfma_f32_32x32x16_bf16(kf[3],qr[1],C1,0,0,0),   P0[14],P0[15],P1[0],P1[1],   pw1[2]=PKW(P0,12),pw1[3]=PKW(P0,14), pw1); \
    VRD(2); SBAR(); GAPA(C0=__builtin_amdgcn_mfma_f32_32x32x16_bf16(kf[4],qr[2],C0,0,0,0),   P1[2],P1[3],P1[4],P1[5],     pw2[0]=PKW(P1,0), pw2[1]=PKW(P1,2), pw2); \
    VRD(6); SBAR(); GAPA(C1=__builtin_amdgcn_mfma_f32_32x32x16_bf16(kf[5],qr[2],C1,0,0,0),   P1[6],P1[7],P1[8],P1[9],     pw2[2]=PKW(P1,4), pw2[3]=PKW(P1,6), pw2); \
    VRD(3); SBAR(); GAPA(C0=__builtin_amdgcn_mfma_f32_32x32x16_bf16(kf[6],qr[3],C0,0,0,0),   P1[10],P1[11],P1[12],P1[13], pw3[0]=PKW(P1,8), pw3[1]=PKW(P1,10), pw3); \
    VRD(7); SBAR(); GAPA(C1=__builtin_amdgcn_mfma_f32_32x32x16_bf16(kf[7],qr[3],C1,0,0,0),   P1[14],P1[15],0.f,0.f,       pw3[2]=PKW(P1,12),pw3[3]=PKW(P1,14), pw3); \
    l_reg+=sacc; \
    if(GK){DMA_K((t)+3,sl_cur);} if(GV){DMA_V((t)+1,sl_next);} \
    CBIAS(C0,C1,t); \
    CMASK(C0,C1,t); \
    { float a=MX3(C0[0],C0[1],C1[0]),b=MX3(C0[2],C0[3],C1[1]); a=MX3(a,C1[2],C1[3]); \
      _Pragma("unroll") for(int r=4;r<16;r+=4){a=MX3(a,C0[r],C0[r+1]);b=MX3(b,C0[r+2],C0[r+3]);a=MX3(a,C1[r],C1[r+1]);b=MX3(b,C1[r+2],C1[r+3]);} \
      float rm=__builtin_fmaxf(a,b); { auto rr=__builtin_amdgcn_permlane32_swap(__float_as_uint(rm),__float_as_uint(rm),false,false); rm=__builtin_fmaxf(__uint_as_float(rr[0]),__uint_as_float(rr[1])); } \
      resc=false; \
      if(__builtin_expect(__any(rm>(float)THRL),0)){ const float dl=__builtin_fmaxf(rm,0.f); mhat+=dl; \
        _Pragma("unroll") for(int r=0;r<16;++r){C0[r]-=dl;C1[r]-=dl;} \
        nm=-mhat; \
        const float f=__builtin_amdgcn_exp2f(-dl); l_reg*=f; if(hi==0)wsf[r32]=f; resc=true; } } \
    SBAR(); \
    GAPB(o[0]=__builtin_amdgcn_mfma_f32_32x32x16_bf16(PAF(0),VFR(0),o[0],0,0,0), C0,0); \
    GAPB(o[1]=__builtin_amdgcn_mfma_f32_32x32x16_bf16(PAF(0),VFR(4),o[1],0,0,0), C0,4); \
    KRD(GL,0); GAPB(o[0]=__builtin_amdgcn_mfma_f32_32x32x16_bf16(PAF(1),VFR(1),o[0],0,0,0), C0,8); \
    KRD(GL,1); GAPB(o[1]=__builtin_amdgcn_mfma_f32_32x32x16_bf16(PAF(1),VFR(5),o[1],0,0,0), C0,12); \
    KRD(GL,2); GAPB(o[0]=__builtin_amdgcn_mfma_f32_32x32x16_bf16(PAF(2),VFR(2),o[0],0,0,0), C1,0); \
    KRD(GL,3); GAPB(o[1]=__builtin_amdgcn_mfma_f32_32x32x16_bf16(PAF(2),VFR(6),o[1],0,0,0), C1,4); \
    GAPB(o[0]=__builtin_amdgcn_mfma_f32_32x32x16_bf16(PAF(3),VFR(3),o[0],0,0,0), C1,8); \
    GAPB(o[1]=__builtin_amdgcn_mfma_f32_32x32x16_bf16(PAF(3),VFR(7),o[1],0,0,0), C1,12); \
    }while(0)
  int t=1;
  #undef CMASK
  #define CMASK(P0,P1,t) do{}while(0)
  for(;t+5<NT;t+=2){
    STEP(pB0,pB1,pA0,pA1,t,true,true,true);     WAIT_BAR(2); RESC(); ROT();
    STEP(pA0,pA1,pB0,pB1,t+1,true,true,true);   WAIT_BAR(2); RESC(); ROT();
  }
  #undef CMASK
  #define CMASK(P0,P1,t) do{int jb_=(t)-(NT-4); if(jb_>=0){int hm_=hi,qm_=qrel; asm volatile("":"+v"(hm_),"+v"(qm_)); cmask(P0,P1,jb_,qm_,hm_);}}while(0)
  #define ENDW(tt) do{ if((tt)+3<NT){WAIT_BAR(2);} else if((tt)+2<NT){WAIT_BAR(1);} else {WAIT_BAR(0);} }while(0)
  for(;t+1<NT;t+=2){
    STEP(pB0,pB1,pA0,pA1,t,(t+3<NT),(t+1<NT),(t+1<NT));       ENDW(t);   RESC(); ROT();
    STEP(pA0,pA1,pB0,pB1,t+1,(t+4<NT),(t+2<NT),(t+2<NT));     ENDW(t+1); RESC(); ROT();
  }
  STEP(pB0,pB1,pA0,pA1,NT-1,false,false,false); RESC();
  { float sacc=pB0[0]+pB0[1]; _Pragma("unroll") for(int r=2;r<16;++r)sacc+=pB0[r]; _Pragma("unroll") for(int r=0;r<16;++r)sacc+=pB1[r]; l_reg+=sacc;
    pw0=(u32x4){PKW(pB0,0),PKW(pB0,2),PKW(pB0,4),PKW(pB0,6)};pw1=(u32x4){PKW(pB0,8),PKW(pB0,10),PKW(pB0,12),PKW(pB0,14)};pw2=(u32x4){PKW(pB1,0),PKW(pB1,2),PKW(pB1,4),PKW(pB1,6)};pw3=(u32x4){PKW(pB1,8),PKW(pB1,10),PKW(pB1,12),PKW(pB1,14)};
    SBAR(); pv(o,vb0+sl_cur,PAF(0),PAF(1),PAF(2),PAF(3)); }
  #undef PKW
  #undef PAF
  #undef VFR
  #undef PIN
  #undef MX3
  #undef GAPA
  #undef GAPB
  #undef EX
  #undef VRD
  #undef KRD
  #undef STEP
  #undef ENDW
  {auto rr=__builtin_amdgcn_permlane32_swap(__float_as_uint(l_reg),__float_as_uint(l_reg),false,false);l_reg=__uint_as_float(rr[0])+__uint_as_float(rr[1]);}
  if(hi==0)wsf[32+r32]=l_reg;asm volatile("s_waitcnt lgkmcnt(0)":::"memory");
  float rli[16];
  #pragma unroll
  for(int r=0;r<16;++r)rli[r]=__builtin_amdgcn_rcpf(wsf[32+crow(r,hi)]);
  bf16*Ow=O+(rowbase+q0+wid*QBLK)*DMO+h*D;
  { bf16*stg=(bf16*)(shm+LDS_OST)+wid*2048;
    #pragma unroll
    for(int r=0;r<16;++r){const int orow=crow(r,hi);
      #pragma unroll
      for(int d0=0;d0<2;++d0)stg[orow*64+d0*32+r32]=__float2bfloat16(o[d0][r]*rli[r]);}
    asm volatile("s_waitcnt lgkmcnt(0)":::"memory");
    int le_=lane; asm volatile("":"+v"(le_));
    #pragma unroll
    for(int i=0;i<4;++i){const int row=i*8+(le_>>3),ch=le_&7; const u32x4 v=*(const u32x4*)(stg+row*64+ch*8); ATTN_STORE16(Ow+(unsigned)(row*DMO+ch*8),v);
      float q_=0.f; _Pragma("unroll") for(int e_=0;e_<4;++e_){const float lo_=__uint_as_float(v[e_]<<16),hi_=__uint_as_float(v[e_]&0xffff0000u); q_+=lo_*lo_+hi_*hi_;}
      q_+=__shfl_xor(q_,1);q_+=__shfl_xor(q_,2);q_+=__shfl_xor(q_,4); if(ch==0)SSA[(rowbase+q0+wid*QBLK+row)*NHEAD+h]=q_; } }
  asm volatile("s_waitcnt lgkmcnt(0)\n\ts_barrier":::"memory");
  #undef DMA_K
  #undef DMA_V
  #undef CMASK
  #undef START
  #undef RESC
  #undef ROT
  #undef CBIAS
}
constexpr int ATTN_LDS_BYTES=LDS_BYTES;
struct AttnTensors { const bf16* Q; const bf16* K; const bf16* V; bf16* O; const float* G; float* SSA; };
struct AttnUnit { int bh; int qb; };
struct StaticOrder {
  int vcu,G;
  __device__ __forceinline__ explicit StaticOrder(int grid,int block):vcu((grid%8==0)?(block%8)*(grid/8)+block/8:block),G(grid){}
  __device__ __forceinline__ bool next(int i,AttnUnit&u)const{
    if(G==256){ if(i>=4)return false; const int hf=vcu&1; u.bh=vcu>>1; u.qb=(i==0)?7-hf:(i==1)?hf:(i==2)?5-hf:2+hf; return true; }
    const int L=i*G+vcu; if(L>=BATCH*NHEAD*NQB)return false; u.bh=L/NQB; u.qb=NQB-1-(L%NQB); return true; }
  __device__ __forceinline__ void a_ready(const AttnUnit&)const{}
  __device__ __forceinline__ void done(const AttnUnit&)const{}
};
template<class Sched,int THRL=100> __device__ __forceinline__ void attn_phase(char*lds,const AttnTensors&T,const Sched&S){
  AttnUnit u;
  for(int i=0;S.next(i,u);++i){ S.a_ready(u); attn_unit<THRL>(u.bh/NHEAD,u.bh%NHEAD,u.qb,T.Q,T.K,T.V,T.O,T.G,T.SSA,lds); S.done(u); }
}
#undef SBAR
#undef WAIT_BAR
}
constexpr size_t MiB = 1u << 20;
constexpr size_t WS_CTL = 0, CTL_ZERO_BYTES = 1 * MiB;
constexpr size_t WS_WI = 1 * MiB;
constexpr size_t WS_WO = 6 * MiB;
constexpr size_t WS_WQ = 8 * MiB;
constexpr size_t WS_WG = 12 * MiB;
constexpr size_t WS_WP = 14 * MiB;
constexpr size_t WS_SK = 14 * MiB + 512 * 1024;
constexpr size_t WS_RS1 = 15 * MiB;
constexpr size_t WS_SS2 = 20 * MiB + 1024 * 1024;
constexpr size_t WS_LF = 16 * MiB;
constexpr size_t WS_G = 17 * MiB;
constexpr size_t WS_SSA = 18 * MiB;
constexpr size_t WS_SS1P = 19 * MiB;
constexpr size_t WS_EU = 22 * MiB;
constexpr size_t WS_EV = 54 * MiB;
constexpr size_t WS_PB = 86 * MiB;
constexpr size_t WS_XB = 102 * MiB;
constexpr size_t WS_QKV = 166 * MiB;
constexpr size_t WS_QP = 102 * MiB;
constexpr size_t WS_PLE = 102 * MiB;
constexpr size_t WS_U = 262 * MiB;
constexpr size_t WS_Y = 294 * MiB;
constexpr size_t WS_H2B = 294 * MiB;
constexpr size_t WS_H1B = 358 * MiB;
constexpr size_t WS_SEL = 422 * MiB;
constexpr size_t WS_GATE = 430 * MiB;
constexpr size_t WS_WACT = 446 * MiB;
constexpr size_t WS_PD = 166 * MiB;
constexpr size_t WS_H1Q = 262 * MiB;
constexpr size_t WS_WH = 462 * MiB;
constexpr size_t WS_END = 470 * MiB;
constexpr int CW_CODE = 2;
constexpr int CW_BAR = 4096;
constexpr int CW_XRANK = 16384;

constexpr int RING_OFF = 0, RING_BYTES = 131072;
constexpr int LDSCTL_OFF = RING_BYTES, MISC_OFF = LDSCTL_OFF + 320;
constexpr int SCAN_OFF = LDSCTL_OFF + 1024;
constexpr int RSA_OFF = LDSCTL_OFF + 2048;
constexpr int LDS_BYTES = 147456;

#define GAS __attribute__((address_space(1)))
#define LAS __attribute__((address_space(3)))
typedef unsigned short bf16;
typedef unsigned v4u __attribute__((ext_vector_type(4)));
typedef float f32x4 __attribute__((ext_vector_type(4)));
typedef short bf16x8 __attribute__((ext_vector_type(8)));
typedef GAS unsigned gu32;
typedef GAS unsigned long long gu64;
#define RLX_AGENT __ATOMIC_RELAXED, __HIP_MEMORY_SCOPE_AGENT
#define LDS_WAIT() asm volatile("s_waitcnt lgkmcnt(0)" ::: "memory")
#define VM_WAIT() asm volatile("s_waitcnt vmcnt(0)" ::: "memory")
__device__ __forceinline__ unsigned long long rt() { return __builtin_amdgcn_s_memrealtime(); }
__device__ __forceinline__ unsigned f2bf(float f) { unsigned u = __builtin_bit_cast(unsigned, f); return (u + 0x7fffu + ((u >> 16) & 1u)) >> 16; }
__device__ __forceinline__ unsigned pk2(float lo, float hi) { return f2bf(lo) | (f2bf(hi) << 16); }

#define XB_TMO      128
#define XB_XCNT(j)  (256  + 64 * (j))
#define XB_XSUB(j)  (1280 + 64 * (j))
#define XB_XGEN(j)  (2304 + 64 * (j))
#define XB_TOP      3328
#define XB_TOPGEN   3392
#define XCD_BAR_WORDS 3456
#define XB_SPIN_CAP (1u << 18)

__device__ __forceinline__ unsigned xb_ld(unsigned* p)              { return __hip_atomic_load(p, __ATOMIC_RELAXED, __HIP_MEMORY_SCOPE_AGENT); }
__device__ __forceinline__ unsigned xb_add(unsigned* p, unsigned v) { return __hip_atomic_fetch_add(p, v, __ATOMIC_RELAXED, __HIP_MEMORY_SCOPE_AGENT); }
__device__ __forceinline__ unsigned xb_xcc_id() { return (unsigned)__builtin_amdgcn_s_getreg((3 << 11) | 20) & 0xFu; }
#define XB_SPIN(cond, bar) do { unsigned _sp = 0; while (cond) { __builtin_amdgcn_s_sleep(1); \
    if ((++_sp & 255u) == 0u) { if (xb_ld(&(bar)[XB_TMO])) break; if (_sp > XB_SPIN_CAP) { atomicAdd(&(bar)[XB_TMO], 1u); break; } } } } while (0)

struct XcdBarrier {
    unsigned* bar; unsigned x;
    volatile LAS unsigned* st;
};

__device__ __forceinline__ XcdBarrier xcd_barrier_post(unsigned* bar, volatile LAS unsigned* st) {
    XcdBarrier b; b.bar = bar; b.x = xb_xcc_id(); b.st = st;
    if (threadIdx.x == 0) (void)xb_add(&bar[XB_XCNT(b.x)], 1u);
    return b;
}
__device__ __forceinline__ void xcd_barrier_complete(unsigned* bar, unsigned x, unsigned& nloc, unsigned& nx) {
    const unsigned G = gridDim.x * gridDim.y * gridDim.z;
    unsigned sum, cnt, mine, sp = 0u;
    for (;;) {
        sum = 0u; cnt = 0u; mine = 0u;
#pragma unroll
        for (unsigned j = 0; j < 16; ++j) { const unsigned c = xb_ld(&bar[XB_XCNT(j)]); sum += c; cnt += (c > 0u) ? 1u : 0u; mine = (j == x) ? c : mine; }
        if (sum == G) break;
        __builtin_amdgcn_s_sleep(1);
        if ((++sp & 255u) == 0u) { if (xb_ld(&bar[XB_TMO])) break; if (sp > XB_SPIN_CAP) { atomicAdd(&bar[XB_TMO], 1u); break; } }
    }
    nloc = mine > 0u ? mine : 1u; nx = cnt > 0u ? cnt : 1u;
}

__device__ __forceinline__ void xcd_barrier(const XcdBarrier& b) {
    asm volatile("s_waitcnt vmcnt(0)" ::: "memory");
    __syncthreads();
    if (threadIdx.x == 0) {
        unsigned* bar = b.bar;
        __builtin_amdgcn_s_waitcnt(0);
        unsigned nloc = b.st[0], nx = b.st[1];
        if (nloc == 0u) { xcd_barrier_complete(bar, b.x, nloc, nx); b.st[0] = nloc; b.st[1] = nx; }
        const unsigned old = xb_add(&bar[XB_XSUB(b.x)], 1u);
        const unsigned gen = old / nloc;
        if (old + 1u == (gen + 1u) * nloc) {
            __builtin_amdgcn_fence(__ATOMIC_RELEASE, "agent");
            asm volatile("s_waitcnt vmcnt(0)" ::: "memory");
            const unsigned og = xb_add(&bar[XB_TOP], 1u);
            const unsigned tg = og / nx;
            if (og + 1u == (tg + 1u) * nx) xb_add(&bar[XB_TOPGEN], 1u);
            else XB_SPIN(xb_ld(&bar[XB_TOPGEN]) == tg, bar);
            __builtin_amdgcn_fence(__ATOMIC_ACQUIRE, "agent");
            xb_add(&bar[XB_XGEN(b.x)], 1u);
            asm volatile("s_waitcnt vmcnt(0)" ::: "memory");
        } else {
            XB_SPIN(xb_ld(&bar[XB_XGEN(b.x)]) == gen, bar);
            __builtin_amdgcn_fence(__ATOMIC_ACQUIRE, "agent");
            asm volatile("s_waitcnt vmcnt(0)" ::: "memory");
        }
    }
    __syncthreads();
}

constexpr int NWAVES = 8;
struct Frame {
    LAS unsigned char* lds;
    volatile LAS unsigned* MISC;
    gu32* ctl;
    int tid, lane, wave;
    int vcu, G;
    unsigned char* ws;
    const float* in[23];
    float* out;
};
enum { I_X = 0, I_P, I_LN_MIX, I_W_IN, I_B_FGATE, I_Q_NORM, I_K_NORM, I_CONV_W, I_CONV_B, I_CONV_LN_G, I_CONV_LN_B, I_ATTN_OUT_NORM, I_CONV_OUT_NORM, I_W_OUT,
       I_LN_FFN, I_W_PEER_Q, I_SUB_KEYS1, I_SUB_KEYS2, I_EXPERT_U, I_EXPERT_V, I_LN_PL, I_W_PL_GATE, I_W_PL_PROJ };

#define PHASE_IDS(F) do { int t_ = threadIdx.x; asm volatile("" : "+v"(t_)); F.tid = t_; F.lane = t_ & 63; F.wave = __builtin_amdgcn_readfirstlane(t_ >> 6); } while (0)
__device__ __forceinline__ float wave_sum(float v) {
    v += __builtin_bit_cast(float, __builtin_amdgcn_update_dpp(0, __builtin_bit_cast(int, v), 0xB1, 0xf, 0xf, true));
    v += __builtin_bit_cast(float, __builtin_amdgcn_update_dpp(0, __builtin_bit_cast(int, v), 0x4E, 0xf, 0xf, true));
    v += __builtin_bit_cast(float, __builtin_amdgcn_update_dpp(0, __builtin_bit_cast(int, v), 0x141, 0xf, 0xf, true));
    v += __builtin_bit_cast(float, __builtin_amdgcn_update_dpp(0, __builtin_bit_cast(int, v), 0x140, 0xf, 0xf, true));
    const int b = __builtin_bit_cast(int, v);
    const float s0 = __builtin_bit_cast(float, __builtin_amdgcn_readlane(b, 0)), s1 = __builtin_bit_cast(float, __builtin_amdgcn_readlane(b, 16));
    const float s2 = __builtin_bit_cast(float, __builtin_amdgcn_readlane(b, 32)), s3 = __builtin_bit_cast(float, __builtin_amdgcn_readlane(b, 48));
    return (s0 + s1) + (s2 + s3);
}
__device__ __forceinline__ float fast_sigmoid(float v) { return __builtin_amdgcn_rcpf(1.0f + __builtin_amdgcn_exp2f(-v * LOG2E)); }

__device__ __forceinline__ void p0_transpose_item(const float* W, int Nsrc, int K, int col0, const float* gain, bf16* WT, int n0, int k0, LAS float* scr, int lane) {
    float wv_[32];
#pragma unroll
    for (int i = 0; i < 32; ++i) wv_[i] = W[(size_t)(k0 + 2 * i + (lane >> 5)) * Nsrc + col0 + (lane & 31)];
#pragma unroll
    for (int i = 0; i < 32; ++i) { const int kk = 2 * i + (lane >> 5); const float g = gain ? gain[kk] : 1.0f; scr[kk * 33 + (lane & 31)] = wv_[i] * g; }
    LDS_WAIT(); asm volatile("" ::: "memory");
    const int c = lane & 7;
#pragma unroll
    for (int j = 0; j < 4; ++j) { const int n = (lane >> 3) + 8 * j; const LAS float* s = scr + (8 * c) * 33 + n;
        v4u o; o.x = pk2(s[0 * 33], s[1 * 33]); o.y = pk2(s[2 * 33], s[3 * 33]); o.z = pk2(s[4 * 33], s[5 * 33]); o.w = pk2(s[6 * 33], s[7 * 33]);
        *(GAS v4u*)(WT + (size_t)(n0 + n) * K + k0 + 8 * c) = o; }
    LDS_WAIT(); asm volatile("" ::: "memory");
}
__device__ __forceinline__ int inproj_src_col(int nb) {
    const int p0 = 32 * nb, pn = p0 >> 8, cp = p0 & 255;
    if (pn < 6) { const int bj = cp >> 7, wc = (cp >> 5) & 3; return 256 * pn + 64 * wc + 32 * bj; }
    const int pg = pn - 6; return cp < 128 ? COL_A + 128 * pg + cp : COL_G + 128 * pg + (cp - 128);
}
constexpr float U_QSCALE = 96.0f, H_QSCALE = 14.0f;
__device__ __forceinline__ unsigned q4(float v) { return (unsigned)((int)__builtin_rintf(__builtin_amdgcn_fmed3f(v, -7.0f, 7.0f)) + 8); }
__device__ __forceinline__ v4u cvt8(const f32x4 a, const f32x4 b) { v4u o; o.x = pk2(a.x, a.y); o.y = pk2(a.z, a.w); o.z = pk2(b.x, b.y); o.w = pk2(b.z, b.w); return o; }

__device__ __forceinline__ void p0_prologue(Frame& F) {
    PHASE_IDS(F);
    LAS float* scr = (LAS float*)(F.lds + RING_OFF + F.wave * 16384);
    const int gw = F.vcu * NWAVES + F.wave, NGW = F.G * NWAVES;
    bf16* WI = (bf16*)(F.ws + WS_WI); bf16* WO = (bf16*)(F.ws + WS_WO); bf16* WQ = (bf16*)(F.ws + WS_WQ); bf16* WG = (bf16*)(F.ws + WS_WG); bf16* WP = (bf16*)(F.ws + WS_WP);
    constexpr int I_IN = 16 * 80, I_OUT = 16 * 32, I_PQ = 16 * 64, I_GT = 16 * 32, I_PJ = 4 * 32, NITEMS = I_IN + I_OUT + I_PQ + I_GT + I_PJ;
    for (int it = gw; it < NITEMS; it += NGW) {
        int r = it;
        if (r < I_IN) { const int kb = r / 80, nb = r % 80; p0_transpose_item(F.in[I_W_IN], NIN, DMODEL, inproj_src_col(nb), F.in[I_LN_MIX] + 64 * kb, WI, 32 * nb, 64 * kb, scr, F.lane); continue; } r -= I_IN;
        if (r < I_OUT) { const int kb = r / 32, nb = r % 32; const float* g = kb < 8 ? F.in[I_ATTN_OUT_NORM] + 64 * kb : F.in[I_CONV_OUT_NORM] + 64 * (kb - 8);
            p0_transpose_item(F.in[I_W_OUT], DMODEL, DMODEL, 32 * nb, g, WO, 32 * nb, 64 * kb, scr, F.lane); continue; } r -= I_OUT;
        if (r < I_PQ) { const int kb = r / 64, nb = r % 64; p0_transpose_item(F.in[I_W_PEER_Q], PH * PQ, DMODEL, 32 * nb, F.in[I_LN_FFN] + 64 * kb, WQ, 32 * nb, 64 * kb, scr, F.lane); continue; } r -= I_PQ;
        if (r < I_GT) { const int kb = r / 32, nb = r % 32; p0_transpose_item(F.in[I_W_PL_GATE], DMODEL, DMODEL, 32 * nb, F.in[I_LN_PL] + 64 * kb, WG, 32 * nb, 64 * kb, scr, F.lane); continue; } r -= I_GT;
        { const int kb = r / 32, nb = r % 32; p0_transpose_item(F.in[I_W_PL_PROJ], DMODEL, DPLE, 32 * nb, nullptr, WP, 32 * nb, 64 * kb, scr, F.lane); }
    }
    {
        float wf[4][4][8];
        const float* w_in = F.in[I_W_IN]; const float* lnm = F.in[I_LN_MIX];
#pragma unroll
        for (int j = 0; j < 4; ++j)
#pragma unroll
            for (int e = 0; e < 4; ++e) { const int k = 4 * F.lane + 256 * j + e; const float g = lnm[k];
                const f32x4 a = *(const f32x4*)(w_in + (size_t)k * NIN + COL_F), b = *(const f32x4*)(w_in + (size_t)k * NIN + COL_F + 4);
                wf[j][e][0] = a.x * g; wf[j][e][1] = a.y * g; wf[j][e][2] = a.z * g; wf[j][e][3] = a.w * g; wf[j][e][4] = b.x * g; wf[j][e][5] = b.y * g; wf[j][e][6] = b.z * g; wf[j][e][7] = b.w * g; }
        const float* x = F.in[I_X]; bf16* XB = (bf16*)(F.ws + WS_XB); float* RS1 = (float*)(F.ws + WS_RS1); float* LF = (float*)(F.ws + WS_LF);
        const float bfh = F.in[I_B_FGATE][F.lane & 7];
        f32x4 v[4], vn[4];
        if (gw < T) { const GAS f32x4* xr = (const GAS f32x4*)(x + (size_t)gw * DMODEL) + F.lane;
#pragma unroll
            for (int j = 0; j < 4; ++j) v[j] = xr[64 * j]; }
#pragma unroll 1
        for (int m = gw; m < T; m += NGW) {
            { const int mn = m + NGW < T ? m + NGW : m; const GAS f32x4* xr = (const GAS f32x4*)(x + (size_t)mn * DMODEL) + F.lane;
#pragma unroll
              for (int j = 0; j < 4; ++j) vn[j] = xr[64 * j]; }
            float s = 0.f; float d[8];
#pragma unroll
            for (int h = 0; h < 8; ++h) d[h] = 0.f;
#pragma unroll
            for (int j = 0; j < 4; ++j) { s += (v[j].x * v[j].x + v[j].y * v[j].y) + (v[j].z * v[j].z + v[j].w * v[j].w);
#pragma unroll
                for (int h = 0; h < 8; ++h) d[h] += (v[j].x * wf[j][0][h] + v[j].y * wf[j][1][h]) + (v[j].z * wf[j][2][h] + v[j].w * wf[j][3][h]); }
            const float rs = 1.0f / sqrtf(wave_sum(s) * (1.0f / DMODEL) + EPS);
            float mine = 0.f;
#pragma unroll
            for (int h = 0; h < 8; ++h) { const float t = wave_sum(d[h]); mine = ((F.lane & 7) == h) ? t : mine; }
            GAS unsigned long long* o8 = (GAS unsigned long long*)(XB + (size_t)m * DMODEL) + F.lane;
#pragma unroll
            for (int j = 0; j < 4; ++j) o8[64 * j] = (unsigned long long)pk2(v[j].x, v[j].y) | ((unsigned long long)pk2(v[j].z, v[j].w) << 32);
            if (F.lane == 0) RS1[m] = rs;
            if (F.lane < 8) { const float z = mine * rs + bfh; const float ls = fminf(z, 0.f) - log1pf(expf(-fabsf(z))); LF[(size_t)m * 8 + F.lane] = ls * LOG2E; }
#pragma unroll
            for (int j = 0; j < 4; ++j) v[j] = vn[j];
        }
    }
    {
        const size_t gt = (size_t)F.vcu * (NWAVES * 64) + F.tid, NGT = (size_t)F.G * NWAVES * 64;
        const float* p = F.in[I_P]; bf16* PB = (bf16*)(F.ws + WS_PB);
        for (size_t c0 = gt; c0 < (size_t)T * DPLE / 8; c0 += 4 * NGT) {
            f32x4 pa[4][2];
#pragma unroll
            for (int k = 0; k < 4; ++k) { const size_t c = c0 + k * NGT < (size_t)T * DPLE / 8 ? c0 + k * NGT : c0; const GAS f32x4* s = (const GAS f32x4*)(p + c * 8); pa[k][0] = s[0]; pa[k][1] = s[1]; }
#pragma unroll
            for (int k = 0; k < 4; ++k) { const size_t c = c0 + k * NGT; if (c < (size_t)T * DPLE / 8) *(GAS v4u*)(PB + c * 8) = cvt8(pa[k][0], pa[k][1]); }
        }
        const float* eu = F.in[I_EXPERT_U]; const float* ev = F.in[I_EXPERT_V]; const float* lnf = F.in[I_LN_FFN];
        unsigned char* EU4 = F.ws + WS_EU; unsigned char* EV4 = F.ws + WS_EV;
        for (size_t c = gt; c < (size_t)NEXP * DMODEL / 32; c += NGT) {
            const int e = (int)(c >> 5), dc = (int)(c & 31), d0 = dc * 32; const size_t dst = (size_t)(dc >> 3) * ((size_t)NEXP * 128) + (size_t)e * 128 + (dc & 7) * 16;
            const GAS f32x4* su = (const GAS f32x4*)(eu + (size_t)e * DMODEL + d0); const GAS f32x4* sv = (const GAS f32x4*)(ev + (size_t)e * DMODEL + d0);
            v4u ou, ov;
#pragma unroll
            for (int q = 0; q < 4; ++q) { const f32x4 a0 = su[2 * q] * (*(const f32x4*)(lnf + d0 + 8 * q) * U_QSCALE), a1 = su[2 * q + 1] * (*(const f32x4*)(lnf + d0 + 8 * q + 4) * U_QSCALE);
                unsigned pu = q4(a0.x) | (q4(a0.y) << 4) | (q4(a0.z) << 8) | (q4(a0.w) << 12) | (q4(a1.x) << 16) | (q4(a1.y) << 20) | (q4(a1.z) << 24) | (q4(a1.w) << 28); ou[q] = pu;
                const f32x4 b0 = sv[2 * q] * 6.0f, b1 = sv[2 * q + 1] * 6.0f;
                unsigned pv = 0u; pv = __builtin_amdgcn_cvt_scalef32_pk_fp4_f32(pv, b0.x, b0.y, 1.0f, 0); pv = __builtin_amdgcn_cvt_scalef32_pk_fp4_f32(pv, b0.z, b0.w, 1.0f, 1);
                pv = __builtin_amdgcn_cvt_scalef32_pk_fp4_f32(pv, b1.x, b1.y, 1.0f, 2); pv = __builtin_amdgcn_cvt_scalef32_pk_fp4_f32(pv, b1.z, b1.w, 1.0f, 3); ov[q] = pv; }
            *(GAS v4u*)(EU4 + dst) = ou; *(GAS v4u*)(EV4 + dst) = ov;
        }
        bf16* SK = (bf16*)(F.ws + WS_SK);
        for (size_t c = gt; c < (size_t)2 * NKEY * PHALF / 8; c += NGT) {
            const float* src = c < (size_t)NKEY * PHALF / 8 ? F.in[I_SUB_KEYS1] + c * 8 : F.in[I_SUB_KEYS2] + (c - NKEY * PHALF / 8) * 8;
            const GAS f32x4* s = (const GAS f32x4*)src; *(GAS v4u*)(SK + c * 8) = cvt8(s[0], s[1]);
        }
    }
}

__device__ __forceinline__ void p1_scan(Frame& F) {
    PHASE_IDS(F);
    const float* LF = (const float*)(F.ws + WS_LF); float* Gc = (float*)(F.ws + WS_G);
    LAS float* wt = (LAS float*)(F.lds + SCAN_OFF);
    for (int bh = blockIdx.x; bh < BATCH * NH; bh += F.G) {
        const int b = bh >> 3, h = bh & 7;
        float v[4];
#pragma unroll
        for (int j = 0; j < 4; ++j) v[j] = LF[((size_t)b * SEQ + 4 * F.tid + j) * 8 + h];
        v[1] += v[0]; v[2] += v[1]; v[3] += v[2];
        float incl = v[3];
#pragma unroll
        for (int o = 1; o < 64; o <<= 1) { const float t = __shfl_up(incl, o); if (F.lane >= o) incl += t; }
        if (F.lane == 63) wt[F.wave] = incl;
        __syncthreads();
        float base = incl - v[3];
        for (int w = 0; w < F.wave; ++w) base += wt[w];
        f32x4 o; o.x = base + v[0]; o.y = base + v[1]; o.z = base + v[2]; o.w = base + v[3];
        *(GAS f32x4*)(Gc + (size_t)bh * SEQ + 4 * F.tid) = o;
        __syncthreads();
    }
}

constexpr int CONV_TOK = 64, CONV_UW = 0, CONV_CWL = (CONV_TOK + 30) * 1024, CONV_LDS = CONV_CWL + CW * 1024;
static_assert(CONV_LDS <= RING_BYTES, "conv LDS");
__device__ __forceinline__ v4u cvt8h(const f32x4 a, const f32x4 b) { v4u o; o.x = __builtin_bit_cast(unsigned, __builtin_amdgcn_cvt_pkrtz(a.x, a.y)); o.y = __builtin_bit_cast(unsigned, __builtin_amdgcn_cvt_pkrtz(a.z, a.w));
    o.z = __builtin_bit_cast(unsigned, __builtin_amdgcn_cvt_pkrtz(b.x, b.y)); o.w = __builtin_bit_cast(unsigned, __builtin_amdgcn_cvt_pkrtz(b.z, b.w)); return o; }
__device__ __forceinline__ unsigned bf2_to_h2(unsigned w) { return __builtin_bit_cast(unsigned, __builtin_amdgcn_cvt_pkrtz(__uint_as_float(w << 16), __uint_as_float(w & 0xffff0000u))); }
__device__ __forceinline__ v4u bf8_to_h8(const v4u w) { v4u o; o.x = bf2_to_h2(w.x); o.y = bf2_to_h2(w.y); o.z = bf2_to_h2(w.z); o.w = bf2_to_h2(w.w); return o; }
__device__ __forceinline__ void unpack8(const v4u w, float (&f)[8]) {
    f[0] = __uint_as_float(w.x << 16); f[1] = __uint_as_float(w.x & 0xffff0000u); f[2] = __uint_as_float(w.y << 16); f[3] = __uint_as_float(w.y & 0xffff0000u);
    f[4] = __uint_as_float(w.z << 16); f[5] = __uint_as_float(w.z & 0xffff0000u); f[6] = __uint_as_float(w.w << 16); f[7] = __uint_as_float(w.w & 0xffff0000u);
}
__device__ __forceinline__ void p2_conv(Frame& F) {
    PHASE_IDS(F);
    const bf16* U = (const bf16*)(F.ws + WS_U); bf16* Y = (bf16*)(F.ws + WS_Y);
    LAS unsigned char* uw = F.lds + RING_OFF + CONV_UW; LAS unsigned char* cwl = F.lds + RING_OFF + CONV_CWL;
    { const float* cw = F.in[I_CONV_W];
      f32x4 ca_[4][2];
#pragma unroll
      for (int k = 0; k < 4; ++k) { const int i = F.tid + k * NWAVES * 64; const GAS f32x4* s = (const GAS f32x4*)(cw + (i < CW * DCONV / 8 ? i : 0) * 8); ca_[k][0] = s[0]; ca_[k][1] = s[1]; }
#pragma unroll
      for (int k = 0; k < 4; ++k) { const int i = F.tid + k * NWAVES * 64; if (i < CW * DCONV / 8) *(LAS v4u*)(cwl + i * 16) = cvt8h(ca_[k][0], ca_[k][1]); } }
    float cb[8], lg[8], lb[8];
    { const int c0 = 8 * F.lane;
#pragma unroll
      for (int e = 0; e < 8; ++e) { cb[e] = F.in[I_CONV_B][c0 + e]; lg[e] = F.in[I_CONV_LN_G][c0 + e]; lb[e] = F.in[I_CONV_LN_B][c0 + e]; } }
    const int NUNIT = T / CONV_TOK;
    for (int un = F.vcu; un < NUNIT; un += F.G) {
        const int b = un / (SEQ / CONV_TOK), s0 = (un % (SEQ / CONV_TOK)) * CONV_TOK;
        __syncthreads();
        { constexpr int NCH = ((CONV_TOK + 30) * 64 + NWAVES * 64 - 1) / (NWAVES * 64); v4u wv_[NCH];
#pragma unroll
          for (int k = 0; k < NCH; ++k) { const int i = F.tid + k * NWAVES * 64, r = i >> 6, ch = i & 63, s = s0 - 30 + r;
              wv_[k] = (v4u){0u, 0u, 0u, 0u}; if (i < (CONV_TOK + 30) * 64 && s >= 0) wv_[k] = *(const GAS v4u*)(U + ((size_t)b * SEQ + s) * DCONV + ch * 8); }
#pragma unroll
          for (int k = 0; k < NCH; ++k) { const int i = F.tid + k * NWAVES * 64, r = i >> 6, ch = i & 63; if (i < (CONV_TOK + 30) * 64) *(LAS v4u*)(uw + r * 1024 + ch * 16) = bf8_to_h8(wv_[k]); } }
        __syncthreads();
#pragma unroll 1
        for (int grp = 0; grp < 2; ++grp) {
            const int sb = 8 * F.wave + 4 * grp;
            typedef _Float16 h2c __attribute__((ext_vector_type(2)));
            h2c hacc[4][4];
#pragma unroll
            for (int q = 0; q < 4; ++q)
#pragma unroll
                for (int e = 0; e < 4; ++e) hacc[q][e] = (h2c){(_Float16)0.f, (_Float16)0.f};
            h2c wv[4][4];
            const LAS unsigned char* up = uw + sb * 1024 + F.lane * 16; const LAS unsigned char* wp = cwl + F.lane * 16;
#define LD_H8(D, P) do { const v4u t_ = *(const LAS v4u*)(P); const unsigned t0_ = t_.x, t1_ = t_.y, t2_ = t_.z, t3_ = t_.w; \
                D[0] = __builtin_bit_cast(h2c, t0_); D[1] = __builtin_bit_cast(h2c, t1_); D[2] = __builtin_bit_cast(h2c, t2_); D[3] = __builtin_bit_cast(h2c, t3_); } while (0)
#define CONV_ROW(RHO, RI) do { h2c ur[4]; LD_H8(ur, up + (RHO) * 1024); \
                if ((RI) < CW) LD_H8(wv[(RI) & 3], wp + (RHO) * 1024); \
                _Pragma("unroll") for (int q = 0; q < 4; ++q) { const int j = (RI) - q; if (j >= 0 && j < CW) { \
                    _Pragma("unroll") for (int e = 0; e < 4; ++e) hacc[q][e] += wv[j & 3][e] * ur[e]; } } \
                __builtin_amdgcn_sched_barrier(0); } while (0)
            CONV_ROW(0, 0); CONV_ROW(1, 1); CONV_ROW(2, 2); CONV_ROW(3, 3);
#pragma unroll 1
            for (int r4 = 4; r4 < 28; r4 += 4) { CONV_ROW(r4, 4); CONV_ROW(r4 + 1, 5); CONV_ROW(r4 + 2, 6); CONV_ROW(r4 + 3, 7); }
            CONV_ROW(28, 28); CONV_ROW(29, 29); CONV_ROW(30, 30); CONV_ROW(31, 31); CONV_ROW(32, 32); CONV_ROW(33, 33);
#undef CONV_ROW
#undef LD_H8
            float acc[4][8];
#pragma unroll
            for (int q = 0; q < 4; ++q)
#pragma unroll
                for (int e = 0; e < 4; ++e) { acc[q][2 * e] = (float)hacc[q][e].x + cb[2 * e]; acc[q][2 * e + 1] = (float)hacc[q][e].y + cb[2 * e + 1]; }
#pragma unroll
            for (int q = 0; q < 4; ++q) {
                float s = 0.f;
#pragma unroll
                for (int e = 0; e < 8; ++e) s += acc[q][e];
                const float mu = wave_sum(s) * (1.0f / DCONV); float s2 = 0.f;
#pragma unroll
                for (int e = 0; e < 8; ++e) { acc[q][e] -= mu; s2 += acc[q][e] * acc[q][e]; }
                const float rstd = 1.0f / sqrtf(wave_sum(s2) * (1.0f / DCONV) + LN_EPS); float s3 = 0.f;
#pragma unroll
                for (int e = 0; e < 8; ++e) { const float y = acc[q][e] * rstd * lg[e] + lb[e]; const float sw = y * fast_sigmoid(y); acc[q][e] = sw; s3 += sw * sw; }
                const float rr = 1.0f / sqrtf(wave_sum(s3) * (1.0f / DCONV) + EPS);
                v4u o; o.x = pk2(acc[q][0] * rr, acc[q][1] * rr); o.y = pk2(acc[q][2] * rr, acc[q][3] * rr); o.z = pk2(acc[q][4] * rr, acc[q][5] * rr); o.w = pk2(acc[q][6] * rr, acc[q][7] * rr);
                *(GAS v4u*)(Y + ((size_t)b * SEQ + s0 + sb + q) * DMODEL + DATT + 8 * F.lane) = o;
            }
        }
    }
    __syncthreads();
}

namespace topk {
typedef float f32x16 __attribute__((ext_vector_type(16)));
typedef short bf16x8 __attribute__((ext_vector_type(8)));
constexpr int SKL_OFF = 0, LUT_OFF = 65536, LUT_STRIDE = 36, TOPK_LDS = LUT_OFF + NWAVES * 64 * LUT_STRIDE;
static_assert(TOPK_LDS <= RING_BYTES, "topk LDS");
__device__ __forceinline__ float vmaxf(float a, float b) { float r; asm("v_max_f32_e32 %0, %1, %2" : "=v"(r) : "v"(a), "v"(b)); return r; }
__device__ __forceinline__ float vminf(float a, float b) { float r; asm("v_min_f32_e32 %0, %1, %2" : "=v"(r) : "v"(a), "v"(b)); return r; }
#define TK_CE(x, y) do { const float hi_ = vmaxf(x, y), lo_ = vminf(x, y); x = hi_; y = lo_; } while (0)
constexpr int SA[63] = {0,2,4,6,8,10,12,14,0,1,4,5,8,9,12,13,1,5,9,13,0,1,2,3,8,9,10,11,2,3,10,11,1,3,5,9,11,13,0,1,2,3,4,5,6,7,4,5,6,7,2,3,6,7,10,11,1,3,5,7,9,11,13};
constexpr int SB[63] = {1,3,5,7,9,11,13,15,2,3,6,7,10,11,14,15,2,6,10,14,4,5,6,7,12,13,14,15,4,5,12,13,2,4,6,10,12,14,8,9,10,11,12,13,14,15,8,9,10,11,4,5,8,9,12,13,2,4,6,8,10,12,14};
constexpr int MA[32] = {0,1,2,3,4,5,6,7,0,1,2,3,8,9,10,11,0,1,4,5,8,9,12,13,0,2,4,6,8,10,12,14};
constexpr int MB[32] = {8,9,10,11,12,13,14,15,4,5,6,7,12,13,14,15,2,3,6,7,10,11,14,15,1,3,5,7,9,11,13,15};
constexpr int CAND_A[50] = {0,0,0,0,0,0,0,0,0,0,0,0,0,0,0,0,1,1,1,1,1,1,1,1,2,2,2,2,2,3,3,3,3,4,4,4,5,5,6,6,7,7,8,9,10,11,12,13,14,15};
constexpr int CAND_B[50] = {0,1,2,3,4,5,6,7,8,9,10,11,12,13,14,15,0,1,2,3,4,5,6,7,0,1,2,3,4,0,1,2,3,0,1,2,0,1,0,1,0,1,0,0,0,0,0,0,0,0};
__device__ __forceinline__ void sort16(float (&v)[16]) {
#pragma unroll
    for (int i = 0; i < 63; ++i) TK_CE(v[SA[i]], v[SB[i]]);
}
__device__ __forceinline__ void bitonic16(float (&v)[16]) {
#pragma unroll
    for (int i = 0; i < 32; ++i) TK_CE(v[MA[i]], v[MB[i]]);
}
__device__ __forceinline__ void merge16(float (&a)[16], const float (&b)[16]) {
#pragma unroll
    for (int i = 0; i < 16; ++i) a[i] = vmaxf(a[i], b[15 - i]);
    bitonic16(a);
}
__device__ __forceinline__ void top16_of_tiles(const f32x16 (&acc)[4], int hi, float (&top)[16]) {
    float w[16];
#pragma unroll
    for (int blk = 0; blk < 4; ++blk) {
#pragma unroll
        for (int r = 0; r < 16; ++r) { const unsigned key = (unsigned)(blk * 32 + (r & 3) + 8 * (r >> 2)) + 4u * (unsigned)hi;
            const float pv = __uint_as_float((__float_as_uint(acc[blk][r]) & 0xffffff80u) | key);
            if (blk == 0) top[r] = pv; else w[r] = pv; }
        if (blk == 0) sort16(top); else { sort16(w); merge16(top, w); }
    }
    float lo[16], hi_[16];
#pragma unroll
    for (int i = 0; i < 16; ++i) { const auto rr = __builtin_amdgcn_permlane32_swap(__float_as_uint(top[i]), __float_as_uint(top[i]), false, false); lo[i] = __uint_as_float(rr[0]); hi_[i] = __uint_as_float(rr[1]); }
#pragma unroll
    for (int i = 0; i < 16; ++i) top[i] = vmaxf(lo[i], hi_[15 - i]);
    bitonic16(top);
}
}

__device__ __forceinline__ void p5_topk(Frame& F) {
    PHASE_IDS(F);
    using namespace topk;
    const bf16* QP = (const bf16*)(F.ws + WS_QP); const bf16* SK = (const bf16*)(F.ws + WS_SK);
    unsigned short* SEL = (unsigned short*)(F.ws + WS_SEL); float* GATE = (float*)(F.ws + WS_GATE);
    LAS unsigned char* skl = F.lds + RING_OFF + SKL_OFF; LAS unsigned char* lut = F.lds + RING_OFF + LUT_OFF + F.tid * LUT_STRIDE;
    { v4u sk_[8];
#pragma unroll
      for (int k = 0; k < 8; ++k) { const int i = F.tid + k * NWAVES * 64, row = i >> 4, c = i & 15; sk_[k] = *(const GAS v4u*)(SK + (size_t)row * PHALF + c * 8); }
#pragma unroll
      for (int k = 0; k < 8; ++k) { const int i = F.tid + k * NWAVES * 64, row = i >> 4, c = i & 15; *(LAS v4u*)(skl + row * 256 + ((c ^ (row & 15)) << 4)) = sk_[k]; } }
    __syncthreads();
    const int gw = F.vcu * NWAVES + F.wave, NGW = F.G * NWAVES, tok = F.lane & 31, hi = F.lane >> 5;
#pragma unroll 1
    for (int un = gw; un < (T / 32) * PH; un += NGW) {
        const int tg = un >> 3, h = un & 7; const size_t trow = (size_t)tg * 32 + tok;
        const unsigned char* qblk = (const unsigned char*)QP + (((size_t)tg * 8 + h) * 16) * 1024 + F.lane * 16;
        float v1[16], v2[16];
#pragma unroll
        for (int half = 0; half < 2; ++half) {
            bf16x8 bq[8];
#pragma unroll
            for (int ks = 0; ks < 8; ++ks) bq[ks] = *(const GAS bf16x8*)(qblk + (half * 8 + ks) * 1024);
            f32x16 acc[4];
#pragma unroll
            for (int blk = 0; blk < 4; ++blk) { acc[blk] = f32x16{};
                const int key = blk * 32 + tok;
#pragma unroll
                for (int ks = 0; ks < 8; ++ks) { const bf16x8 a = *(const LAS bf16x8*)(skl + half * 32768 + key * 256 + (((2 * ks + hi) ^ (key & 15)) << 4));
                    acc[blk] = __builtin_amdgcn_mfma_f32_32x32x16_bf16(a, bq[ks], acc[blk], 0, 0, 0); } }
            if (half == 0) top16_of_tiles(acc, hi, v1); else top16_of_tiles(acc, hi, v2);
        }
#pragma unroll
        for (int i = 0; i < 16; ++i) { lut[i] = (unsigned char)(__float_as_uint(v1[i]) & 0x7fu); lut[16 + i] = (unsigned char)(__float_as_uint(v2[i]) & 0x7fu); }
        float c[4][16];
#pragma unroll
        for (int n = 0; n < 64; ++n) {
            if (n < 50) { const int a = CAND_A[n], b = CAND_B[n];
                const float s = __uint_as_float(__float_as_uint(v1[a]) & 0xffffff80u) + __uint_as_float(__float_as_uint(v2[b]) & 0xffffff80u);
                c[n >> 4][n & 15] = __uint_as_float((__float_as_uint(s) & 0xffffff00u) | (unsigned)((a << 4) | b)); }
            else c[n >> 4][n & 15] = -INFINITY;
        }
        sort16(c[0]); sort16(c[1]); merge16(c[0], c[1]); sort16(c[2]); merge16(c[0], c[2]); sort16(c[3]); merge16(c[0], c[3]);
        float g[16]; float sum = 0.f; const float m0 = __uint_as_float(__float_as_uint(c[0][0]) & 0xffffff00u);
#pragma unroll
        for (int i = 0; i < 16; ++i) { g[i] = __builtin_amdgcn_exp2f((__uint_as_float(__float_as_uint(c[0][i]) & 0xffffff00u) - m0) * LOG2E); sum += g[i]; }
        const float inv = __builtin_amdgcn_rcpf(sum);
        asm volatile("s_waitcnt lgkmcnt(0)" ::: "memory");
        unsigned ids[16];
#pragma unroll
        for (int i = 0; i < 16; ++i) { const unsigned code = __float_as_uint(c[0][i]) & 0xffu; ids[i] = (unsigned)lut[code >> 4] * NKEY + (unsigned)lut[16 + (code & 15)]; }
        if (hi == 0) {
            v4u s0, s1; s0.x = ids[0] | (ids[1] << 16); s0.y = ids[2] | (ids[3] << 16); s0.z = ids[4] | (ids[5] << 16); s0.w = ids[6] | (ids[7] << 16);
            s1.x = ids[8] | (ids[9] << 16); s1.y = ids[10] | (ids[11] << 16); s1.z = ids[12] | (ids[13] << 16); s1.w = ids[14] | (ids[15] << 16);
            GAS v4u* sp = (GAS v4u*)(SEL + trow * NSEL + h * PK); sp[0] = s0; sp[1] = s1;
        } else {
            GAS f32x4* gp = (GAS f32x4*)(GATE + trow * NSEL + h * PK);
#pragma unroll
            for (int i = 0; i < 4; ++i) gp[i] = (f32x4){g[4 * i] * inv, g[4 * i + 1] * inv, g[4 * i + 2] * inv, g[4 * i + 3] * inv};
        }
        asm volatile("s_waitcnt lgkmcnt(0)" ::: "memory");
    }
    __syncthreads();
}

constexpr float USCALE = 96.0f * 14.0f, VSCALE = 6.0f;
constexpr size_t SLICE_BYTES = (size_t)NEXP * 128;
typedef float f32x2v __attribute__((ext_vector_type(2)));
typedef _Float16 h2v __attribute__((ext_vector_type(2)));
__device__ __forceinline__ float gelu_tanh(float x) {
    const float u = 1.5957691216057308f * (x + 0.044715f * x * x * x);
    return x * __builtin_amdgcn_rcpf(1.0f + __builtin_amdgcn_exp2f(-u * LOG2E));
}
__device__ __forceinline__ float dpp_sum8(float v) {
    v += __builtin_bit_cast(float, __builtin_amdgcn_update_dpp(0, __builtin_bit_cast(int, v), 0xB1, 0xf, 0xf, true));
    v += __builtin_bit_cast(float, __builtin_amdgcn_update_dpp(0, __builtin_bit_cast(int, v), 0x4E, 0xf, 0xf, true));
    v += __builtin_bit_cast(float, __builtin_amdgcn_update_dpp(0, __builtin_bit_cast(int, v), 0x141, 0xf, 0xf, true));
    return v;
}
template <int NSL> __device__ __forceinline__ void slice_of_block(Frame& F, int which, int& s, int& gws, int& nws) {
#if SLICE_BY_XCC
    LAS unsigned* slot = (LAS unsigned*)(F.lds + MISC_OFF) + 16;
    if (F.tid == 0) {
        unsigned ok = (F.MISC[8] != 0u) ? 1u : 0u; unsigned* bw = (unsigned*)(F.ctl + CW_BAR); const unsigned x = xb_xcc_id(); unsigned mine = 0u;
        for (unsigned j = 0; j < 16; ++j) { const unsigned cnt = xb_ld(&bw[XB_XCNT(j)]); ok &= (j < 8) ? (cnt > 0u) : (cnt == 0u); if (j < 8 && (j & (NSL - 1)) == (x & (NSL - 1))) mine += cnt; }
        unsigned rank = 0u;
        if (ok) rank = xb_add((unsigned*)(F.ctl + CW_XRANK + (which * 16 + (int)(x & (NSL - 1))) * 64), 1u);
        slot[0] = ok; slot[1] = rank; slot[2] = x & (NSL - 1); slot[3] = mine;
    }
    __syncthreads();
    const unsigned ok = slot[0], rank = slot[1], x = slot[2], mine = slot[3];
    __syncthreads();
    if (ok) { s = (int)x; gws = (int)rank * NWAVES + F.wave; nws = (int)mine * NWAVES; return; }
#endif
    s = (int)(blockIdx.x & (NSL - 1)); gws = (int)(blockIdx.x / NSL) * NWAVES + F.wave; nws = ((F.G - s + NSL - 1) / NSL) * NWAVES;
}
struct TokIdx { v4u i0, i1; };
__device__ __forceinline__ unsigned sel_of(const TokIdx& I, int b) { const unsigned w = b < 8 ? I.i0[b >> 1] : I.i1[(b - 8) >> 1]; return (b & 1) ? (w >> 16) : (w & 0xffffu); }
#define LD_ROW(I, b) __builtin_bit_cast(v4u, __builtin_amdgcn_raw_buffer_load_b128(rsrc, (int)((sel_of(I, (b)) & EMASK) * 128u + lane16), 0, 0))
template <unsigned EMASK> __device__ __forceinline__ void p6_experts_u(Frame& F, float* PD, int which) {
    PHASE_IDS(F);
    const unsigned char* H1Q = F.ws + WS_H1Q; const unsigned short* SEL = (const unsigned short*)(F.ws + WS_SEL);
    int s, gws, nws; slice_of_block<4>(F, which, s, gws, nws);
    const __amdgpu_buffer_rsrc_t rsrc = __builtin_amdgcn_make_buffer_rsrc((void*)(F.ws + WS_EU + (size_t)s * SLICE_BYTES), 0, (int)SLICE_BYTES, 0x00020000);
    const unsigned lane16 = 16u * (F.lane & 7); const int g = F.lane >> 3, c = F.lane & 7;
    const unsigned short* selp = SEL + 16 * g; const unsigned char* hp = H1Q + 256 * s + 32 * c;
    struct HP { v4u h[2]; };
#define LD_IDX(I, H, tt) do { const size_t t_ = (size_t)((tt) < T ? (tt) : T - 1); I.i0 = *(const GAS v4u*)(selp + t_ * NSEL); I.i1 = *(const GAS v4u*)(selp + t_ * NSEL + 8); \
        H.h[0] = *(const GAS v4u*)(hp + t_ * DMODEL); H.h[1] = *(const GAS v4u*)(hp + t_ * DMODEL + 16); } while (0)
    TokIdx In, In2; HP hc, hn, h2; v4u r[16];
    int t = gws;
    if (t >= T) return;
    { TokIdx Ic; LD_IDX(Ic, hc, t); LD_IDX(In, hn, t + nws);
#pragma unroll
      for (int b = 0; b < 16; ++b) r[b] = LD_ROW(Ic, b); }
#pragma unroll 1
    for (; t < T; t += nws) {
        LD_IDX(In2, h2, t + 2 * nws);
        int hs = 0;
#pragma unroll
        for (int w = 0; w < 8; ++w) hs = __builtin_amdgcn_sdot4(0x01010101, (int)hc.h[w >> 2][w & 3], hs, false);
        const int seed = -8 * hs;
        float v0 = 0.f, v1 = 0.f;
#pragma unroll
        for (int b = 0; b < 16; ++b) {
            asm volatile("" : "+v"(r[b]));
            int a0 = seed, a1 = 0;
#pragma unroll
            for (int q = 0; q < 4; ++q) { const unsigned x = r[b][q];
                a0 = __builtin_amdgcn_sdot4((int)(x & 0x0F0F0F0Fu), (int)hc.h[q >> 1][2 * (q & 1)], a0, false);
                a1 = __builtin_amdgcn_sdot4((int)((x >> 4) & 0x0F0F0F0Fu), (int)hc.h[q >> 1][2 * (q & 1) + 1], a1, false); }
            float pr = dpp_sum8((float)(a0 + a1)); asm volatile("" : "+v"(pr));
            if (b & 1) v1 = (c == (b >> 1)) ? pr : v1; else v0 = (c == (b >> 1)) ? pr : v0;
            r[b] = LD_ROW(In, b);
        }
        *(GAS f32x2v*)(PD + ((size_t)t * 4 + s) * NSEL + 16 * g + 2 * c) = (f32x2v){v0, v1};
        In = In2; hc = hn; hn = h2;
    }
#undef LD_IDX
}
__device__ __forceinline__ void p6b_reduce(Frame& F) {
    PHASE_IDS(F);
    const float* PD = (const float*)(F.ws + WS_PD); const float* GATE = (const float*)(F.ws + WS_GATE); const float* SS1P = (const float*)(F.ws + WS_SS1P); float* WACT = (float*)(F.ws + WS_WACT);
    const int gw = F.vcu * NWAVES + F.wave, NGW = F.G * NWAVES;
#pragma unroll 1
    for (int t = gw; t < T; t += NGW) {
        float ssv = F.lane < 16 ? SS1P[(size_t)t * 16 + F.lane] : 0.f; ssv = wave_sum(ssv);
        const float rs2 = (1.0f / USCALE) / sqrtf(ssv * (1.0f / DMODEL) + EPS);
        f32x2v acc = (f32x2v){0.f, 0.f};
#pragma unroll
        for (int sl = 0; sl < 4; ++sl) acc += *(const GAS f32x2v*)(PD + ((size_t)t * 4 + sl) * NSEL + 2 * F.lane);
        const f32x2v gt = *(const GAS f32x2v*)(GATE + (size_t)t * NSEL + 2 * F.lane);
        const float w0_ = gt.x * gelu_tanh(acc.x * rs2), w1_ = gt.y * gelu_tanh(acc.y * rs2);
        ((GAS unsigned*)(F.ws + WS_WH))[(size_t)t * (NSEL / 2) + F.lane] = __builtin_bit_cast(unsigned, __builtin_amdgcn_cvt_pkrtz(w0_, w1_));
#if SELFCHECK
        *(GAS f32x2v*)(WACT + (size_t)t * NSEL + 2 * F.lane) = (f32x2v){w0_, w1_};
#endif
    }
}
__device__ __forceinline__ float xchg32(float send, bool up) { const auto rr = __builtin_amdgcn_permlane32_swap(__float_as_uint(send), __float_as_uint(send), false, false); return __uint_as_float(up ? rr[0] : rr[1]); }
__device__ __forceinline__ void p7_experts_v(Frame& F) {
    constexpr unsigned EMASK = 0xffffu;
    PHASE_IDS(F);
    const bf16* H1B = (const bf16*)(F.ws + WS_H1B); const unsigned short* SEL = (const unsigned short*)(F.ws + WS_SEL); const unsigned* WH = (const unsigned*)(F.ws + WS_WH);
    bf16* H2B = (bf16*)(F.ws + WS_H2B); float* SS2P = (float*)(F.ws + WS_SS2);
    int s, gws, nws; slice_of_block<4>(F, 1, s, gws, nws);
    const __amdgpu_buffer_rsrc_t rsrc = __builtin_amdgcn_make_buffer_rsrc((void*)(F.ws + WS_EV + (size_t)s * SLICE_BYTES), 0, (int)SLICE_BYTES, 0x00020000);
    const unsigned lane16 = 16u * (F.lane & 7); const int g = F.lane >> 3, c = F.lane & 7;
    const bool up32 = (F.lane & 32) != 0, up16 = (F.lane & 16) != 0, up8 = (F.lane & 8) != 0;
    const int k0 = (up32 ? 16 : 0) + (up16 ? 8 : 0) + (up8 ? 4 : 0);
    const unsigned short* selp = SEL + 16 * g; const unsigned* wp = WH + 8 * g; const bf16* hp = H1B + 256 * s + 32 * c + k0;
    typedef unsigned u32x2v __attribute__((ext_vector_type(2)));
#define LD_IDXW(I, W, HR, tt) do { const size_t t_ = (size_t)((tt) < T ? (tt) : T - 1); I.i0 = *(const GAS v4u*)(selp + t_ * NSEL); I.i1 = *(const GAS v4u*)(selp + t_ * NSEL + 8); \
        W[0] = *(const GAS v4u*)(wp + t_ * (NSEL / 2)); W[1] = *(const GAS v4u*)(wp + t_ * (NSEL / 2) + 4); HR = *(const GAS u32x2v*)(hp + t_ * DMODEL); } while (0)
    TokIdx In, In2; v4u wc[2], wn[2], w2[2]; u32x2v hrc, hrn, hr2; v4u r[16];
    int t = gws;
    if (t >= T) return;
    { TokIdx Ic; LD_IDXW(Ic, wc, hrc, t); LD_IDXW(In, wn, hrn, t + nws);
#pragma unroll
      for (int b = 0; b < 16; ++b) r[b] = LD_ROW(Ic, b); }
#pragma unroll 1
    for (; t < T; t += nws) {
        LD_IDXW(In2, w2, hr2, t + 2 * nws);
        h2v ov[16];
#pragma unroll
        for (int k = 0; k < 16; ++k) ov[k] = (h2v){(_Float16)0.f, (_Float16)0.f};
#pragma unroll
        for (int b = 0; b < 16; ++b) {
            const unsigned wu_ = (b >> 3) ? ((((b >> 1) & 3) == 0) ? wc[1].x : (((b >> 1) & 3) == 1) ? wc[1].y : (((b >> 1) & 3) == 2) ? wc[1].z : wc[1].w) : ((((b >> 1) & 3) == 0) ? wc[0].x : (((b >> 1) & 3) == 1) ? wc[0].y : (((b >> 1) & 3) == 2) ? wc[0].z : wc[0].w);
            const h2v wp_ = __builtin_bit_cast(h2v, wu_); const h2v wv = (b & 1) ? (h2v){wp_.y, wp_.y} : (h2v){wp_.x, wp_.x};
            asm volatile("" : "+v"(r[b]));
#pragma unroll
            for (int q = 0; q < 4; ++q) { ov[4 * q] += wv * __builtin_amdgcn_cvt_scalef32_pk_f16_fp4(r[b][q], 1.0f, 0); ov[4 * q + 1] += wv * __builtin_amdgcn_cvt_scalef32_pk_f16_fp4(r[b][q], 1.0f, 1);
                ov[4 * q + 2] += wv * __builtin_amdgcn_cvt_scalef32_pk_f16_fp4(r[b][q], 1.0f, 2); ov[4 * q + 3] += wv * __builtin_amdgcn_cvt_scalef32_pk_f16_fp4(r[b][q], 1.0f, 3); }
            r[b] = LD_ROW(In, b);
        }
#pragma unroll
        for (int i = 0; i < 8; ++i) { const h2v keep = up32 ? ov[8 + i] : ov[i], send = up32 ? ov[i] : ov[8 + i];
            ov[i] = keep + __builtin_bit_cast(h2v, __float_as_uint(xchg32(__uint_as_float(__builtin_bit_cast(unsigned, send)), up32))); }
#pragma unroll
        for (int i = 0; i < 4; ++i) { const h2v keep = up16 ? ov[4 + i] : ov[i], send = up16 ? ov[i] : ov[4 + i];
            ov[i] = keep + __builtin_bit_cast(h2v, (unsigned)__shfl_xor((int)__builtin_bit_cast(unsigned, send), 16)); }
        float o[4];
#pragma unroll
        for (int i = 0; i < 2; ++i) { const h2v keep = up8 ? ov[2 + i] : ov[i], send = up8 ? ov[i] : ov[2 + i];
            const h2v got = __builtin_bit_cast(h2v, (unsigned)__shfl_xor((int)__builtin_bit_cast(unsigned, send), 8));
            o[2 * i] = (float)keep.x + (float)got.x; o[2 * i + 1] = (float)keep.y + (float)got.y; }
        const float a0 = __uint_as_float(hrc.x << 16) + o[0] * (1.0f / VSCALE), a1 = __uint_as_float(hrc.x & 0xffff0000u) + o[1] * (1.0f / VSCALE);
        const float a2 = __uint_as_float(hrc.y << 16) + o[2] * (1.0f / VSCALE), a3 = __uint_as_float(hrc.y & 0xffff0000u) + o[3] * (1.0f / VSCALE);
        *(GAS u32x2v*)(H2B + (size_t)t * DMODEL + 256 * s + 32 * c + k0) = (u32x2v){pk2(a0, a1), pk2(a2, a3)};
        const float ss = wave_sum((a0 * a0 + a1 * a1) + (a2 * a2 + a3 * a3));
        if (F.lane == 0) SS2P[(size_t)t * 4 + s] = ss;
        In = In2; hrc = hrn; hrn = hr2;
#pragma unroll
        for (int q = 0; q < 2; ++q) { wc[q] = wn[q]; wn[q] = w2[q]; }
    }
#undef LD_ROW
#undef LD_IDXW
}

constexpr int N_PHASES = 10;
struct Args { const float* in[23]; float* out; unsigned char* ws; int ph_lo, ph_hi; };
__global__ void __launch_bounds__(NWAVES * 64, 2) mega_fwd(Args args) {
    extern __shared__ __attribute__((aligned(16))) unsigned char lds[];
    Frame F;
    F.lds = (LAS unsigned char*)lds;
    F.MISC = (volatile LAS unsigned*)(F.lds + MISC_OFF);
    F.tid = threadIdx.x; F.lane = F.tid & 63; F.wave = __builtin_amdgcn_readfirstlane(F.tid >> 6);
    F.G = gridDim.x; { const int bx = blockIdx.x; F.vcu = (F.G % 8 == 0) ? (bx % 8) * (F.G / 8) + bx / 8 : bx; }
    F.ws = args.ws; F.ctl = (gu32*)(args.ws + WS_CTL); F.out = args.out;
#pragma unroll
    for (int i = 0; i < 23; ++i) F.in[i] = args.in[i];
    for (int u = F.tid; u < (LDS_BYTES - LDSCTL_OFF) / 4; u += NWAVES * 64) ((LAS unsigned*)(F.lds + LDSCTL_OFF))[u] = 0u;
    __syncthreads();
    const int lo = args.ph_lo, hi = args.ph_hi;
    XcdBarrier bar; bar.bar = (unsigned*)(F.ctl + CW_BAR); bar.x = 0; bar.st = nullptr;
    if (hi - lo > 1) bar = xcd_barrier_post((unsigned*)(F.ctl + CW_BAR), F.MISC + 8);
#define IN(k) ((((PH_MASK) >> (k)) & 1) && lo <= (k) && (k) < hi)
#define SEAM(k) do { if (IN(k) && IN((k) + 1)) xcd_barrier(bar); } while (0)

    if (IN(0)) { p0_prologue(F); SEAM(0); }

    if (IN(1)) {
        p1_scan(F);
        pg8::Gemm g{(const pg8::bf16_t*)(F.ws + WS_XB), (const pg8::bf16_t*)(F.ws + WS_WI), T, NINP, DMODEL};
        pg8::StaticOrder S; S.init(T, NINP, F.G, (int)blockIdx.x);
        { const float* RS1 = (const float*)(F.ws + WS_RS1); LAS float* tab = (LAS float*)(F.lds + RSA_OFF); pg8::Unit u;
          float tv_[8]; int nu_ = 0;
#pragma unroll
          for (int i = 0; i < 8; ++i) { const bool ok_ = S.next(i, u); tv_[i] = (ok_ && F.tid < 256) ? RS1[u.pm * 256 + F.tid] : 0.f; nu_ += ok_ ? 1 : 0; }
#pragma unroll
          for (int i = 0; i < 8; ++i) if (i < nu_ && F.tid < 256) tab[i * 256 + F.tid] = tv_[i];
          __syncthreads(); }
        pg8::EpiInProj E{(pg8::bf16_t*)(F.ws + WS_QKV), (pg8::bf16_t*)(F.ws + WS_U), RSA_OFF - RING_OFF, F.in[I_Q_NORM], F.in[I_K_NORM]};
        pg8::gemm_phase<pg8::EpiInProj, pg8::StaticOrder, true, true>(F.lds + RING_OFF, g, S, E);
        SEAM(1);
    }

    if (IN(2)) {
        static_assert(attn_body::LDS_BYTES <= RING_BYTES, "attention LDS");
        const attn_body::AttnTensors AT{(const attn_body::bf16*)(F.ws + WS_QKV), (const attn_body::bf16*)(F.ws + WS_QKV) + 512, (const attn_body::bf16*)(F.ws + WS_QKV) + 1024,
                                        (attn_body::bf16*)(F.ws + WS_Y), (const float*)(F.ws + WS_G), (float*)(F.ws + WS_SSA)};
        const attn_body::StaticOrder S((int)F.G, (int)blockIdx.x);
        for (int r_ = 0; r_ < ATTN_REPS; ++r_) attn_body::attn_phase<attn_body::StaticOrder>((char*)lds + RING_OFF, AT, S);
        for (int r_ = 0; r_ < CONV_REPS; ++r_) p2_conv(F);
        SEAM(2);
    }

    if (IN(3)) {
        pg8::Gemm g{(const pg8::bf16_t*)(F.ws + WS_Y), (const pg8::bf16_t*)(F.ws + WS_WO), T, DMODEL, DMODEL};
        pg8::StaticOrder S; S.init(T, DMODEL, F.G, (int)blockIdx.x);
        { const float* SSA = (const float*)(F.ws + WS_SSA); LAS float* tab = (LAS float*)(F.lds + RSA_OFF); pg8::Unit u;
          for (int i = 0; i < 8 && S.next(i, u); ++i) if (F.tid < 256) { const int row = u.pm * 256 + F.tid;
              const f32x4 s0 = *(const f32x4*)(SSA + (size_t)row * 8), s1 = *(const f32x4*)(SSA + (size_t)row * 8 + 4);
              tab[i * 256 + F.tid] = 1.0f / sqrtf(((s0.x + s0.y) + (s0.z + s0.w) + (s1.x + s1.y) + (s1.z + s1.w)) * (1.0f / DATT) + EPS); }
          __syncthreads(); }
        pg8::EpiOutProj E{F.in[I_X], (pg8::bf16_t*)(F.ws + WS_H1B), (float*)(F.ws + WS_SS1P), (const float*)(F.ws + WS_SSA), F.ws + WS_H1Q, RSA_OFF - RING_OFF};
        pg8::gemm_phase<pg8::EpiOutProj, pg8::StaticOrder, true, true>(F.lds + RING_OFF, g, S, E);
        SEAM(3);
    }
    if (IN(4)) {
        pg8::Gemm g{(const pg8::bf16_t*)(F.ws + WS_H1B), (const pg8::bf16_t*)(F.ws + WS_WQ), T, PH * PQ, DMODEL};
        pg8::StaticOrder S; S.init(T, PH * PQ, F.G, (int)blockIdx.x);
        { const float* SS1P = (const float*)(F.ws + WS_SS1P); LAS float* tab = (LAS float*)(F.lds + RSA_OFF); pg8::Unit u;
          for (int i0 = 0; i0 < 8; i0 += 4) {
          f32x4 tb_[4][4]; int nu_ = 0;
#pragma unroll
          for (int i = 0; i < 4; ++i) { const bool ok_ = S.next(i0 + i, u); const float* sp = SS1P + ((ok_ && F.tid < 256) ? (size_t)(u.pm * 256 + F.tid) : 0) * 16;
#pragma unroll
              for (int q4_ = 0; q4_ < 4; ++q4_) tb_[i][q4_] = *(const f32x4*)(sp + 4 * q4_); nu_ += ok_ ? 1 : 0; }
#pragma unroll
          for (int i = 0; i < 4; ++i) if (i < nu_ && F.tid < 256) { float s = 0.f;
#pragma unroll
              for (int q4_ = 0; q4_ < 4; ++q4_) { const f32x4 v = tb_[i][q4_]; s += (v.x + v.y) + (v.z + v.w); }
              tab[(i0 + i) * 256 + F.tid] = 1.0f / sqrtf(s * (1.0f / DMODEL) + EPS); }
          if (nu_ < 4) break; }
          __syncthreads(); }
        pg8::EpiRowScale E{(pg8::bf16_t*)(F.ws + WS_QP), 0, RSA_OFF - RING_OFF};
        pg8::gemm_phase<pg8::EpiRowScale, pg8::StaticOrder, true, true>(F.lds + RING_OFF, g, S, E);
        SEAM(4);
    }
    if (IN(5)) { p5_topk(F); SEAM(5); }
    if (IN(6)) {
        pg8::Gemm g{(const pg8::bf16_t*)(F.ws + WS_PB), (const pg8::bf16_t*)(F.ws + WS_WP), T, DMODEL, DPLE};
        pg8::StaticOrder S; S.init(T, DMODEL, F.G, (int)blockIdx.x);
        pg8::EpiRowScale E{(pg8::bf16_t*)(F.ws + WS_PLE), DMODEL, -1};
        pg8::gemm_phase<pg8::EpiRowScale, pg8::StaticOrder, true, true>(F.lds + RING_OFF, g, S, E);
        p6_experts_u<0xffffu>(F, (float*)(F.ws + WS_PD), 0);
#if PROBE_U
        p6_experts_u<PROBE_U_MASK>(F, F.out, 2);
#endif
        SEAM(6);
    }
    if (IN(7)) { p6b_reduce(F); SEAM(7); }
    if (IN(8)) { p7_experts_v(F); SEAM(8); }
    if (IN(9)) {
        pg8::Gemm g{(const pg8::bf16_t*)(F.ws + WS_H2B), (const pg8::bf16_t*)(F.ws + WS_WG), T, DMODEL, DMODEL};
        pg8::StaticOrder S; S.init(T, DMODEL, F.G, (int)blockIdx.x);
        { const float* SS2P = (const float*)(F.ws + WS_SS2); LAS float* tab = (LAS float*)(F.lds + RSA_OFF); pg8::Unit u;
          for (int i = 0; i < 8 && S.next(i, u); ++i) if (F.tid < 256) { const f32x4 v0 = *(const f32x4*)(SS2P + (size_t)(u.pm * 256 + F.tid) * 4);
              tab[i * 256 + F.tid] = 1.0f / sqrtf(((v0.x + v0.y) + (v0.z + v0.w)) * (1.0f / DMODEL) + EPS); }
          __syncthreads(); }
        pg8::EpiFinal E{(const pg8::bf16_t*)(F.ws + WS_H2B), (const pg8::bf16_t*)(F.ws + WS_PLE), RSA_OFF - RING_OFF, F.out};
        pg8::gemm_phase<pg8::EpiFinal, pg8::StaticOrder, true, true>(F.lds + RING_OFF, g, S, E);
    }

#undef IN
#undef SEAM
}

#if SELFCHECK
namespace chk {
constexpr int NS = 64;
__device__ __forceinline__ int sample_token(int i) {
    switch (i) { case 0: return 0; case 1: return 2047; case 2: return 2048; case 3: return T - 1; case 4: return 255; case 5: return 256; case 6: return 31; case 7: return 2048 * 7 + 1000; default: break; }
    return (int)(((long)i * 7919 + 13) % T);
}
__device__ __forceinline__ float bf2f(unsigned short v) { return __uint_as_float((unsigned)v << 16); }
__device__ float block_sum(float v, float* red) {
    for (int o = 1; o < 64; o <<= 1) v += __shfl_xor(v, o);
    const int w = threadIdx.x >> 6, nw = blockDim.x >> 6;
    __syncthreads(); if ((threadIdx.x & 63) == 0) red[w] = v; __syncthreads();
    float t = 0.f; for (int i = 0; i < nw; ++i) t += red[i];
    return t;
}
__device__ float block_max(float v, float* red) {
    for (int o = 1; o < 64; o <<= 1) v = fmaxf(v, __shfl_xor(v, o));
    const int w = threadIdx.x >> 6, nw = blockDim.x >> 6;
    __syncthreads(); if ((threadIdx.x & 63) == 0) red[w] = v; __syncthreads();
    float t = red[0]; for (int i = 1; i < nw; ++i) t = fmaxf(t, red[i]);
    return t;
}
__device__ void verdict(unsigned* code, int bit, float d2, float r2, float tol) { if (threadIdx.x == 0 && !(d2 <= tol * tol * r2 + 1e-10f)) atomicOr(code, 1u << bit); }

__global__ void __launch_bounds__(256) chk_inproj(Args a) {
    __shared__ float zs[NIN]; __shared__ float xs[DMODEL]; __shared__ float msq[16]; __shared__ float red[8];
    const int t = sample_token(blockIdx.x), tid = threadIdx.x; unsigned* code = (unsigned*)(a.ws + WS_CTL) + CW_CODE;
    const float* x = a.in[I_X] + (size_t)t * DMODEL; float s = 0.f;
    for (int k = tid; k < DMODEL; k += 256) s += x[k] * x[k];
    const float rs = 1.0f / sqrtf(block_sum(s, red) / DMODEL + EPS);
    for (int k = tid; k < DMODEL; k += 256) xs[k] = x[k] * rs * a.in[I_LN_MIX][k];
    __syncthreads();
    for (int c = tid; c < NIN; c += 256) { float acc = 0.f; const float* w = a.in[I_W_IN] + c; for (int k = 0; k < DMODEL; ++k) acc += xs[k] * w[(size_t)k * NIN]; zs[c] = acc; }
    __syncthreads();
    if (tid < 16) { float m = 0.f; for (int d = 0; d < 64; ++d) { const float v = zs[64 * tid + d]; m += v * v; } msq[tid] = m / 64.f; }
    __syncthreads();
    const unsigned short* QKV = (const unsigned short*)(a.ws + WS_QKV) + (size_t)t * 1536; const unsigned short* U = (const unsigned short*)(a.ws + WS_U) + (size_t)t * 512;
    float d2[5] = {0, 0, 0, 0, 0}, r2[5] = {0, 0, 0, 0, 0};
    for (int i = tid; i < 512; i += 256) { const int h = i >> 6, d = i & 63;
        float e = zs[i] / sqrtf(msq[h] + EPS) * a.in[I_Q_NORM][d] * pg8::ATT_C2, v = bf2f(QKV[i]); d2[0] += (e - v) * (e - v); r2[0] += e * e;
        e = zs[512 + i] / sqrtf(msq[8 + h] + EPS) * a.in[I_K_NORM][d]; v = bf2f(QKV[512 + i]); d2[1] += (e - v) * (e - v); r2[1] += e * e;
        e = zs[1024 + i]; v = bf2f(QKV[1024 + i]); d2[2] += (e - v) * (e - v); r2[2] += e * e;
        e = zs[COL_A + i] / (1.f + expf(-zs[COL_G + i])); v = bf2f(U[i]); d2[3] += (e - v) * (e - v); r2[3] += e * e; }
    if (tid < 8) { const float z = zs[COL_F + tid] + a.in[I_B_FGATE][tid]; const float e = (fminf(z, 0.f) - log1pf(expf(-fabsf(z)))) * LOG2E, v = ((const float*)(a.ws + WS_LF))[(size_t)t * 8 + tid]; d2[4] += (e - v) * (e - v); r2[4] += e * e; }
    for (int g = 0; g < 5; ++g) { const float dd = block_sum(d2[g], red), rr = block_sum(r2[g], red); verdict(code, g, dd, rr, 2e-2f); }
}
__global__ void chk_scan(Args a) {
    const int i = threadIdx.x; unsigned* code = (unsigned*)(a.ws + WS_CTL) + CW_CODE;
    const int bh = (i * 5) % (BATCH * NH), s = i == 0 ? 0 : (i == 1 ? SEQ - 1 : (i * 331 + 77) % SEQ), b = bh >> 3, h = bh & 7;
    const float* LF = (const float*)(a.ws + WS_LF); double acc = 0.0; for (int u = 0; u <= s; ++u) acc += LF[((size_t)b * SEQ + u) * 8 + h];
    const float v = ((const float*)(a.ws + WS_G))[(size_t)bh * SEQ + s];
    if (!(fabsf(v - (float)acc) <= 2e-3f * (1.f + fabsf((float)acc)))) atomicOr(code, 1u << 5);
}
__global__ void __launch_bounds__(256) chk_attn(Args a) {
    __shared__ float l[SEQ]; __shared__ float qs[64]; __shared__ float part[4][64]; __shared__ float red[8];
    const int t = sample_token(blockIdx.x), h = blockIdx.x & 7, tid = threadIdx.x, b = t / SEQ, st = t % SEQ; unsigned* code = (unsigned*)(a.ws + WS_CTL) + CW_CODE;
    const unsigned short* QKV = (const unsigned short*)(a.ws + WS_QKV); const float* G = (const float*)(a.ws + WS_G) + (size_t)(b * NH + h) * SEQ;
    if (tid < 64) qs[tid] = bf2f(QKV[(size_t)t * 1536 + 64 * h + tid]);
    __syncthreads();
    float mx = -INFINITY;
    for (int s = tid; s <= st; s += 256) { const unsigned short* kr = QKV + ((size_t)b * SEQ + s) * 1536 + 512 + 64 * h; float acc = 0.f; for (int d = 0; d < 64; ++d) acc += qs[d] * bf2f(kr[d]);
        acc += G[st] - G[s]; l[s] = acc; mx = fmaxf(mx, acc); }
    mx = block_max(mx, red);
    float sm = 0.f; for (int s = tid; s <= st; s += 256) { const float p = exp2f(l[s] - mx); l[s] = p; sm += p; }
    sm = block_sum(sm, red);
    { const int d = tid & 63, pt = tid >> 6; float acc = 0.f; for (int s = pt; s <= st; s += 4) acc += l[s] * bf2f(QKV[((size_t)b * SEQ + s) * 1536 + 1024 + 64 * h + d]); part[pt][d] = acc; }
    __syncthreads();
    float d2 = 0.f, r2 = 0.f, e2 = 0.f;
    if (tid < 64) { const float e = (part[0][tid] + part[1][tid] + part[2][tid] + part[3][tid]) / sm, v = bf2f(((const unsigned short*)(a.ws + WS_Y))[(size_t)t * 1024 + 64 * h + tid]); d2 = (e - v) * (e - v); r2 = e * e; e2 = e * e; }
    d2 = block_sum(d2, red); r2 = block_sum(r2, red); verdict(code, 6, d2, r2, 3e-2f);
    if (tid == 0) { const float v = ((const float*)(a.ws + WS_SSA))[(size_t)t * 8 + h]; if (!(fabsf(v - r2) <= 0.05f * r2 + 1e-6f)) atomicOr(code, 1u << 7); }
}
__global__ void __launch_bounds__(512) chk_conv(Args a) {
    __shared__ float red[8];
    const int t = sample_token(blockIdx.x), c = threadIdx.x, b = t / SEQ, st = t % SEQ; unsigned* code = (unsigned*)(a.ws + WS_CTL) + CW_CODE;
    const unsigned short* U = (const unsigned short*)(a.ws + WS_U);
    float y = a.in[I_CONV_B][c];
    for (int j = 0; j < CW; ++j) { const int s = st - 30 + j; if (s >= 0) y += a.in[I_CONV_W][j * DCONV + c] * bf2f(U[((size_t)b * SEQ + s) * DCONV + c]); }
    const float mu = block_sum(y, red) / DCONV; const float var = block_sum((y - mu) * (y - mu), red) / DCONV;
    const float ln = (y - mu) / sqrtf(var + LN_EPS) * a.in[I_CONV_LN_G][c] + a.in[I_CONV_LN_B][c]; const float sw = ln / (1.f + expf(-ln));
    const float ss = block_sum(sw * sw, red) / DCONV; const float e = sw / sqrtf(ss + EPS);
    const float v = bf2f(((const unsigned short*)(a.ws + WS_Y))[(size_t)t * 1024 + 512 + c]);
    const float d2 = block_sum((e - v) * (e - v), red), r2 = block_sum(e * e, red); verdict(code, 8, d2, r2, 2e-2f);
}
__device__ __forceinline__ size_t qp_elem(int t, int n) { const int head = n >> 8, w = n & 255, half = w >> 7, cc = w & 127; return pg8::qpf_byte(t, head, half, cc >> 4, (cc >> 3) & 1) / 2 + (cc & 7); }
__device__ void dense_row(const float* a, int K, const float* W, int ldw, int N, float* out) {
    for (int n = threadIdx.x; n < N; n += blockDim.x) { float acc = 0.f; for (int k = 0; k < K; ++k) acc += a[k] * W[(size_t)k * ldw + n]; out[n] = acc; }
}
__global__ void __launch_bounds__(256) chk_outproj(Args a) {
    __shared__ float ys[DMODEL]; __shared__ float hs[DMODEL]; __shared__ float red[8];
    const int t = sample_token(blockIdx.x), tid = threadIdx.x; unsigned* code = (unsigned*)(a.ws + WS_CTL) + CW_CODE;
    const unsigned short* Y = (const unsigned short*)(a.ws + WS_Y) + (size_t)t * DMODEL;
    float s = 0.f; for (int c = tid; c < DATT; c += 256) { const float v = bf2f(Y[c]); s += v * v; }
    const float rsa = 1.0f / sqrtf(block_sum(s, red) / DATT + EPS);
    for (int c = tid; c < DMODEL; c += 256) ys[c] = c < DATT ? bf2f(Y[c]) * rsa * a.in[I_ATTN_OUT_NORM][c] : bf2f(Y[c]) * a.in[I_CONV_OUT_NORM][c - DATT];
    __syncthreads();
    dense_row(ys, DMODEL, a.in[I_W_OUT], DMODEL, DMODEL, hs);
    __syncthreads();
    float d2 = 0.f, r2 = 0.f;
    for (int n = tid; n < DMODEL; n += 256) { const float e = a.in[I_X][(size_t)t * DMODEL + n] + hs[n], v = bf2f(((const unsigned short*)(a.ws + WS_H1B))[(size_t)t * DMODEL + n]); d2 += (e - v) * (e - v); r2 += e * e; }
    d2 = block_sum(d2, red); r2 = block_sum(r2, red); verdict(code, 9, d2, r2, 2e-2f);
    if (tid == 0) { float ss = 0.f; for (int i = 0; i < 16; ++i) ss += ((const float*)(a.ws + WS_SS1P))[(size_t)t * 16 + i]; if (!(fabsf(ss - r2) <= 0.03f * r2)) atomicOr(code, 1u << 10); }
}
__global__ void __launch_bounds__(256) chk_peerq(Args a) {
    __shared__ float xs[DMODEL]; __shared__ float qs[PH * PQ]; __shared__ float red[8];
    const int t = sample_token(blockIdx.x), tid = threadIdx.x; unsigned* code = (unsigned*)(a.ws + WS_CTL) + CW_CODE;
    const unsigned short* H = (const unsigned short*)(a.ws + WS_H1B) + (size_t)t * DMODEL;
    float s = 0.f; for (int c = tid; c < DMODEL; c += 256) { const float v = bf2f(H[c]); s += v * v; }
    const float rs = 1.0f / sqrtf(block_sum(s, red) / DMODEL + EPS);
    for (int c = tid; c < DMODEL; c += 256) xs[c] = bf2f(H[c]) * rs * a.in[I_LN_FFN][c];
    __syncthreads();
    dense_row(xs, DMODEL, a.in[I_W_PEER_Q], PH * PQ, PH * PQ, qs);
    __syncthreads();
    float d2 = 0.f, r2 = 0.f;
    for (int n = tid; n < PH * PQ; n += 256) { const float e = qs[n], v = bf2f(((const unsigned short*)(a.ws + WS_QP))[qp_elem(t, n)]); d2 += (e - v) * (e - v); r2 += e * e; }
    d2 = block_sum(d2, red); r2 = block_sum(r2, red); verdict(code, 11, d2, r2, 2e-2f);
}
__global__ void __launch_bounds__(256) chk_topk(Args a) {
    __shared__ float s1[NKEY], s2[NKEY]; __shared__ float red[8]; __shared__ int bad;
    const int t = sample_token(blockIdx.x), h = (blockIdx.x * 3) & 7, tid = threadIdx.x; unsigned* code = (unsigned*)(a.ws + WS_CTL) + CW_CODE;
    const unsigned short* QPp = (const unsigned short*)(a.ws + WS_QP);
    if (tid == 0) bad = 0;
    { const int k = tid & 127, half = tid >> 7; const float* sk = (half ? a.in[I_SUB_KEYS2] : a.in[I_SUB_KEYS1]) + (size_t)k * PHALF; float acc = 0.f;
      for (int d = 0; d < PHALF; ++d) acc += bf2f(QPp[qp_elem(t, h * PQ + half * PHALF + d)]) * sk[d];
      if (half) s2[k] = acc; else s1[k] = acc; }
    __syncthreads();
    const unsigned short* sel = (const unsigned short*)(a.ws + WS_SEL) + (size_t)t * NSEL + h * PK; const float* gate = (const float*)(a.ws + WS_GATE) + (size_t)t * NSEL + h * PK;
    float cs[PK]; float mx = -INFINITY;
    for (int i = 0; i < PK; ++i) { const int e = sel[i]; cs[i] = s1[e >> 7] + s2[e & 127]; mx = fmaxf(mx, cs[i]); }
    for (int i = 0; i < PK; ++i) {
        int cnt = 0; for (int c = tid; c < NKEY * NKEY; c += 256) cnt += (s1[c >> 7] + s2[c & 127] > cs[i] + 2e-2f) ? 1 : 0;
        const float tot = block_sum((float)cnt, red); if (tid == 0 && tot >= 16.f) bad = 1;
        for (int j = 0; j < i; ++j) if (tid == 0 && sel[j] == sel[i]) bad = 1;
    }
    if (tid == 0) { float sum = 0.f; for (int i = 0; i < PK; ++i) sum += expf(cs[i] - mx);
        for (int i = 0; i < PK; ++i) { const float e = expf(cs[i] - mx) / sum; if (!(fabsf(gate[i] - e) <= 0.02f * e + 1e-4f)) bad = 1; }
        if (bad) atomicOr(code, 1u << 12); }
}
__global__ void __launch_bounds__(256) chk_experts(Args a) {
    __shared__ float xs[DMODEL]; __shared__ float ws_[NSEL]; __shared__ float red[8];
    const int t = sample_token(blockIdx.x), tid = threadIdx.x; unsigned* code = (unsigned*)(a.ws + WS_CTL) + CW_CODE;
    const unsigned short* H = (const unsigned short*)(a.ws + WS_H1B) + (size_t)t * DMODEL;
    float s = 0.f; for (int c = tid; c < DMODEL; c += 256) { const float v = bf2f(H[c]); s += v * v; }
    const float rs = 1.0f / sqrtf(block_sum(s, red) / DMODEL + EPS);
    for (int c = tid; c < DMODEL; c += 256) xs[c] = bf2f(H[c]) * rs * a.in[I_LN_FFN][c];
    __syncthreads();
    const unsigned short* sel = (const unsigned short*)(a.ws + WS_SEL) + (size_t)t * NSEL; const float* gate = (const float*)(a.ws + WS_GATE) + (size_t)t * NSEL;
    float d2 = 0.f, r2 = 0.f;
    if (tid < NSEL) { const float* u = a.in[I_EXPERT_U] + (size_t)sel[tid] * DMODEL; float acc = 0.f; for (int d = 0; d < DMODEL; ++d) acc += u[d] * xs[d];
        const float act = 0.5f * acc * (1.f + tanhf(0.7978845608028654f * (acc + 0.044715f * acc * acc * acc))); const float e = gate[tid] * act, v = ((const float*)(a.ws + WS_WACT))[(size_t)t * NSEL + tid];
        ws_[tid] = e; d2 = (e - v) * (e - v); r2 = e * e; }
    d2 = block_sum(d2, red); r2 = block_sum(r2, red); verdict(code, 13, d2, r2, 2.5e-1f);
    __syncthreads();
    d2 = 0.f; r2 = 0.f;
    for (int d = tid; d < DMODEL; d += 256) { float acc = bf2f(H[d]); for (int j = 0; j < NSEL; ++j) acc += ws_[j] * a.in[I_EXPERT_V][(size_t)sel[j] * DMODEL + d];
        const float v = bf2f(((const unsigned short*)(a.ws + WS_H2B))[(size_t)t * DMODEL + d]); d2 += (acc - v) * (acc - v); r2 += acc * acc; }
    d2 = block_sum(d2, red); r2 = block_sum(r2, red); verdict(code, 14, d2, r2, 5e-2f);
    if (tid == 0) { float ss = 0.f; for (int i = 0; i < 4; ++i) ss += ((const float*)(a.ws + WS_SS2))[(size_t)t * 4 + i]; if (!(fabsf(ss - r2) <= 0.03f * r2)) atomicOr(code, 1u << 15); }
}
__global__ void __launch_bounds__(256) chk_ple(Args a) {
    __shared__ float ps[DPLE]; __shared__ float os[DMODEL]; __shared__ float red[8];
    const int t = sample_token(blockIdx.x), tid = threadIdx.x; unsigned* code = (unsigned*)(a.ws + WS_CTL) + CW_CODE;
    for (int c = tid; c < DPLE; c += 256) ps[c] = a.in[I_P][(size_t)t * DPLE + c];
    __syncthreads();
    dense_row(ps, DPLE, a.in[I_W_PL_PROJ], DMODEL, DMODEL, os);
    __syncthreads();
    float d2 = 0.f, r2 = 0.f;
    for (int n = tid; n < DMODEL; n += 256) { const float e = os[n], v = bf2f(((const unsigned short*)(a.ws + WS_PLE))[(size_t)t * DMODEL + n]); d2 += (e - v) * (e - v); r2 += e * e; }
    d2 = block_sum(d2, red); r2 = block_sum(r2, red); verdict(code, 16, d2, r2, 2e-2f);
}
__global__ void __launch_bounds__(256) chk_final(Args a) {
    __shared__ float xs[DMODEL]; __shared__ float gs[DMODEL]; __shared__ float red[8];
    const int t = sample_token(blockIdx.x), tid = threadIdx.x; unsigned* code = (unsigned*)(a.ws + WS_CTL) + CW_CODE;
    const unsigned short* H = (const unsigned short*)(a.ws + WS_H2B) + (size_t)t * DMODEL;
    float s = 0.f; for (int c = tid; c < DMODEL; c += 256) { const float v = bf2f(H[c]); s += v * v; }
    const float rs = 1.0f / sqrtf(block_sum(s, red) / DMODEL + EPS);
    for (int c = tid; c < DMODEL; c += 256) xs[c] = bf2f(H[c]) * rs * a.in[I_LN_PL][c];
    __syncthreads();
    dense_row(xs, DMODEL, a.in[I_W_PL_GATE], DMODEL, DMODEL, gs);
    __syncthreads();
    float d2 = 0.f, r2 = 0.f;
    for (int n = tid; n < DMODEL; n += 256) { const float e = bf2f(H[n]) + bf2f(((const unsigned short*)(a.ws + WS_PLE))[(size_t)t * DMODEL + n]) / (1.f + expf(-gs[n])), v = a.out[(size_t)t * DMODEL + n]; d2 += (e - v) * (e - v); r2 += e * e; }
    d2 = block_sum(d2, red); r2 = block_sum(r2, red); verdict(code, 17, d2, r2, 1e-2f);
}

__global__ void finish(Args a, int complete) {
    const unsigned code = ((const unsigned*)(a.ws + WS_CTL))[CW_CODE];
    const float add = code ? 1000.f * (float)(1 + __builtin_ctz(code)) : 0.f;
    for (size_t i = (size_t)blockIdx.x * blockDim.x + threadIdx.x; i < (size_t)T * DMODEL; i += (size_t)gridDim.x * blockDim.x) a.out[i] = (complete ? a.out[i] : 0.f) + add;
}
}
#endif

extern "C" void kernel_launch(void* const* d_in, const int* in_sizes, int n_in, void* d_out, int out_size, void* d_ws, size_t ws_size, hipStream_t stream) {
    static int grid = 0;
    if (grid == 0) {
        if (n_in != 23 || in_sizes[0] != T * DMODEL || out_size != T * DMODEL || ws_size < WS_END) { fprintf(stderr, "kernel_launch: unexpected problem (n_in %d, in0 %d, out %d, ws %zu); nothing launched\n", n_in, n_in > 0 ? in_sizes[0] : -1, out_size, ws_size); grid = -1; return; }
        int dev = 0, cus = 0, per_cu = 0;
        if (hipGetDevice(&dev) != hipSuccess || hipDeviceGetAttribute(&cus, hipDeviceAttributeMultiprocessorCount, dev) != hipSuccess) { grid = -1; return; }
        if (hipFuncSetAttribute((const void*)mega_fwd, hipFuncAttributeMaxDynamicSharedMemorySize, LDS_BYTES) != hipSuccess) { fprintf(stderr, "kernel_launch: hipFuncSetAttribute failed\n"); grid = -1; return; }
        if (hipOccupancyMaxActiveBlocksPerMultiprocessor(&per_cu, (const void*)mega_fwd, NWAVES * 64, LDS_BYTES) != hipSuccess || per_cu < 1) { fprintf(stderr, "kernel_launch: occupancy query says %d\n", per_cu); per_cu = 1; }
        (void)hipGetLastError();
        grid = cus;
    }
    if (grid < 0) return;
    (void)hipMemsetAsync((char*)d_ws + WS_CTL, 0, CTL_ZERO_BYTES, stream);
    Args a{};
    for (int i = 0; i < 23; ++i) a.in[i] = (const float*)d_in[i];
    a.out = (float*)d_out; a.ws = (unsigned char*)d_ws;
    constexpr int LASTP = LAST_PHASE < N_PHASES - 1 ? LAST_PHASE : N_PHASES - 1;
#if MK_ONE_LAUNCH
    a.ph_lo = 0; a.ph_hi = LASTP + 1;
    void* kargs[] = {&a};
    hipError_t e = hipLaunchCooperativeKernel((const void*)mega_fwd, dim3(grid), dim3(NWAVES * 64), kargs, LDS_BYTES, stream);
    if (e != hipSuccess) fprintf(stderr, "kernel_launch: cooperative launch failed: %s (grid %d)\n", hipGetErrorString(e), grid);
#else
    for (int ph = 0; ph <= LASTP; ++ph) {
        a.ph_lo = ph; a.ph_hi = ph + 1;
        for (int rep = 0; rep < 1 + (((REPEAT_MASK) >> ph) & 1) * (REPEAT_N - 1); ++rep) hipLaunchKernelGGL(mega_fwd, dim3(grid), dim3(NWAVES * 64), LDS_BYTES, stream, a);
#if SELFCHECK
        if (ph == 1) { hipLaunchKernelGGL(chk::chk_inproj, dim3(chk::NS), dim3(256), 0, stream, a); hipLaunchKernelGGL(chk::chk_scan, dim3(1), dim3(64), 0, stream, a); }
        if (ph == 2) { hipLaunchKernelGGL(chk::chk_attn, dim3(chk::NS), dim3(256), 0, stream, a); hipLaunchKernelGGL(chk::chk_conv, dim3(chk::NS), dim3(512), 0, stream, a); }
                if (ph == 3) hipLaunchKernelGGL(chk::chk_outproj, dim3(chk::NS), dim3(256), 0, stream, a);
        if (ph == 4) hipLaunchKernelGGL(chk::chk_peerq, dim3(chk::NS), dim3(256), 0, stream, a);
        if (ph == 5) hipLaunchKernelGGL(chk::chk_topk, dim3(chk::NS), dim3(256), 0, stream, a);
        if (ph == 6) hipLaunchKernelGGL(chk::chk_ple, dim3(chk::NS), dim3(256), 0, stream, a);
        if (ph == 8) hipLaunchKernelGGL(chk::chk_experts, dim3(chk::NS), dim3(256), 0, stream, a);
        if (ph == 9) hipLaunchKernelGGL(chk::chk_final, dim3(chk::NS), dim3(256), 0, stream, a);

#endif
    }
#endif
#if SELFCHECK
    hipLaunchKernelGGL(chk::finish, dim3(2048), dim3(256), 0, stream, a, (int)(LASTP == N_PHASES - 1));
#endif
}
```

```cpp
#include <hip/hip_runtime.h>
#include <hip/hip_bf16.h>
#include <cstdio>
#include <cstdint>
#include <cmath>

#define MK_ONE_LAUNCH 1
#define SELFCHECK 0
#ifndef LAST_PHASE
#define LAST_PHASE 99
#endif

#ifndef SLICE_BY_XCC
#define SLICE_BY_XCC 1
#endif
#ifndef ATTN_REPS
#define ATTN_REPS 1
#endif
#ifndef CONV_REPS
#define CONV_REPS 1
#endif
#ifndef PROBE_U
#define PROBE_U 0
#endif
#ifndef PROBE_U_MASK
#define PROBE_U_MASK 0xffffu
#endif
#ifndef REPEAT_MASK
#define REPEAT_MASK 0
#endif
#ifndef REPEAT_N
#define REPEAT_N 2
#endif
#ifndef PH_MASK
#define PH_MASK 0x3ff
#endif

constexpr int BATCH = 16, SEQ = 2048, DMODEL = 1024, T = BATCH * SEQ;
constexpr int DATT = 512, NH = 8, HD = 64, DCONV = 512, CW = 31;
constexpr int NIN = 2568, NINP = 2560;
constexpr int COL_F = 1536, COL_A = 1544, COL_G = 2056;
constexpr int NKEY = 128, NEXP = 16384, PH = 8, PQ = 256, PHALF = 128, PK = 16, NSEL = PH * PK;
constexpr int DPLE = 256;
constexpr float EPS = 1e-6f, LN_EPS = 1e-5f;
constexpr float LOG2E = 1.4426950408889634f;

namespace pg8 {
#define PG8_LAS __attribute__((address_space(3)))
typedef unsigned short bf16_t;
typedef short bf16x8 __attribute__((ext_vector_type(8)));
typedef float f32x4 __attribute__((ext_vector_type(4)));
typedef unsigned u32x4 __attribute__((ext_vector_type(4)));
constexpr int BM = 256, BK = 64, HALF = 128, HTB = HALF * BK * 2  , STAGE_BYTES = 8 * HTB, NXCD = 8, WGM = 8;

__host__ __device__ __forceinline__ int lds_byte(int r, int c) { const int st = (r >> 4) * 2 + (c >> 5), rr = r & 15, cc = c & 31, ob = rr * 64 + cc * 2; return st * 1024 + (ob ^ (((ob >> 9) & 1) << 5)); }
__host__ __device__ __forceinline__ void stage_rc(int b, int& R, int& C) { const int st = b / 1024, sb = b % 1024, swz = sb ^ (((sb >> 9) & 1) << 5); R = (st >> 1) * 16 + swz / 64; C = (st & 1) * 32 + (swz % 64) / 2; }
__host__ __device__ __forceinline__ int perm32(int rho) { const int n = rho >> 4, i = rho & 15; return 8 * (i >> 2) + 4 * n + (i & 3); }

struct Unit { int pm, pn; };
struct Gemm { const bf16_t* A; const bf16_t* Bt; int M, N, K; };

struct StaticOrder {
    int nM, nN, nwg, G, c;
    __host__ __device__ __forceinline__ void init(int M, int N, int G_, int c_) { nM = M / BM; nN = N / BM; nwg = nM * nN; G = G_; c = c_; }
    __host__ __device__ __forceinline__ bool next(int i, Unit& u) const {
        const long L = (long)i * G + c; if (L >= nwg) return false;
        int wgid = (int)L; { const int q = nwg / NXCD, r = nwg % NXCD, xcd = wgid % NXCD, off = wgid / NXCD; wgid = (xcd < r ? xcd * (q + 1) : r * (q + 1) + (xcd - r) * q) + off; }
        const int nig = WGM * nN, gid = wgid / nig, fm = gid * WGM, gsz = (nM - fm) < WGM ? (nM - fm) : WGM;
        u.pm = fm + ((wgid % nig) % gsz); u.pn = (wgid % nig) / gsz; return true;
    }
    __device__ __forceinline__ void a_ready(const Unit&) const {}
    __device__ __forceinline__ void done(const Unit&) const {}
};

template <class Epi, class Sched, bool ALIGN_EPI = false, bool SP2 = false>
__device__ __forceinline__ void gemm_phase(PG8_LAS unsigned char* lds, const Gemm g, const Sched& S, const Epi& E) {
    int tid_ = threadIdx.x; asm volatile("" : "+v"(tid_));
    const int tid = tid_, wid = __builtin_amdgcn_readfirstlane(tid >> 6), lane = tid & 63, wr = wid >> 2, wc = wid & 3, fr = lane & 15, fq = lane >> 4;
    const int K = g.K, nt = K / BK;
    unsigned voffA[2], voffB[2];
#pragma unroll
    for (int i = 0; i < 2; ++i) { int R, C; stage_rc(tid * 16 + i * 8192, R, C); const int Rb = Epi::PERM ? ((R & ~31) + perm32(R & 31)) : R;
        voffA[i] = (unsigned)(R * K + C) * 2u; voffB[i] = (unsigned)(Rb * K + C) * 2u; }
    const size_t kstep = (size_t)(BK * 2);
    const size_t hstep = (size_t)HALF * K * 2;
    const size_t tstep = 2 * hstep;
    const unsigned ldsw = (unsigned)wid * 1024u;
    const int aoff = lds_byte(wr * 64 + fr, fq * 8), boff = lds_byte(wc * 32 + fr, fq * 8);
#define PG8_SA(b, h) (((b) * 2 + (h)) * HTB)
#define PG8_SB(b, h) ((4 + (b) * 2 + (h)) * HTB)
#define PG8_STAGE(bufoff, gbase, voff) do { _Pragma("unroll") for (int _i = 0; _i < 2; ++_i) \
        __builtin_amdgcn_global_load_lds((const unsigned*)((const char*)(gbase) + (voff)[_i]), (PG8_LAS unsigned*)(lds + (bufoff) + ldsw + _i * 8192), 16, 0, 0); } while (0)
#define PG8_LDA(dst, b, h) do { _Pragma("unroll") for (int m = 0; m < 4; ++m) _Pragma("unroll") for (int k = 0; k < 2; ++k) dst[m][k] = *(const PG8_LAS bf16x8*)(lds + PG8_SA(b, h) + aoff + m * 2048 + k * 1024); } while (0)
#define PG8_LDB(dst, b, h) do { _Pragma("unroll") for (int n = 0; n < 2; ++n) _Pragma("unroll") for (int k = 0; k < 2; ++k) dst[n][k] = *(const PG8_LAS bf16x8*)(lds + PG8_SB(b, h) + boff + n * 2048 + k * 1024); } while (0)
#define PG8_MMA(ai, bj, At, Bt) do { __builtin_amdgcn_s_setprio(1); _Pragma("unroll") for (int m = 0; m < 4; ++m) _Pragma("unroll") for (int n = 0; n < 2; ++n) _Pragma("unroll") for (int k = 0; k < 2; ++k) \
        acc[ai][bj][m][n] = __builtin_amdgcn_mfma_f32_16x16x32_bf16(Bt[n][k], At[m][k], acc[ai][bj][m][n], 0, 0, 0); __builtin_amdgcn_s_setprio(0); } while (0)
#define PG8_WAIT_V(n) asm volatile("s_waitcnt vmcnt(" #n ")" ::: "memory")
#define PG8_WAIT_L(n) asm volatile("s_waitcnt lgkmcnt(" #n ")" ::: "memory")
#define PG8_BAR __builtin_amdgcn_s_barrier()
#define PG8_SCHED __builtin_amdgcn_sched_barrier(0)
    Unit cur, nxt; int ui = 0;
    if (!S.next(0, cur)) return;
    f32x4 acc[2][2][4][2];
#pragma unroll
    for (int a = 0; a < 2; ++a)
#pragma unroll
        for (int b = 0; b < 2; ++b)
#pragma unroll
            for (int m = 0; m < 4; ++m)
#pragma unroll
                for (int n = 0; n < 2; ++n) acc[a][b][m][n] = (f32x4){0.f, 0.f, 0.f, 0.f};
    bf16x8 At[4][2], B0[2][2], B1[2][2];
    const char* cA = (const char*)g.A + (size_t)cur.pm * tstep; const char* cB = (const char*)g.Bt + (size_t)cur.pn * tstep;
    S.a_ready(cur);
    if constexpr (SP2) {
        PG8_STAGE(PG8_SB(0, 0), cB, voffB); PG8_STAGE(PG8_SB(0, 1), cB + hstep, voffB); PG8_STAGE(PG8_SA(0, 0), cA, voffA); PG8_STAGE(PG8_SA(0, 1), cA + hstep, voffA);
        if (wr == 1) PG8_BAR;
        PG8_WAIT_V(2); PG8_BAR;
        PG8_STAGE(PG8_SB(1, 0), cB + kstep, voffB); PG8_STAGE(PG8_SA(1, 0), cA + kstep, voffA); PG8_STAGE(PG8_SB(1, 1), cB + hstep + kstep, voffB);
        PG8_WAIT_V(6); PG8_BAR;
    } else {
        PG8_STAGE(PG8_SB(0, 0), cB, voffB); PG8_STAGE(PG8_SA(0, 0), cA, voffA); PG8_STAGE(PG8_SB(0, 1), cB + hstep, voffB); PG8_STAGE(PG8_SA(0, 1), cA + hstep, voffA);
        if (wr == 1) PG8_BAR;
        PG8_WAIT_V(4); PG8_BAR;
        PG8_STAGE(PG8_SB(1, 0), cB + kstep, voffB); PG8_STAGE(PG8_SA(1, 0), cA + kstep, voffA); PG8_STAGE(PG8_SB(1, 1), cB + hstep + kstep, voffB);
        PG8_WAIT_V(6); PG8_BAR;
    }
    for (;;) {
        const bool has_next = S.next(ui + 1, nxt);
        const char* nA = has_next ? (const char*)g.A + (size_t)nxt.pm * tstep : cA; const char* nB = has_next ? (const char*)g.Bt + (size_t)nxt.pn * tstep : cB;
        for (int t = 0; t < nt; t += 2) {
            if constexpr (Epi::MIDK > 0) { if (t == Epi::MIDK) E.mid(acc, cur, ui, lds, wr, wc, fr, fq); }
            const bool last = (t == nt - 2);
            const char* a1 = cA + (size_t)(t + 1) * kstep;
            const char* a2 = last ? nA : cA + (size_t)(t + 2) * kstep; const char* b2 = last ? nB : cB + (size_t)(t + 2) * kstep;
            const char* a3 = a2 + kstep; const char* b3 = b2 + kstep;
            if (last && has_next) S.a_ready(nxt);
            if constexpr (SP2) {
            PG8_LDB(B0, 0, 0); PG8_LDB(B1, 0, 1); PG8_SCHED; PG8_LDA(At, 0, 0); PG8_STAGE(PG8_SA(1, 1), a1 + hstep, voffA);
            PG8_WAIT_V(8); PG8_WAIT_L(0); PG8_BAR; PG8_MMA(0, 0, At, B0); PG8_MMA(0, 1, At, B1); PG8_BAR; PG8_SCHED;
            PG8_LDA(At, 0, 1); PG8_STAGE(PG8_SB(0, 0), b2, voffB); PG8_STAGE(PG8_SB(0, 1), b2 + hstep, voffB); PG8_STAGE(PG8_SA(0, 0), a2, voffA);
            PG8_WAIT_V(8); PG8_WAIT_L(0); PG8_BAR; PG8_MMA(1, 0, At, B0); PG8_MMA(1, 1, At, B1); PG8_BAR; PG8_SCHED;
            PG8_LDB(B0, 1, 0); PG8_LDB(B1, 1, 1); PG8_SCHED; PG8_LDA(At, 1, 0); PG8_STAGE(PG8_SA(0, 1), a2 + hstep, voffA);
            PG8_WAIT_V(8); PG8_WAIT_L(0); PG8_BAR; PG8_MMA(0, 0, At, B0); PG8_MMA(0, 1, At, B1); PG8_BAR; PG8_SCHED;
            PG8_LDA(At, 1, 1); PG8_STAGE(PG8_SB(1, 0), b3, voffB); PG8_STAGE(PG8_SB(1, 1), b3 + hstep, voffB); PG8_STAGE(PG8_SA(1, 0), a3, voffA);
            PG8_WAIT_V(8); PG8_WAIT_L(0); PG8_BAR; PG8_MMA(1, 0, At, B0); PG8_MMA(1, 1, At, B1); PG8_BAR; PG8_SCHED;
            } else {
            PG8_LDB(B0, 0, 0); PG8_SCHED; PG8_LDA(At, 0, 0); PG8_STAGE(PG8_SA(1, 1), a1 + hstep, voffA);
            PG8_WAIT_L(8); PG8_BAR; PG8_WAIT_L(0); PG8_MMA(0, 0, At, B0); PG8_BAR; PG8_SCHED;
            PG8_LDB(B1, 0, 1); PG8_STAGE(PG8_SB(0, 0), b2, voffB);
            PG8_BAR; PG8_WAIT_L(0); PG8_MMA(0, 1, At, B1); PG8_BAR;
            PG8_LDA(At, 0, 1); PG8_STAGE(PG8_SA(0, 0), a2, voffA);
            PG8_BAR; PG8_WAIT_L(0); PG8_MMA(1, 0, At, B0); PG8_BAR; PG8_SCHED;
            PG8_STAGE(PG8_SB(0, 1), b2 + hstep, voffB);
            PG8_WAIT_V(6); PG8_BAR; PG8_MMA(1, 1, At, B1); PG8_BAR;
            PG8_LDB(B0, 1, 0); PG8_SCHED; PG8_LDA(At, 1, 0); PG8_STAGE(PG8_SA(0, 1), a2 + hstep, voffA);
            PG8_WAIT_L(8); PG8_BAR; PG8_WAIT_L(0); PG8_MMA(0, 0, At, B0); PG8_BAR; PG8_SCHED;
            PG8_LDB(B1, 1, 1); PG8_STAGE(PG8_SB(1, 0), b3, voffB);
            PG8_BAR; PG8_WAIT_L(0); PG8_MMA(0, 1, At, B1); PG8_BAR;
            PG8_LDA(At, 1, 1); PG8_STAGE(PG8_SA(1, 0), a3, voffA);
            PG8_BAR; PG8_WAIT_L(0); PG8_MMA(1, 0, At, B0); PG8_BAR; PG8_SCHED;
            PG8_STAGE(PG8_SB(1, 1), b3 + hstep, voffB);
            PG8_WAIT_V(6); PG8_BAR; PG8_MMA(1, 1, At, B1); PG8_BAR;
            }
        }
        if constexpr (ALIGN_EPI) { if (wr == 0) PG8_BAR; }
        if constexpr (!Epi::AFTER_DRAIN) { E(acc, cur, ui, lds, wr, wc, fr, fq); S.done(cur); }
        if (!has_next) break;
#pragma unroll
        for (int a = 0; a < 2; ++a)
#pragma unroll
            for (int b = 0; b < 2; ++b)
#pragma unroll
                for (int m = 0; m < 4; ++m)
#pragma unroll
                    for (int n = 0; n < 2; ++n) acc[a][b][m][n] = (f32x4){0.f, 0.f, 0.f, 0.f};
        cur = nxt; cA = nA; cB = nB; ++ui;
        if constexpr (ALIGN_EPI) { if (wr == 1) PG8_BAR; }
    }
    PG8_WAIT_V(0);
    if constexpr (!ALIGN_EPI) { if (wr == 0) PG8_BAR; }
    PG8_BAR;
    if constexpr (Epi::AFTER_DRAIN) { E.fused(acc, cur, wr, wc, fr, fq, lds, wid, lane); S.done(cur); }
#undef PG8_SA
#undef PG8_SB
#undef PG8_STAGE
#undef PG8_LDA
#undef PG8_LDB
#undef PG8_MMA
#undef PG8_WAIT_V
#undef PG8_WAIT_L
#undef PG8_BAR
#undef PG8_SCHED
}
}
namespace pg8 {
typedef float f32x2_t __attribute__((ext_vector_type(2))); typedef __bf16 bf16x2_t __attribute__((ext_vector_type(2)));
__device__ __forceinline__ unsigned cvt_pk_bf16(float lo, float hi) { f32x2_t v = {lo, hi}; bf16x2_t b = __builtin_convertvector(v, bf16x2_t); return __builtin_bit_cast(unsigned, b); }
__device__ __forceinline__ u32x4 pack8(const f32x4 a, const f32x4 b) { u32x4 w; w.x = cvt_pk_bf16(a[0], a[1]); w.y = cvt_pk_bf16(a[2], a[3]); w.z = cvt_pk_bf16(b[0], b[1]); w.w = cvt_pk_bf16(b[2], b[3]); return w; }
__device__ __forceinline__ float bf_lo(unsigned w) { return __uint_as_float(w << 16); }
__device__ __forceinline__ float bf_hi(unsigned w) { return __uint_as_float(w & 0xffff0000u); }
__device__ __forceinline__ float sigmoidf_fast(float v) { return __builtin_amdgcn_rcpf(1.0f + __builtin_amdgcn_exp2f(-v * 1.4426950408889634f)); }
constexpr float ATT_C2 = 0.125f * 1.4426950408889634f;

struct EpiInProj {
    static constexpr bool PERM = true, AFTER_DRAIN = false; static constexpr int MIDK = 0;
    bf16_t* QKV; bf16_t* U; int tab_off; const float* qn; const float* kn;
    __device__ __forceinline__ void mid(f32x4 (&)[2][2][4][2], const Unit&, int, PG8_LAS unsigned char*, int, int, int, int) const {}
    __device__ __forceinline__ void operator()(const f32x4 (&acc)[2][2][4][2], const Unit& u, int ui, PG8_LAS unsigned char* lds, int wr, int wc, int fr, int fq) const {
        const int row0 = u.pm * BM + wr * 64 + fr; const PG8_LAS float* tab = (const PG8_LAS float*)(lds + tab_off) + ui * BM + wr * 64 + fr;
        if (u.pn < 6) {
            const int kind = u.pn >> 1, head = 4 * (u.pn & 1) + wc;
            f32x4 gs[2][2];
#pragma unroll
            for (int bj = 0; bj < 2; ++bj)
#pragma unroll
                for (int n = 0; n < 2; ++n) { const int d = 32 * bj + 8 * fq + 4 * n;
                    gs[bj][n] = kind == 0 ? *(const f32x4*)(qn + d) * ATT_C2 : (kind == 1 ? *(const f32x4*)(kn + d) : (f32x4){1.f, 1.f, 1.f, 1.f}); }
            bf16_t* base = QKV + kind * 512 + head * 64 + 8 * fq;
#pragma unroll
            for (int ai = 0; ai < 2; ++ai)
#pragma unroll
                for (int m = 0; m < 4; ++m) { const int row = row0 + ai * HALF + m * 16; const float rs = tab[ai * HALF + m * 16];
                    f32x4 z[2][2]; float ss = 0.f;
#pragma unroll
                    for (int bj = 0; bj < 2; ++bj)
#pragma unroll
                        for (int n = 0; n < 2; ++n) { z[bj][n] = acc[ai][bj][m][n] * rs; const f32x4 q = z[bj][n] * z[bj][n]; ss += (q[0] + q[1]) + (q[2] + q[3]); }
                    float inv = 1.f;
                    if (kind < 2) { ss += __shfl_xor(ss, 16); ss += __shfl_xor(ss, 32); inv = 1.0f / sqrtf(ss * (1.0f / 64.0f) + 1e-6f); }
#pragma unroll
                    for (int bj = 0; bj < 2; ++bj) *(u32x4*)(base + (size_t)row * 1536 + 32 * bj) = pack8(z[bj][0] * inv * gs[bj][0], z[bj][1] * inv * gs[bj][1]); }
        } else {
            bf16_t* base = U + 128 * (u.pn - 6) + 32 * wc + 8 * fq;
#pragma unroll
            for (int ai = 0; ai < 2; ++ai)
#pragma unroll
                for (int m = 0; m < 4; ++m) { const int row = row0 + ai * HALF + m * 16; const float rs = tab[ai * HALF + m * 16];
                    f32x4 uu[2];
#pragma unroll
                    for (int n = 0; n < 2; ++n) { const f32x4 a = acc[ai][0][m][n] * rs, g = acc[ai][1][m][n] * rs;
                        uu[n] = (f32x4){a[0] * sigmoidf_fast(g[0]), a[1] * sigmoidf_fast(g[1]), a[2] * sigmoidf_fast(g[2]), a[3] * sigmoidf_fast(g[3])}; }
                    *(u32x4*)(base + (size_t)row * 512) = pack8(uu[0], uu[1]); }
        }
    }
};

struct EpiOutProj {
    static constexpr bool PERM = true, AFTER_DRAIN = false; static constexpr int MIDK = 8;
    const bf16_t* x; bf16_t* H1B; float* SS1P; const float* SSA; unsigned char* H1Q;
    int rsa_off;
    __device__ __forceinline__ void mid(f32x4 (&acc)[2][2][4][2], const Unit& u, int ui, PG8_LAS unsigned char* lds, int wr, int wc, int fr, int fq) const {
        const PG8_LAS float* tab = (const PG8_LAS float*)(lds + rsa_off) + ui * BM + wr * 64 + fr;
#pragma unroll
        for (int ai = 0; ai < 2; ++ai)
#pragma unroll
            for (int m = 0; m < 4; ++m) { const float rsa = tab[ai * HALF + m * 16];
#pragma unroll
                for (int bj = 0; bj < 2; ++bj)
#pragma unroll
                    for (int n = 0; n < 2; ++n) acc[ai][bj][m][n] *= rsa; }
    }
    __device__ __forceinline__ void operator()(const f32x4 (&acc)[2][2][4][2], const Unit& u, int ui, PG8_LAS unsigned char* lds, int wr, int wc, int fr, int fq) const {
        const int row0 = u.pm * BM + wr * 64 + fr, col0 = u.pn * BM + wc * 32 + 8 * fq;
#pragma unroll
        for (int ai = 0; ai < 2; ++ai) {
            u32x4 xv[4][2];
#pragma unroll
            for (int m = 0; m < 4; ++m)
#pragma unroll
                for (int bj = 0; bj < 2; ++bj) { const size_t off = (size_t)(row0 + ai * HALF + m * 16) * 1024 + col0 + bj * HALF; xv[m][bj] = *(const u32x4*)(x + off); }
#pragma unroll
            for (int m = 0; m < 4; ++m) { const int row = row0 + ai * HALF + m * 16; float ss = 0.f;
#pragma unroll
                for (int bj = 0; bj < 2; ++bj) { const size_t off = (size_t)row * 1024 + col0 + bj * HALF;
                    const u32x4 xw = xv[m][bj]; f32x4 h0, h1;
                    h0[0] = bf_lo(xw.x) + acc[ai][bj][m][0][0]; h0[1] = bf_hi(xw.x) + acc[ai][bj][m][0][1]; h0[2] = bf_lo(xw.y) + acc[ai][bj][m][0][2]; h0[3] = bf_hi(xw.y) + acc[ai][bj][m][0][3];
                    h1[0] = bf_lo(xw.z) + acc[ai][bj][m][1][0]; h1[1] = bf_hi(xw.z) + acc[ai][bj][m][1][1]; h1[2] = bf_lo(xw.w) + acc[ai][bj][m][1][2]; h1[3] = bf_hi(xw.w) + acc[ai][bj][m][1][3];
                    ss += (h0[0] * h0[0] + h0[1] * h0[1]) + (h0[2] * h0[2] + h0[3] * h0[3]) + (h1[0] * h1[0] + h1[1] * h1[1]) + (h1[2] * h1[2] + h1[3] * h1[3]);
                    *(u32x4*)(H1B + off) = pack8(h0, h1);
                    { const f32x4 g0 = h0 * 14.0f, g1 = h1 * 14.0f;
#define Q8(v) ((unsigned)((int)__builtin_rintf(__builtin_amdgcn_fmed3f((v), -127.0f, 127.0f)) & 0xff))
                      const unsigned ev = Q8(g0[0]) | (Q8(g0[2]) << 8) | (Q8(g1[0]) << 16) | (Q8(g1[2]) << 24), od = Q8(g0[1]) | (Q8(g0[3]) << 8) | (Q8(g1[1]) << 16) | (Q8(g1[3]) << 24);
#undef Q8
                      *(unsigned long long*)(H1Q + off) = (unsigned long long)ev | ((unsigned long long)od << 32); } }
                ss += __shfl_xor(ss, 16); ss += __shfl_xor(ss, 32);
                if (fq == 0) SS1P[(size_t)row * 16 + u.pn * 4 + wc] = ss; }
        }
    }
};

__host__ __device__ __forceinline__ size_t qpf_byte(int row, int head, int half, int ks, int hi) { return ((((size_t)(row >> 5) * 8 + head) * 2 + half) * 8 + ks) * 1024 + (size_t)(hi * 32 + (row & 31)) * 16; }
struct EpiRowScale {
    static constexpr bool PERM = true, AFTER_DRAIN = false; static constexpr int MIDK = 0;
    bf16_t* O; int ldc; int tab_off;
    __device__ __forceinline__ void mid(f32x4 (&)[2][2][4][2], const Unit&, int, PG8_LAS unsigned char*, int, int, int, int) const {}
    __device__ __forceinline__ void operator()(const f32x4 (&acc)[2][2][4][2], const Unit& u, int ui, PG8_LAS unsigned char* lds, int wr, int wc, int fr, int fq) const {
        const int row0 = u.pm * BM + wr * 64 + fr, col0 = u.pn * BM + wc * 32 + 8 * fq; const PG8_LAS float* tab = (const PG8_LAS float*)(lds + (tab_off < 0 ? 0 : tab_off)) + ui * BM + wr * 64 + fr;
#pragma unroll
        for (int ai = 0; ai < 2; ++ai)
#pragma unroll
            for (int m = 0; m < 4; ++m) { const int row = row0 + ai * HALF + m * 16; const float rs = tab_off < 0 ? 1.0f : tab[ai * HALF + m * 16];
#pragma unroll
                for (int bj = 0; bj < 2; ++bj) { const u32x4 w = pack8(acc[ai][bj][m][0] * rs, acc[ai][bj][m][1] * rs);
                    if (ldc > 0) *(u32x4*)(O + (size_t)row * ldc + col0 + bj * HALF) = w;
                    else *(u32x4*)((unsigned char*)O + qpf_byte(row, u.pn, bj, 2 * wc + (fq >> 1), fq & 1)) = w; } }
    }
};

struct EpiFinal {
    static constexpr bool PERM = true, AFTER_DRAIN = false; static constexpr int MIDK = 0;
    const bf16_t* H2B; const bf16_t* PLE; int tab_off; float* out;
    __device__ __forceinline__ void mid(f32x4 (&)[2][2][4][2], const Unit&, int, PG8_LAS unsigned char*, int, int, int, int) const {}
    __device__ __forceinline__ void operator()(const f32x4 (&acc)[2][2][4][2], const Unit& u, int ui, PG8_LAS unsigned char* lds, int wr, int wc, int fr, int fq) const {
        const int row0 = u.pm * BM + wr * 64 + fr, col0 = u.pn * BM + wc * 32 + 8 * fq; const PG8_LAS float* tab = (const PG8_LAS float*)(lds + tab_off) + ui * BM + wr * 64 + fr;
#pragma unroll
        for (int ai = 0; ai < 2; ++ai) {
            u32x4 hh[4][2], pp[4][2];
#pragma unroll
            for (int m = 0; m < 4; ++m)
#pragma unroll
                for (int bj = 0; bj < 2; ++bj) { const size_t off = (size_t)(row0 + ai * HALF + m * 16) * 1024 + col0 + bj * HALF; hh[m][bj] = *(const u32x4*)(H2B + off); pp[m][bj] = *(const u32x4*)(PLE + off); }
#pragma unroll
            for (int m = 0; m < 4; ++m) { const int row = row0 + ai * HALF + m * 16; const float rs = tab[ai * HALF + m * 16];
#pragma unroll
                for (int bj = 0; bj < 2; ++bj) { const size_t off = (size_t)row * 1024 + col0 + bj * HALF;
                    const u32x4 h = hh[m][bj], p = pp[m][bj];
                    const f32x4 a0 = acc[ai][bj][m][0] * rs, a1 = acc[ai][bj][m][1] * rs;
                    f32x4 o0, o1;
                    o0[0] = bf_lo(h.x) + sigmoidf_fast(a0[0]) * bf_lo(p.x); o0[1] = bf_hi(h.x) + sigmoidf_fast(a0[1]) * bf_hi(p.x);
                    o0[2] = bf_lo(h.y) + sigmoidf_fast(a0[2]) * bf_lo(p.y); o0[3] = bf_hi(h.y) + sigmoidf_fast(a0[3]) * bf_hi(p.y);
                    o1[0] = bf_lo(h.z) + sigmoidf_fast(a1[0]) * bf_lo(p.z); o1[1] = bf_hi(h.z) + sigmoidf_fast(a1[1]) * bf_hi(p.z);
                    o1[2] = bf_lo(h.w) + sigmoidf_fast(a1[2]) * bf_lo(p.w); o1[3] = bf_hi(h.w) + sigmoidf_fast(a1[3]) * bf_hi(p.w);
                    *(f32x4*)(out + off) = o0; *(f32x4*)(out + off + 4) = o1; } }
        }
    }
};
}

#include <hip/hip_bf16.h>
namespace attn_body {
using bf16=__hip_bfloat16;
using bf16x8=__attribute__((ext_vector_type(8)))short;
using s16x4=__attribute__((ext_vector_type(4)))short;
using f32x16=__attribute__((ext_vector_type(16)))float;
using u32x4=__attribute__((ext_vector_type(4)))unsigned;
typedef float f32x4_t __attribute__((ext_vector_type(4)));
constexpr int BATCH=16,NHEAD=8,SEQ=2048,D=64,DMI=1536,DMO=1024;
constexpr int NW=8,QBLK=32,QB=QBLK*NW,KVBLK=64,NQB=SEQ/QB;
constexpr int ATTN_UNIT_ROWS=QB;
__device__ __forceinline__ int crow(int r,int hi){return (r&3)+8*(r>>2)+4*hi;}
#define SBAR() __builtin_amdgcn_sched_barrier(0)
__device__ __forceinline__ void cmask(f32x16&p0,f32x16&p1,int jb,int qrel,int hi){
  const float NEG=-INFINITY; int kb=64*jb+4*hi;
  #pragma unroll
  for(int r=0;r<16;++r){int kv=kb+(r&3)+8*(r>>2); if(kv>qrel)p0[r]=NEG; if(kv+32>qrel)p1[r]=NEG;}
}

constexpr int NSLOT=3, SLOTB=8192;
constexpr int LDS_K=0, LDS_V=NSLOT*SLOTB, LDS_WS=2*NSLOT*SLOTB, LDS_OST=LDS_WS+NW*64*4, LDS_GB=LDS_OST+NW*4096, LDS_BYTES=LDS_GB+SEQ*4;
constexpr float SKIP_THR=-100.0f;
constexpr float C2=0.125f*1.4426950408889634f;
__device__ __forceinline__ void glds16(const void*gsrc,unsigned lds_dst){unsigned keep;
  asm volatile("s_mov_b32 %0, m0\n\ts_mov_b32 m0, %2\n\ts_nop 0\n\tglobal_load_lds_dwordx4 %1, off\n\ts_mov_b32 m0, %0":"=&s"(keep):"v"(gsrc),"s"(lds_dst):"memory");}
__device__ __forceinline__ float max3f(float a,float b,float c){float r;asm("v_max3_f32 %0, %1, %2, %3":"=v"(r):"v"(a),"v"(b),"v"(c));return r;}
__device__ __forceinline__ float max2f(float a,float b){float r;asm("v_max_f32_e32 %0, %1, %2":"=v"(r):"v"(a),"v"(b));return r;}
__device__ __forceinline__ float fadd_s(float a,float b){float r;asm("v_add_f32_e32 %0, %1, %2":"=v"(r):"v"(a),"v"(b));return r;}
__device__ __forceinline__ float fsub_s(float a,float b){float r;asm("v_sub_f32_e32 %0, %1, %2":"=v"(r):"v"(a),"v"(b));return r;}
typedef float f32x2_t __attribute__((ext_vector_type(2))); typedef __bf16 bf16x2_t __attribute__((ext_vector_type(2)));
__device__ __forceinline__ unsigned cvtpk_s(float lo,float hi){f32x2_t v={lo,hi};bf16x2_t b=__builtin_convertvector(v,bf16x2_t);return __builtin_bit_cast(unsigned,b);}
#define WAIT_BAR(N) asm volatile("s_waitcnt vmcnt(" #N ") lgkmcnt(0)\n\ts_barrier":::"memory")

__device__ __forceinline__ void qkt(f32x16&p0,f32x16&p1,const char*Kslot,const bf16x8*qr,const f32x16&c0,const f32x16&c1,int r32,int hi){
  const char*kb=Kslot+hi*1024+r32*16;
  #pragma unroll
  for(int d0=0;d0<4;++d0){
    const bf16x8 b0=*reinterpret_cast<const bf16x8*>(kb+d0*2048);
    const bf16x8 b1=*reinterpret_cast<const bf16x8*>(kb+d0*2048+512);
    if(d0==0){p0=__builtin_amdgcn_mfma_f32_32x32x16_bf16(b0,qr[0],c0,0,0,0);p1=__builtin_amdgcn_mfma_f32_32x32x16_bf16(b1,qr[0],c1,0,0,0);}
    else{p0=__builtin_amdgcn_mfma_f32_32x32x16_bf16(b0,qr[d0],p0,0,0,0);p1=__builtin_amdgcn_mfma_f32_32x32x16_bf16(b1,qr[d0],p1,0,0,0);}}
}
typedef __attribute__((address_space(3))) const char* lds_cptr;
typedef short v4i16_t __attribute__((ext_vector_type(4)));
__device__ __forceinline__ void kload8(bf16x8*kf,lds_cptr kp){
  kf[0]=*(const __attribute__((address_space(3))) bf16x8*)(kp);      kf[1]=*(const __attribute__((address_space(3))) bf16x8*)(kp+512);
  kf[2]=*(const __attribute__((address_space(3))) bf16x8*)(kp+2048); kf[3]=*(const __attribute__((address_space(3))) bf16x8*)(kp+2560);
  kf[4]=*(const __attribute__((address_space(3))) bf16x8*)(kp+4096); kf[5]=*(const __attribute__((address_space(3))) bf16x8*)(kp+4608);
  kf[6]=*(const __attribute__((address_space(3))) bf16x8*)(kp+6144); kf[7]=*(const __attribute__((address_space(3))) bf16x8*)(kp+6656);
}
__device__ __forceinline__ void kload2(bf16x8*kf,lds_cptr kp,int j){ kf[2*j]=*(const __attribute__((address_space(3))) bf16x8*)(kp+j*2048); kf[2*j+1]=*(const __attribute__((address_space(3))) bf16x8*)(kp+j*2048+512); }
__device__ __forceinline__ s16x4 vtr(lds_cptr p){ return __builtin_bit_cast(s16x4,__builtin_amdgcn_ds_read_tr16_b64_v4i16((__attribute__((address_space(3))) v4i16_t*)p)); }
__device__ __forceinline__ float rowmax(const f32x16&p0,const f32x16&p1){
  float a=max3f(p0[0],p0[1],p1[0]),b=max3f(p0[2],p0[3],p1[1]);a=max3f(a,p1[2],p1[3]);
  #pragma unroll
  for(int r=4;r<16;r+=4){a=max3f(a,p0[r],p0[r+1]);b=max3f(b,p0[r+2],p0[r+3]);a=max3f(a,p1[r],p1[r+1]);b=max3f(b,p1[r+2],p1[r+3]);}
  const float m=max2f(a,b);
  auto rr=__builtin_amdgcn_permlane32_swap(__float_as_uint(m),__float_as_uint(m),false,false);
  return max2f(__uint_as_float(rr[0]),__uint_as_float(rr[1]));
}
__device__ __forceinline__ void pv(f32x16*o,int vb,bf16x8 pa0,bf16x8 pa1,bf16x8 pa2,bf16x8 pa3){
  #pragma unroll
  for(int d0=0;d0<2;++d0){s16x4 lo[4],hi[4];
    #pragma unroll
    for(int ks=0;ks<4;++ks){
      asm volatile("ds_read_b64_tr_b16 %0,%1 offset:%c2":"=&v"(lo[ks]):"v"(vb),"i"(d0*4096+ks*1024):"memory");
      asm volatile("ds_read_b64_tr_b16 %0,%1 offset:%c2":"=&v"(hi[ks]):"v"(vb),"i"(d0*4096+ks*1024+512):"memory");}
    asm volatile("s_waitcnt lgkmcnt(0)":::"memory");SBAR();
    #define PK(k) (bf16x8){lo[k][0],lo[k][1],lo[k][2],lo[k][3],hi[k][0],hi[k][1],hi[k][2],hi[k][3]}
    o[d0]=__builtin_amdgcn_mfma_f32_32x32x16_bf16(pa0,PK(0),o[d0],0,0,0);
    o[d0]=__builtin_amdgcn_mfma_f32_32x32x16_bf16(pa1,PK(1),o[d0],0,0,0);
    o[d0]=__builtin_amdgcn_mfma_f32_32x32x16_bf16(pa2,PK(2),o[d0],0,0,0);
    o[d0]=__builtin_amdgcn_mfma_f32_32x32x16_bf16(pa3,PK(3),o[d0],0,0,0);
    #undef PK
  }
}

#ifndef ATTN_STORE16
#define ATTN_STORE16(p,v) (*(u32x4*)(p)=(v))
#endif
template<int THRL> __device__ __forceinline__ void attn_unit(int b,int h,int qb,const bf16*Q,const bf16*__restrict__ K,const bf16*__restrict__ V,bf16*O,const float*Gf,float*SSA,char*shm){
  int tid_=threadIdx.x; asm volatile("":"+v"(tid_)); const int tid=tid_,lane=tid&63,r32=lane&31,hi=lane>>5; const int wid=__builtin_amdgcn_readfirstlane(tid>>6);
  const long rowbase=(long)b*SEQ; const int q0=qb*QB;
  const float*Gbh=Gf+((long)b*NHEAD+h)*SEQ; const float g0=Gbh[q0];
  int ts; { const int ntf=(q0+QB)/KVBLK, j_=2*lane; const bool dead_=(j_+6<=ntf) && (g0-Gbh[(j_+6<=ntf)?64*(j_+1)+63:0]<SKIP_THR);
    ts=2*__builtin_popcountll(__ballot(dead_)); ts=__builtin_amdgcn_readfirstlane(ts); }
  const bf16*Qw=Q+(rowbase+q0+wid*QBLK)*DMI+h*D;
  const bf16*Kh=K+(rowbase+64*ts)*DMI+h*D,*Vh=V+(rowbase+64*ts)*DMI+h*D;
  typedef __attribute__((address_space(3))) char* lds_wptr; const lds_wptr shm3w=(lds_wptr)shm;
  const unsigned lds0=(unsigned)(uintptr_t)shm;
  float*wsf=(float*)(shm+LDS_WS)+wid*64;
  const bf16*ksrc=Kh+(long)lane*DMI+wid*8;
  const bf16*vsrc=Vh+(long)(16*(wid&3)+(lane>>2))*DMI+(wid>>2)*32+(lane&3)*8;
  const unsigned kdst=lds0+LDS_K+wid*1024, vdst=lds0+LDS_V+wid*1024;
  #define DMA_K(t,slot) glds16(ksrc+(long)(t)*KVBLK*DMI,(unsigned)__builtin_amdgcn_readfirstlane(kdst+(slot)))
  #define DMA_V(t,slot) glds16(vsrc+(long)(t)*KVBLK*DMI,(unsigned)__builtin_amdgcn_readfirstlane(vdst+(slot)))
  const int vb0=(int)(lds0+LDS_V)+((lane>>4)&1)*32+(lane&3)*8+(4*hi+((lane&15)>>2))*64;
  const char*Kbase=shm+LDS_K; bf16x8 kf[8];
  const lds_cptr shm3=(lds_cptr)shm; const lds_cptr kp0=shm3+LDS_K+hi*1024+r32*16; const lds_cptr vp0=shm3+LDS_V+((lane>>4)&1)*32+(lane&3)*8+(4*hi+((lane&15)>>2))*64;
  const int NT=(q0+QB)/KVBLK-ts;
  DMA_K(0,0);DMA_V(0,0);DMA_K(1,SLOTB);
  { __attribute__((address_space(3))) float*gbw=(__attribute__((address_space(3))) float*)(shm3w+LDS_GB);
    float gv_[4];
    _Pragma("unroll") for(int k_=0;k_<4;++k_){const int s_=64*ts+tid+k_*NW*64; gv_[k_]=Gbh[s_<q0+QB?s_:q0];}
    _Pragma("unroll") for(int k_=0;k_<4;++k_){const int s_=64*ts+tid+k_*NW*64; if(s_<q0+QB)gbw[s_-64*ts]=g0-gv_[k_];} }
  bf16x8 qr[4];
  #pragma unroll
  for(int d0=0;d0<4;++d0)qr[d0]=*reinterpret_cast<const bf16x8*>(&Qw[(long)r32*DMI+d0*16+hi*8]);
  float mhat=0.f,l_reg=0.f;f32x16 o[2];o[0]=f32x16{};o[1]=f32x16{};float nm=0.f; const f32x16 zero16=f32x16{};
  const __attribute__((address_space(3))) char*gbp0=(const __attribute__((address_space(3))) char*)(shm3w+LDS_GB)+hi*16;
  #define CBIAS(CA,CB,t) do{ const __attribute__((address_space(3))) char*gp_=gbp0+(t)*256; _Pragma("unroll") for(int g_=0;g_<4;++g_){ \
      const f32x4_t a_=*(const __attribute__((address_space(3))) f32x4_t*)(gp_+g_*32), b_=*(const __attribute__((address_space(3))) f32x4_t*)(gp_+128+g_*32); \
      _Pragma("unroll") for(int j_=0;j_<4;++j_){ CA[4*g_+j_]+=a_[j_]+nm; CB[4*g_+j_]+=b_[j_]+nm; } } }while(0)
  const int qrel=wid*QBLK+r32;
  #define CMASK(P0,P1,t) do{int jb_=(t)-(NT-4); if(jb_>=0){int hm_=hi,qm_=qrel; asm volatile("":"+v"(hm_),"+v"(qm_)); cmask(P0,P1,jb_,qm_,hm_);}}while(0)
  bool resc=false;
  #define START(P0,P1) do{ const float rm=rowmax(P0,P1); resc=false; \
    { const float dl=rm; mhat=fadd_s(mhat,dl); \
      _Pragma("unroll") for(int r=0;r<16;++r){P0[r]=fsub_s(P0[r],dl);P1[r]=fsub_s(P1[r],dl);} \
      nm=-mhat; } \
    _Pragma("unroll") for(int r=0;r<16;++r)P0[r]=__builtin_amdgcn_exp2f(P0[r]); }while(0)
  #define RESC() do{ if(resc){ asm volatile("s_waitcnt lgkmcnt(0)":::"memory"); \
      _Pragma("unroll") for(int d_=0;d_<2;++d_) _Pragma("unroll") for(int r=0;r<16;++r)o[d_][r]*=wsf[crow(r,hi)]; } }while(0)
  f32x16 pA0,pA1,pB0,pB1;
  int sl_prev=0,sl_cur=0,sl_next=SLOTB;
  #define ROT() do{sl_prev=sl_cur;sl_cur=sl_next;sl_next=(sl_next==(NSLOT-1)*SLOTB)?0:sl_next+SLOTB;}while(0)
  DMA_K(2,2*SLOTB);
  WAIT_BAR(3);
  qkt(pA0,pA1,Kbase,qr,zero16,zero16,r32,hi);asm volatile("s_nop 15\n\ts_nop 7":"+v"(pA0),"+v"(pA1));CBIAS(pA0,pA1,0);CMASK(pA0,pA1,0);
  START(pA0,pA1);
  _Pragma("unroll") for(int r=0;r<16;++r)pA1[r]=__builtin_amdgcn_exp2f(pA1[r]);
  WAIT_BAR(0);
  DMA_K(3,0);DMA_V(1,SLOTB);
  ROT();
  kload8(kf,kp0+sl_cur);
  WAIT_BAR(2);
  s16x4 vlo[8],vhi[8]; u32x4 pw0,pw1,pw2,pw3;
  #define PKW(P,B) cvtpk_s(P[B],P[B+1])
  #define PAF(k) __builtin_bit_cast(bf16x8,pw##k)
  #define VFR(i) (bf16x8){vlo[i][0],vlo[i][1],vlo[i][2],vlo[i][3],vhi[i][0],vhi[i][1],vhi[i][2],vhi[i][3]}
  #define PIN(x) asm volatile("":"+v"(x))
  #define MX3(a,b,c) __builtin_fmaxf(__builtin_fmaxf((a),(b)),(c))
  #define GAPA(MF,A0,A1,A2,A3,W0,W1,PW) do{ MF; sacc+=A0; sacc+=A1; sacc+=A2; sacc+=A3; PIN(sacc); W0; W1; PIN(PW); SBAR(); }while(0)
  #define EX(v) __builtin_amdgcn_exp2f(v)
  #define GAPB(MF,X,B) do{ MF; X[B]=EX(X[B]); X[B+1]=EX(X[B+1]); X[B+2]=EX(X[B+2]); X[B+3]=EX(X[B+3]); PIN(X); SBAR(); }while(0)
  #define VRD(i) do{ vlo[i]=vtr(vp_+(((i)>>2)*4096+((i)&3)*1024)); vhi[i]=vtr(vp_+(((i)>>2)*4096+((i)&3)*1024+512)); }while(0)
  #define KRD(G,j) do{ if(G){ kload2(kf,kp0+sl_next,j); SBAR(); } }while(0)
  #define STEP(C0,C1,P0,P1,t,GK,GV,GL) do{ SBAR(); \
    const lds_cptr vp_=vp0+sl_prev; \
    VRD(0); SBAR(); float sacc=(P0[0]+P0[1]); \
    GAPA(C0=__builtin_amdgcn_mfma_f32_32x32x16_bf16(kf[0],qr[0],zero16,0,0,0), P0[2],P0[3],P0[4],P0[5],     pw0[0]=PKW(P0,0), pw0[1]=PKW(P0,2), pw0); \
    VRD(4); SBAR(); GAPA(C1=__builtin_amdgcn_mfma_f32_32x32x16_bf16(kf[1],qr[0],zero16,0,0,0), P0[6],P0[7],P0[8],P0[9],     pw0[2]=PKW(P0,4), pw0[3]=PKW(P0,6), pw0); \
    VRD(1); SBAR(); GAPA(C0=__builtin_amdgcn_mfma_f32_32x32x16_bf16(kf[2],qr[1],C0,0,0,0),   P0[10],P0[11],P0[12],P0[13], pw1[0]=PKW(P0,8), pw1[1]=PKW(P0,10), pw1); \
    VRD(5); SBAR(); GAPA(C1=__builtin_amdgcn_mfma_f32_32x32x16_bf16(kf[3],qr[1],C1,0,0,0),   P0[14],P0[15],P1[0],P1[1],   pw1[2]=PKW(P0,12),pw1[3]=PKW(P0,14), pw1); \
    VRD(2); SBAR(); GAPA(C0=__builtin_amdgcn_mfma_f32_32x32x16_bf16(kf[4],qr[2],C0,0,0,0),   P1[2],P1[3],P1[4],P1[5],     pw2[0]=PKW(P1,0), pw2[1]=PKW(P1,2), pw2); \
    VRD(6); SBAR(); GAPA(C1=__builtin_amdgcn_mfma_f32_32x32x16_bf16(kf[5],qr[2],C1,0,0,0),   P1[6],P1[7],P1[8],P1[9],     pw2[2]=PKW(P1,4), pw2[3]=PKW(P1,6), pw2); \
    VRD(3); SBAR(); GAPA(C0=__builtin_amdgcn_mfma_f32_32x32x16_bf16(kf[6],qr[3],C0,0,0,0),   P1[10],P1[11],P1[12],P1[13], pw3[0]=PKW(P1,8), pw3[1]=PKW(P1,10), pw3); \
    VRD(7); SBAR(); GAPA(C1=__builtin_amdgcn_mfma_f32_32x32x16_bf16(kf[7],qr[3],C1,0,0,0),   P1[14],P1[15],0.f,0.f,       pw3[2]=PKW(P1,12),pw3[3]=PKW(P1,14), pw3); \
    l_reg+=sacc; \
    if(GK){DMA_K((t)+3,sl_cur);} if(GV){DMA_V((t)+1,sl_next);} \
    CBIAS(C0,C1,t); \
    CMASK(C0,C1,t); \
    { float a=MX3(C0[0],C0[1],C1[0]),b=MX3(C0[2],C0[3],C1[1]); a=MX3(a,C1[2],C1[3]); \
      _Pragma("unroll") for(int r=4;r<16;r+=4){a=MX3(a,C0[r],C0[r+1]);b=MX3(b,C0[r+2],C0[r+3]);a=MX3(a,C1[r],C1[r+1]);b=MX3(b,C1[r+2],C1[r+3]);} \
      float rm=__builtin_fmaxf(a,b); { auto rr=__builtin_amdgcn_permlane32_swap(__float_as_uint(rm),__float_as_uint(rm),false,false); rm=__builtin_fmaxf(__uint_as_float(rr[0]),__uint_as_float(rr[1])); } \
      resc=false; \
      if(__builtin_expect(__any(rm>(float)THRL),0)){ const float dl=__builtin_fmaxf(rm,0.f); mhat+=dl; \
        _Pragma("unroll") for(int r=0;r<16;++r){C0[r]-=dl;C1[r]-=dl;} \
        nm=-mhat; \
        const float f=__builtin_amdgcn_exp2f(-dl); l_reg*=f; if(hi==0)wsf[r32]=f; resc=true; } } \
    SBAR(); \
    GAPB(o[0]=__builtin_amdgcn_mfma_f32_32x32x16_bf16(PAF(0),VFR(0),o[0],0,0,0), C0,0); \
    GAPB(o[1]=__builtin_amdgcn_mfma_f32_32x32x16_bf16(PAF(0),VFR(4),o[1],0,0,0), C0,4); \
    KRD(GL,0); GAPB(o[0]=__builtin_amdgcn_mfma_f32_32x32x16_bf16(PAF(1),VFR(1),o[0],0,0,0), C0,8); \
    KRD(GL,1); GAPB(o[1]=__builtin_amdgcn_mfma_f32_32x32x16_bf16(PAF(1),VFR(5),o[1],0,0,0), C0,12); \
    KRD(GL,2); GAPB(o[0]=__builtin_amdgcn_mfma_f32_32x32x16_bf16(PAF(2),VFR(2),o[0],0,0,0), C1,0); \
    KRD(GL,3); GAPB(o[1]=__builtin_amdgcn_mfma_f32_32x32x16_bf16(PAF(2),VFR(6),o[1],0,0,0), C1,4); \
    GAPB(o[0]=__builtin_amdgcn_mfma_f32_32x32x16_bf16(PAF(3),VFR(3),o[0],0,0,0), C1,8); \
    GAPB(o[1]=__builtin_amdgcn_mfma_f32_32x32x16_bf16(PAF(3),VFR(7),o[1],0,0,0), C1,12); \
    }while(0)
  int t=1;
  #undef CMASK
  #define CMASK(P0,P1,t) do{}while(0)
  for(;t+5<NT;t+=2){
    STEP(pB0,pB1,pA0,pA1,t,true,true,true);     WAIT_BAR(2); RESC(); ROT();
    STEP(pA0,pA1,pB0,pB1,t+1,true,true,true);   WAIT_BAR(2); RESC(); ROT();
  }
  #undef CMASK
  #define CMASK(P0,P1,t) do{int jb_=(t)-(NT-4); if(jb_>=0){int hm_=hi,qm_=qrel; asm volatile("":"+v"(hm_),"+v"(qm_)); cmask(P0,P1,jb_,qm_,hm_);}}while(0)
  #define ENDW(tt) do{ if((tt)+3<NT){WAIT_BAR(2);} else if((tt)+2<NT){WAIT_BAR(1);} else {WAIT_BAR(0);} }while(0)
  for(;t+1<NT;t+=2){
    STEP(pB0,pB1,pA0,pA1,t,(t+3<NT),(t+1<NT),(t+1<NT));       ENDW(t);   RESC(); ROT();
    STEP(pA0,pA1,pB0,pB1,t+1,(t+4<NT),(t+2<NT),(t+2<NT));     ENDW(t+1); RESC(); ROT();
  }
  STEP(pB0,pB1,pA0,pA1,NT-1,false,false,false); RESC();
  { float sacc=pB0[0]+pB0[1]; _Pragma("unroll") for(int r=2;r<16;++r)sacc+=pB0[r]; _Pragma("unroll") for(int r=0;r<16;++r)sacc+=pB1[r]; l_reg+=sacc;
    pw0=(u32x4){PKW(pB0,0),PKW(pB0,2),PKW(pB0,4),PKW(pB0,6)};pw1=(u32x4){PKW(pB0,8),PKW(pB0,10),PKW(pB0,12),PKW(pB0,14)};pw2=(u32x4){PKW(pB1,0),PKW(pB1,2),PKW(pB1,4),PKW(pB1,6)};pw3=(u32x4){PKW(pB1,8),PKW(pB1,10),PKW(pB1,12),PKW(pB1,14)};
    SBAR(); pv(o,vb0+sl_cur,PAF(0),PAF(1),PAF(2),PAF(3)); }
  #undef PKW
  #undef PAF
  #undef VFR
  #undef PIN
  #undef MX3
  #undef GAPA
  #undef GAPB
  #undef EX
  #undef VRD
  #undef KRD
  #undef STEP
  #undef ENDW
  {auto rr=__builtin_amdgcn_permlane32_swap(__float_as_uint(l_reg),__float_as_uint(l_reg),false,false);l_reg=__uint_as_float(rr[0])+__uint_as_float(rr[1]);}
  if(hi==0)wsf[32+r32]=l_reg;asm volatile("s_waitcnt lgkmcnt(0)":::"memory");
  float rli[16];
  #pragma unroll
  for(int r=0;r<16;++r)rli[r]=__builtin_amdgcn_rcpf(wsf[32+crow(r,hi)]);
  bf16*Ow=O+(rowbase+q0+wid*QBLK)*DMO+h*D;
  { bf16*stg=(bf16*)(shm+LDS_OST)+wid*2048;
    #pragma unroll
    for(int r=0;r<16;++r){const int orow=crow(r,hi);
      #pragma unroll
      for(int d0=0;d0<2;++d0)stg[orow*64+d0*32+r32]=__float2bfloat16(o[d0][r]*rli[r]);}
    asm volatile("s_waitcnt lgkmcnt(0)":::"memory");
    int le_=lane; asm volatile("":"+v"(le_));
    #pragma unroll
    for(int i=0;i<4;++i){const int row=i*8+(le_>>3),ch=le_&7; const u32x4 v=*(const u32x4*)(stg+row*64+ch*8); ATTN_STORE16(Ow+(unsigned)(row*DMO+ch*8),v);
      float q_=0.f; _Pragma("unroll") for(int e_=0;e_<4;++e_){const float lo_=__uint_as_float(v[e_]<<16),hi_=__uint_as_float(v[e_]&0xffff0000u); q_+=lo_*lo_+hi_*hi_;}
      q_+=__shfl_xor(q_,1);q_+=__shfl_xor(q_,2);q_+=__shfl_xor(q_,4); if(ch==0)SSA[(rowbase+q0+wid*QBLK+row)*NHEAD+h]=q_; } }
  asm volatile("s_waitcnt lgkmcnt(0)\n\ts_barrier":::"memory");
  #undef DMA_K
  #undef DMA_V
  #undef CMASK
  #undef START
  #undef RESC
  #undef ROT
  #undef CBIAS
}
constexpr int ATTN_LDS_BYTES=LDS_BYTES;
struct AttnTensors { const bf16* Q; const bf16* K; const bf16* V; bf16* O; const float* G; float* SSA; };
struct AttnUnit { int bh; int qb; };
struct StaticOrder {
  int vcu,G;
  __device__ __forceinline__ explicit StaticOrder(int grid,int block):vcu((grid%8==0)?(block%8)*(grid/8)+block/8:block),G(grid){}
  __device__ __forceinline__ bool next(int i,AttnUnit&u)const{
    if(G==256){ if(i>=4)return false; const int hf=vcu&1; u.bh=vcu>>1; u.qb=(i==0)?7-hf:(i==1)?hf:(i==2)?5-hf:2+hf; return true; }
    const int L=i*G+vcu; if(L>=BATCH*NHEAD*NQB)return false; u.bh=L/NQB; u.qb=NQB-1-(L%NQB); return true; }
  __device__ __forceinline__ void a_ready(const AttnUnit&)const{}
  __device__ __forceinline__ void done(const AttnUnit&)const{}
};
template<class Sched,int THRL=100> __device__ __forceinline__ void attn_phase(char*lds,const AttnTensors&T,const Sched&S){
  AttnUnit u;
  for(int i=0;S.next(i,u);++i){ S.a_ready(u); attn_unit<THRL>(u.bh/NHEAD,u.bh%NHEAD,u.qb,T.Q,T.K,T.V,T.O,T.G,T.SSA,lds); S.done(u); }
}
#undef SBAR
#undef WAIT_BAR
}
constexpr size_t MiB = 1u << 20;
constexpr size_t WS_CTL = 0, CTL_ZERO_BYTES = 1 * MiB;
constexpr size_t WS_WI = 1 * MiB;
constexpr size_t WS_WO = 6 * MiB;
constexpr size_t WS_WQ = 8 * MiB;
constexpr size_t WS_WG = 12 * MiB;
constexpr size_t WS_WP = 14 * MiB;
constexpr size_t WS_SK = 14 * MiB + 512 * 1024;
constexpr size_t WS_RS1 = 15 * MiB;
constexpr size_t WS_SS2 = 20 * MiB + 1024 * 1024;
constexpr size_t WS_LF = 16 * MiB;
constexpr size_t WS_G = 17 * MiB;
constexpr size_t WS_SSA = 18 * MiB;
constexpr size_t WS_SS1P = 19 * MiB;
constexpr size_t WS_EU = 22 * MiB;
constexpr size_t WS_EV = 54 * MiB;
constexpr size_t WS_PB = 86 * MiB;
constexpr size_t WS_XB = 102 * MiB;
constexpr size_t WS_QKV = 166 * MiB;
constexpr size_t WS_QP = 102 * MiB;
constexpr size_t WS_PLE = 102 * MiB;
constexpr size_t WS_U = 262 * MiB;
constexpr size_t WS_Y = 294 * MiB;
constexpr size_t WS_H2B = 294 * MiB;
constexpr size_t WS_H1B = 358 * MiB;
constexpr size_t WS_SEL = 422 * MiB;
constexpr size_t WS_GATE = 430 * MiB;
constexpr size_t WS_WACT = 446 * MiB;
constexpr size_t WS_PD = 166 * MiB;
constexpr size_t WS_H1Q = 262 * MiB;
constexpr size_t WS_WH = 462 * MiB;
constexpr size_t WS_END = 470 * MiB;
constexpr int CW_CODE = 2;
constexpr int CW_BAR = 4096;
constexpr int CW_XRANK = 16384;

constexpr int RING_OFF = 0, RING_BYTES = 131072;
constexpr int LDSCTL_OFF = RING_BYTES, MISC_OFF = LDSCTL_OFF + 320;
constexpr int SCAN_OFF = LDSCTL_OFF + 1024;
constexpr int RSA_OFF = LDSCTL_OFF + 2048;
constexpr int LDS_BYTES = 147456;

#define GAS __attribute__((address_space(1)))
#define LAS __attribute__((address_space(3)))
typedef unsigned short bf16;
typedef unsigned v4u __attribute__((ext_vector_type(4)));
typedef float f32x4 __attribute__((ext_vector_type(4)));
typedef short bf16x8 __attribute__((ext_vector_type(8)));
typedef GAS unsigned gu32;
typedef GAS unsigned long long gu64;
#define RLX_AGENT __ATOMIC_RELAXED, __HIP_MEMORY_SCOPE_AGENT
#define LDS_WAIT() asm volatile("s_waitcnt lgkmcnt(0)" ::: "memory")
#define VM_WAIT() asm volatile("s_waitcnt vmcnt(0)" ::: "memory")
__device__ __forceinline__ unsigned long long rt() { return __builtin_amdgcn_s_memrealtime(); }
__device__ __forceinline__ unsigned f2bf(float f) { unsigned u = __builtin_bit_cast(unsigned, f); return (u + 0x7fffu + ((u >> 16) & 1u)) >> 16; }
__device__ __forceinline__ unsigned pk2(float lo, float hi) { return f2bf(lo) | (f2bf(hi) << 16); }

#define XB_TMO      128
#define XB_XCNT(j)  (256  + 64 * (j))
#define XB_XSUB(j)  (1280 + 64 * (j))
#define XB_XGEN(j)  (2304 + 64 * (j))
#define XB_TOP      3328
#define XB_TOPGEN   3392
#define XCD_BAR_WORDS 3456
#define XB_SPIN_CAP (1u << 18)

__device__ __forceinline__ unsigned xb_ld(unsigned* p)              { return __hip_atomic_load(p, __ATOMIC_RELAXED, __HIP_MEMORY_SCOPE_AGENT); }
__device__ __forceinline__ unsigned xb_add(unsigned* p, unsigned v) { return __hip_atomic_fetch_add(p, v, __ATOMIC_RELAXED, __HIP_MEMORY_SCOPE_AGENT); }
__device__ __forceinline__ unsigned xb_xcc_id() { return (unsigned)__builtin_amdgcn_s_getreg((3 << 11) | 20) & 0xFu; }
#define XB_SPIN(cond, bar) do { unsigned _sp = 0; while (cond) { __builtin_amdgcn_s_sleep(1); \
    if ((++_sp & 255u) == 0u) { if (xb_ld(&(bar)[XB_TMO])) break; if (_sp > XB_SPIN_CAP) { atomicAdd(&(bar)[XB_TMO], 1u); break; } } } } while (0)

struct XcdBarrier {
    unsigned* bar; unsigned x;
    volatile LAS unsigned* st;
};

__device__ __forceinline__ XcdBarrier xcd_barrier_post(unsigned* bar, volatile LAS unsigned* st) {
    XcdBarrier b; b.bar = bar; b.x = xb_xcc_id(); b.st = st;
    if (threadIdx.x == 0) (void)xb_add(&bar[XB_XCNT(b.x)], 1u);
    return b;
}
__device__ __forceinline__ void xcd_barrier_complete(unsigned* bar, unsigned x, unsigned& nloc, unsigned& nx) {
    const unsigned G = gridDim.x * gridDim.y * gridDim.z;
    unsigned sum, cnt, mine, sp = 0u;
    for (;;) {
        sum = 0u; cnt = 0u; mine = 0u;
#pragma unroll
        for (unsigned j = 0; j < 16; ++j) { const unsigned c = xb_ld(&bar[XB_XCNT(j)]); sum += c; cnt += (c > 0u) ? 1u : 0u; mine = (j == x) ? c : mine; }
        if (sum == G) break;
        __builtin_amdgcn_s_sleep(1);
        if ((++sp & 255u) == 0u) { if (xb_ld(&bar[XB_TMO])) break; if (sp > XB_SPIN_CAP) { atomicAdd(&bar[XB_TMO], 1u); break; } }
    }
    nloc = mine > 0u ? mine : 1u; nx = cnt > 0u ? cnt : 1u;
}

__device__ __forceinline__ void xcd_barrier(const XcdBarrier& b) {
    asm volatile("s_waitcnt vmcnt(0)" ::: "memory");
    __syncthreads();
    if (threadIdx.x == 0) {
        unsigned* bar = b.bar;
        __builtin_amdgcn_s_waitcnt(0);
        unsigned nloc = b.st[0], nx = b.st[1];
        if (nloc == 0u) { xcd_barrier_complete(bar, b.x, nloc, nx); b.st[0] = nloc; b.st[1] = nx; }
        const unsigned old = xb_add(&bar[XB_XSUB(b.x)], 1u);
        const unsigned gen = old / nloc;
        if (old + 1u == (gen + 1u) * nloc) {
            __builtin_amdgcn_fence(__ATOMIC_RELEASE, "agent");
            asm volatile("s_waitcnt vmcnt(0)" ::: "memory");
            const unsigned og = xb_add(&bar[XB_TOP], 1u);
            const unsigned tg = og / nx;
            if (og + 1u == (tg + 1u) * nx) xb_add(&bar[XB_TOPGEN], 1u);
            else XB_SPIN(xb_ld(&bar[XB_TOPGEN]) == tg, bar);
            __builtin_amdgcn_fence(__ATOMIC_ACQUIRE, "agent");
            xb_add(&bar[XB_XGEN(b.x)], 1u);
            asm volatile("s_waitcnt vmcnt(0)" ::: "memory");
        } else {
            XB_SPIN(xb_ld(&bar[XB_XGEN(b.x)]) == gen, bar);
            __builtin_amdgcn_fence(__ATOMIC_ACQUIRE, "agent");
            asm volatile("s_waitcnt vmcnt(0)" ::: "memory");
        }
    }
    __syncthreads();
}

constexpr int NWAVES = 8;
struct Frame {
    LAS unsigned char* lds;
    volatile LAS unsigned* MISC;
    gu32* ctl;
    int tid, lane, wave;
    int vcu, G;
    unsigned char* ws;
    const float* in[23];
    float* out;
};
enum { I_X = 0, I_P, I_LN_MIX, I_W_IN, I_B_FGATE, I_Q_NORM, I_K_NORM, I_CONV_W, I_CONV_B, I_CONV_LN_G, I_CONV_LN_B, I_ATTN_OUT_NORM, I_CONV_OUT_NORM, I_W_OUT,
       I_LN_FFN, I_W_PEER_Q, I_SUB_KEYS1, I_SUB_KEYS2, I_EXPERT_U, I_EXPERT_V, I_LN_PL, I_W_PL_GATE, I_W_PL_PROJ };

#define PHASE_IDS(F) do { int t_ = threadIdx.x; asm volatile("" : "+v"(t_)); F.tid = t_; F.lane = t_ & 63; F.wave = __builtin_amdgcn_readfirstlane(t_ >> 6); } while (0)
__device__ __forceinline__ float wave_sum(float v) {
    v += __builtin_bit_cast(float, __builtin_amdgcn_update_dpp(0, __builtin_bit_cast(int, v), 0xB1, 0xf, 0xf, true));
    v += __builtin_bit_cast(float, __builtin_amdgcn_update_dpp(0, __builtin_bit_cast(int, v), 0x4E, 0xf, 0xf, true));
    v += __builtin_bit_cast(float, __builtin_amdgcn_update_dpp(0, __builtin_bit_cast(int, v), 0x141, 0xf, 0xf, true));
    v += __builtin_bit_cast(float, __builtin_amdgcn_update_dpp(0, __builtin_bit_cast(int, v), 0x140, 0xf, 0xf, true));
    const int b = __builtin_bit_cast(int, v);
    const float s0 = __builtin_bit_cast(float, __builtin_amdgcn_readlane(b, 0)), s1 = __builtin_bit_cast(float, __builtin_amdgcn_readlane(b, 16));
    const float s2 = __builtin_bit_cast(float, __builtin_amdgcn_readlane(b, 32)), s3 = __builtin_bit_cast(float, __builtin_amdgcn_readlane(b, 48));
    return (s0 + s1) + (s2 + s3);
}
__device__ __forceinline__ float fast_sigmoid(float v) { return __builtin_amdgcn_rcpf(1.0f + __builtin_amdgcn_exp2f(-v * LOG2E)); }

__device__ __forceinline__ void p0_transpose_item(const float* W, int Nsrc, int K, int col0, const float* gain, bf16* WT, int n0, int k0, LAS float* scr, int lane) {
    float wv_[32];
#pragma unroll
    for (int i = 0; i < 32; ++i) wv_[i] = W[(size_t)(k0 + 2 * i + (lane >> 5)) * Nsrc + col0 + (lane & 31)];
#pragma unroll
    for (int i = 0; i < 32; ++i) { const int kk = 2 * i + (lane >> 5); const float g = gain ? gain[kk] : 1.0f; scr[kk * 33 + (lane & 31)] = wv_[i] * g; }
    LDS_WAIT(); asm volatile("" ::: "memory");
    const int c = lane & 7;
#pragma unroll
    for (int j = 0; j < 4; ++j) { const int n = (lane >> 3) + 8 * j; const LAS float* s = scr + (8 * c) * 33 + n;
        v4u o; o.x = pk2(s[0 * 33], s[1 * 33]); o.y = pk2(s[2 * 33], s[3 * 33]); o.z = pk2(s[4 * 33], s[5 * 33]); o.w = pk2(s[6 * 33], s[7 * 33]);
        *(GAS v4u*)(WT + (size_t)(n0 + n) * K + k0 + 8 * c) = o; }
    LDS_WAIT(); asm volatile("" ::: "memory");
}
__device__ __forceinline__ int inproj_src_col(int nb) {
    const int p0 = 32 * nb, pn = p0 >> 8, cp = p0 & 255;
    if (pn < 6) { const int bj = cp >> 7, wc = (cp >> 5) & 3; return 256 * pn + 64 * wc + 32 * bj; }
    const int pg = pn - 6; return cp < 128 ? COL_A + 128 * pg + cp : COL_G + 128 * pg + (cp - 128);
}
constexpr float U_QSCALE = 96.0f, H_QSCALE = 14.0f;
__device__ __forceinline__ unsigned q4(float v) { return (unsigned)((int)__builtin_rintf(__builtin_amdgcn_fmed3f(v, -7.0f, 7.0f)) + 8); }
__device__ __forceinline__ v4u cvt8(const f32x4 a, const f32x4 b) { v4u o; o.x = pk2(a.x, a.y); o.y = pk2(a.z, a.w); o.z = pk2(b.x, b.y); o.w = pk2(b.z, b.w); return o; }

__device__ __forceinline__ void p0_prologue(Frame& F) {
    PHASE_IDS(F);
    LAS float* scr = (LAS float*)(F.lds + RING_OFF + F.wave * 16384);
    const int gw = F.vcu * NWAVES + F.wave, NGW = F.G * NWAVES;
    bf16* WI = (bf16*)(F.ws + WS_WI); bf16* WO = (bf16*)(F.ws + WS_WO); bf16* WQ = (bf16*)(F.ws + WS_WQ); bf16* WG = (bf16*)(F.ws + WS_WG); bf16* WP = (bf16*)(F.ws + WS_WP);
    constexpr int I_IN = 16 * 80, I_OUT = 16 * 32, I_PQ = 16 * 64, I_GT = 16 * 32, I_PJ = 4 * 32, NITEMS = I_IN + I_OUT + I_PQ + I_GT + I_PJ;
    for (int it = gw; it < NITEMS; it += NGW) {
        int r = it;
        if (r < I_IN) { const int kb = r / 80, nb = r % 80; p0_transpose_item(F.in[I_W_IN], NIN, DMODEL, inproj_src_col(nb), F.in[I_LN_MIX] + 64 * kb, WI, 32 * nb, 64 * kb, scr, F.lane); continue; } r -= I_IN;
        if (r < I_OUT) { const int kb = r / 32, nb = r % 32; const float* g = kb < 8 ? F.in[I_ATTN_OUT_NORM] + 64 * kb : F.in[I_CONV_OUT_NORM] + 64 * (kb - 8);
            p0_transpose_item(F.in[I_W_OUT], DMODEL, DMODEL, 32 * nb, g, WO, 32 * nb, 64 * kb, scr, F.lane); continue; } r -= I_OUT;
        if (r < I_PQ) { const int kb = r / 64, nb = r % 64; p0_transpose_item(F.in[I_W_PEER_Q], PH * PQ, DMODEL, 32 * nb, F.in[I_LN_FFN] + 64 * kb, WQ, 32 * nb, 64 * kb, scr, F.lane); continue; } r -= I_PQ;
        if (r < I_GT) { const int kb = r / 32, nb = r % 32; p0_transpose_item(F.in[I_W_PL_GATE], DMODEL, DMODEL, 32 * nb, F.in[I_LN_PL] + 64 * kb, WG, 32 * nb, 64 * kb, scr, F.lane); continue; } r -= I_GT;
        { const int kb = r / 32, nb = r % 32; p0_transpose_item(F.in[I_W_PL_PROJ], DMODEL, DPLE, 32 * nb, nullptr, WP, 32 * nb, 64 * kb, scr, F.lane); }
    }
    {
        float wf[4][4][8];
        const float* w_in = F.in[I_W_IN]; const float* lnm = F.in[I_LN_MIX];
#pragma unroll
        for (int j = 0; j < 4; ++j)
#pragma unroll
            for (int e = 0; e < 4; ++e) { const int k = 4 * F.lane + 256 * j + e; const float g = lnm[k];
                const f32x4 a = *(const f32x4*)(w_in + (size_t)k * NIN + COL_F), b = *(const f32x4*)(w_in + (size_t)k * NIN + COL_F + 4);
                wf[j][e][0] = a.x * g; wf[j][e][1] = a.y * g; wf[j][e][2] = a.z * g; wf[j][e][3] = a.w * g; wf[j][e][4] = b.x * g; wf[j][e][5] = b.y * g; wf[j][e][6] = b.z * g; wf[j][e][7] = b.w * g; }
        const float* x = F.in[I_X]; bf16* XB = (bf16*)(F.ws + WS_XB); float* RS1 = (float*)(F.ws + WS_RS1); float* LF = (float*)(F.ws + WS_LF);
        const float bfh = F.in[I_B_FGATE][F.lane & 7];
        f32x4 v[4], vn[4], vnn[4];
        if (gw < T) { const GAS f32x4* xr = (const GAS f32x4*)(x + (size_t)gw * DMODEL) + F.lane;
            const GAS f32x4* xr2 = (const GAS f32x4*)(x + (size_t)(gw + NGW < T ? gw + NGW : gw) * DMODEL) + F.lane;
#pragma unroll
            for (int j = 0; j < 4; ++j) v[j] = xr[64 * j];
#pragma unroll
            for (int j = 0; j < 4; ++j) vn[j] = xr2[64 * j]; }
#pragma unroll 1
        for (int m = gw; m < T; m += NGW) {
            { const int mn = m + 2 * NGW < T ? m + 2 * NGW : m; const GAS f32x4* xr = (const GAS f32x4*)(x + (size_t)mn * DMODEL) + F.lane;
#pragma unroll
              for (int j = 0; j < 4; ++j) vnn[j] = xr[64 * j]; }
            float s = 0.f; float d[8];
#pragma unroll
            for (int h = 0; h < 8; ++h) d[h] = 0.f;
#pragma unroll
            for (int j = 0; j < 4; ++j) { s += (v[j].x * v[j].x + v[j].y * v[j].y) + (v[j].z * v[j].z + v[j].w * v[j].w);
#pragma unroll
                for (int h = 0; h < 8; ++h) d[h] += (v[j].x * wf[j][0][h] + v[j].y * wf[j][1][h]) + (v[j].z * wf[j][2][h] + v[j].w * wf[j][3][h]); }
            const float rs = 1.0f / sqrtf(wave_sum(s) * (1.0f / DMODEL) + EPS);
            float mine = 0.f;
#pragma unroll
            for (int h = 0; h < 8; ++h) { const float t = wave_sum(d[h]); mine = ((F.lane & 7) == h) ? t : mine; }
            GAS unsigned long long* o8 = (GAS unsigned long long*)(XB + (size_t)m * DMODEL) + F.lane;
#pragma unroll
            for (int j = 0; j < 4; ++j) o8[64 * j] = (unsigned long long)pk2(v[j].x, v[j].y) | ((unsigned long long)pk2(v[j].z, v[j].w) << 32);
            if (F.lane == 0) RS1[m] = rs;
            if (F.lane < 8) { const float z = mine * rs + bfh; const float ls = fminf(z, 0.f) - log1pf(expf(-fabsf(z))); LF[(size_t)m * 8 + F.lane] = ls * LOG2E; }
#pragma unroll
            for (int j = 0; j < 4; ++j) { v[j] = vn[j]; vn[j] = vnn[j]; }
        }
    }
    {
        const size_t gt = (size_t)F.vcu * (NWAVES * 64) + F.tid, NGT = (size_t)F.G * NWAVES * 64;
        const float* p = F.in[I_P]; bf16* PB = (bf16*)(F.ws + WS_PB);
        for (size_t c0 = gt; c0 < (size_t)T * DPLE / 8; c0 += 4 * NGT) {
            f32x4 pa[4][2];
#pragma unroll
            for (int k = 0; k < 4; ++k) { const size_t c = c0 + k * NGT < (size_t)T * DPLE / 8 ? c0 + k * NGT : c0; const GAS f32x4* s = (const GAS f32x4*)(p + c * 8); pa[k][0] = s[0]; pa[k][1] = s[1]; }
#pragma unroll
            for (int k = 0; k < 4; ++k) { const size_t c = c0 + k * NGT; if (c < (size_t)T * DPLE / 8) *(GAS v4u*)(PB + c * 8) = cvt8(pa[k][0], pa[k][1]); }
        }
        const float* eu = F.in[I_EXPERT_U]; const float* ev = F.in[I_EXPERT_V]; const float* lnf = F.in[I_LN_FFN];
        unsigned char* EU4 = F.ws + WS_EU; unsigned char* EV4 = F.ws + WS_EV;
        for (size_t c = gt; c < (size_t)NEXP * DMODEL / 32; c += NGT) {
            const int e = (int)(c >> 5), dc = (int)(c & 31), d0 = dc * 32; const size_t dst = (size_t)(dc >> 3) * ((size_t)NEXP * 128) + (size_t)e * 128 + (dc & 7) * 16;
            const GAS f32x4* su = (const GAS f32x4*)(eu + (size_t)e * DMODEL + d0); const GAS f32x4* sv = (const GAS f32x4*)(ev + (size_t)e * DMODEL + d0);
            v4u ou, ov;
#pragma unroll
            for (int q = 0; q < 4; ++q) { const f32x4 a0 = su[2 * q] * (*(const f32x4*)(lnf + d0 + 8 * q) * U_QSCALE), a1 = su[2 * q + 1] * (*(const f32x4*)(lnf + d0 + 8 * q + 4) * U_QSCALE);
                unsigned pu = q4(a0.x) | (q4(a0.y) << 4) | (q4(a0.z) << 8) | (q4(a0.w) << 12) | (q4(a1.x) << 16) | (q4(a1.y) << 20) | (q4(a1.z) << 24) | (q4(a1.w) << 28); ou[q] = pu;
                const f32x4 b0 = sv[2 * q] * 6.0f, b1 = sv[2 * q + 1] * 6.0f;
                unsigned pv = 0u; pv = __builtin_amdgcn_cvt_scalef32_pk_fp4_f32(pv, b0.x, b0.y, 1.0f, 0); pv = __builtin_amdgcn_cvt_scalef32_pk_fp4_f32(pv, b0.z, b0.w, 1.0f, 1);
                pv = __builtin_amdgcn_cvt_scalef32_pk_fp4_f32(pv, b1.x, b1.y, 1.0f, 2); pv = __builtin_amdgcn_cvt_scalef32_pk_fp4_f32(pv, b1.z, b1.w, 1.0f, 3); ov[q] = pv; }
            *(GAS v4u*)(EU4 + dst) = ou; *(GAS v4u*)(EV4 + dst) = ov;
        }
        bf16* SK = (bf16*)(F.ws + WS_SK);
        for (size_t c = gt; c < (size_t)2 * NKEY * PHALF / 8; c += NGT) {
            const float* src = c < (size_t)NKEY * PHALF / 8 ? F.in[I_SUB_KEYS1] + c * 8 : F.in[I_SUB_KEYS2] + (c - NKEY * PHALF / 8) * 8;
            const GAS f32x4* s = (const GAS f32x4*)src; *(GAS v4u*)(SK + c * 8) = cvt8(s[0], s[1]);
        }
    }
}

__device__ __forceinline__ void p1_scan(Frame& F) {
    PHASE_IDS(F);
    const float* LF = (const float*)(F.ws + WS_LF); float* Gc = (float*)(F.ws + WS_G);
    LAS float* wt = (LAS float*)(F.lds + SCAN_OFF);
    for (int bh = blockIdx.x; bh < BATCH * NH; bh += F.G) {
        const int b = bh >> 3, h = bh & 7;
        float v[4];
#pragma unroll
        for (int j = 0; j < 4; ++j) v[j] = LF[((size_t)b * SEQ + 4 * F.tid + j) * 8 + h];
        v[1] += v[0]; v[2] += v[1]; v[3] += v[2];
        float incl = v[3];
#pragma unroll
        for (int o = 1; o < 64; o <<= 1) { const float t = __shfl_up(incl, o); if (F.lane >= o) incl += t; }
        if (F.lane == 63) wt[F.wave] = incl;
        __syncthreads();
        float base = incl - v[3];
        for (int w = 0; w < F.wave; ++w) base += wt[w];
        f32x4 o; o.x = base + v[0]; o.y = base + v[1]; o.z = base + v[2]; o.w = base + v[3];
        *(GAS f32x4*)(Gc + (size_t)bh * SEQ + 4 * F.tid) = o;
        __syncthreads();
    }
}

constexpr int CONV_TOK = 64, CONV_UW = 0, CONV_CWL = (CONV_TOK + 30) * 1024, CONV_LDS = CONV_CWL + CW * 1024;
static_assert(CONV_LDS <= RING_BYTES, "conv LDS");
__device__ __forceinline__ v4u cvt8h(const f32x4 a, const f32x4 b) { v4u o; o.x = __builtin_bit_cast(unsigned, __builtin_amdgcn_cvt_pkrtz(a.x, a.y)); o.y = __builtin_bit_cast(unsigned, __builtin_amdgcn_cvt_pkrtz(a.z, a.w));
    o.z = __builtin_bit_cast(unsigned, __builtin_amdgcn_cvt_pkrtz(b.x, b.y)); o.w = __builtin_bit_cast(unsigned, __builtin_amdgcn_cvt_pkrtz(b.z, b.w)); return o; }
__device__ __forceinline__ unsigned bf2_to_h2(unsigned w) { return __builtin_bit_cast(unsigned, __builtin_amdgcn_cvt_pkrtz(__uint_as_float(w << 16), __uint_as_float(w & 0xffff0000u))); }
__device__ __forceinline__ v4u bf8_to_h8(const v4u w) { v4u o; o.x = bf2_to_h2(w.x); o.y = bf2_to_h2(w.y); o.z = bf2_to_h2(w.z); o.w = bf2_to_h2(w.w); return o; }
__device__ __forceinline__ void unpack8(const v4u w, float (&f)[8]) {
    f[0] = __uint_as_float(w.x << 16); f[1] = __uint_as_float(w.x & 0xffff0000u); f[2] = __uint_as_float(w.y << 16); f[3] = __uint_as_float(w.y & 0xffff0000u);
    f[4] = __uint_as_float(w.z << 16); f[5] = __uint_as_float(w.z & 0xffff0000u); f[6] = __uint_as_float(w.w << 16); f[7] = __uint_as_float(w.w & 0xffff0000u);
}
__device__ __forceinline__ void p2_conv(Frame& F) {
    PHASE_IDS(F);
    const bf16* U = (const bf16*)(F.ws + WS_U); bf16* Y = (bf16*)(F.ws + WS_Y);
    LAS unsigned char* uw = F.lds + RING_OFF + CONV_UW; LAS unsigned char* cwl = F.lds + RING_OFF + CONV_CWL;
    { const float* cw = F.in[I_CONV_W];
      f32x4 ca_[4][2];
#pragma unroll
      for (int k = 0; k < 4; ++k) { const int i = F.tid + k * NWAVES * 64; const GAS f32x4* s = (const GAS f32x4*)(cw + (i < CW * DCONV / 8 ? i : 0) * 8); ca_[k][0] = s[0]; ca_[k][1] = s[1]; }
#pragma unroll
      for (int k = 0; k < 4; ++k) { const int i = F.tid + k * NWAVES * 64; if (i < CW * DCONV / 8) *(LAS v4u*)(cwl + i * 16) = cvt8h(ca_[k][0], ca_[k][1]); } }
    float cb[8], lg[8], lb[8];
    { const int c0 = 8 * F.lane;
#pragma unroll
      for (int e = 0; e < 8; ++e) { cb[e] = F.in[I_CONV_B][c0 + e]; lg[e] = F.in[I_CONV_LN_G][c0 + e]; lb[e] = F.in[I_CONV_LN_B][c0 + e]; } }
    const int NUNIT = T / CONV_TOK;
    for (int un = F.vcu; un < NUNIT; un += F.G) {
        const int b = un / (SEQ / CONV_TOK), s0 = (un % (SEQ / CONV_TOK)) * CONV_TOK;
        __syncthreads();
        { constexpr int NCH = ((CONV_TOK + 30) * 64 + NWAVES * 64 - 1) / (NWAVES * 64); v4u wv_[NCH];
#pragma unroll
          for (int k = 0; k < NCH; ++k) { const int i = F.tid + k * NWAVES * 64, r = i >> 6, ch = i & 63, s = s0 - 30 + r;
              wv_[k] = (v4u){0u, 0u, 0u, 0u}; if (i < (CONV_TOK + 30) * 64 && s >= 0) wv_[k] = *(const GAS v4u*)(U + ((size_t)b * SEQ + s) * DCONV + ch * 8); }
#pragma unroll
          for (int k = 0; k < NCH; ++k) { const int i = F.tid + k * NWAVES * 64, r = i >> 6, ch = i & 63; if (i < (CONV_TOK + 30) * 64) *(LAS v4u*)(uw + r * 1024 + ch * 16) = bf8_to_h8(wv_[k]); } }
        __syncthreads();
#pragma unroll 1
        for (int grp = 0; grp < 2; ++grp) {
            const int sb = 8 * F.wave + 4 * grp;
            typedef _Float16 h2c __attribute__((ext_vector_type(2)));
            h2c hacc[4][4];
#pragma unroll
            for (int q = 0; q < 4; ++q)
#pragma unroll
                for (int e = 0; e < 4; ++e) hacc[q][e] = (h2c){(_Float16)0.f, (_Float16)0.f};
            h2c wv[4][4];
            const LAS unsigned char* up = uw + sb * 1024 + F.lane * 16; const LAS unsigned char* wp = cwl + F.lane * 16;
#define LD_H8(D, P) do { const v4u t_ = *(const LAS v4u*)(P); const unsigned t0_ = t_.x, t1_ = t_.y, t2_ = t_.z, t3_ = t_.w; \
                D[0] = __builtin_bit_cast(h2c, t0_); D[1] = __builtin_bit_cast(h2c, t1_); D[2] = __builtin_bit_cast(h2c, t2_); D[3] = __builtin_bit_cast(h2c, t3_); } while (0)
#define CONV_ROW(RHO, RI) do { h2c ur[4]; LD_H8(ur, up + (RHO) * 1024); \
                if ((RI) < CW) LD_H8(wv[(RI) & 3], wp + (RHO) * 1024); \
                _Pragma("unroll") for (int q = 0; q < 4; ++q) { const int j = (RI) - q; if (j >= 0 && j < CW) { \
                    _Pragma("unroll") for (int e = 0; e < 4; ++e) hacc[q][e] += wv[j & 3][e] * ur[e]; } } \
                __builtin_amdgcn_sched_barrier(0); } while (0)
            CONV_ROW(0, 0); CONV_ROW(1, 1); CONV_ROW(2, 2); CONV_ROW(3, 3);
#pragma unroll 1
            for (int r4 = 4; r4 < 28; r4 += 4) { CONV_ROW(r4, 4); CONV_ROW(r4 + 1, 5); CONV_ROW(r4 + 2, 6); CONV_ROW(r4 + 3, 7); }
            CONV_ROW(28, 28); CONV_ROW(29, 29); CONV_ROW(30, 30); CONV_ROW(31, 31); CONV_ROW(32, 32); CONV_ROW(33, 33);
#undef CONV_ROW
#undef LD_H8
            float acc[4][8];
#pragma unroll
            for (int q = 0; q < 4; ++q)
#pragma unroll
                for (int e = 0; e < 4; ++e) { acc[q][2 * e] = (float)hacc[q][e].x + cb[2 * e]; acc[q][2 * e + 1] = (float)hacc[q][e].y + cb[2 * e + 1]; }
#pragma unroll
            for (int q = 0; q < 4; ++q) {
                float s = 0.f;
#pragma unroll
                for (int e = 0; e < 8; ++e) s += acc[q][e];
                const float mu = wave_sum(s) * (1.0f / DCONV); float s2 = 0.f;
#pragma unroll
                for (int e = 0; e < 8; ++e) { acc[q][e] -= mu; s2 += acc[q][e] * acc[q][e]; }
                const float rstd = 1.0f / sqrtf(wave_sum(s2) * (1.0f / DCONV) + LN_EPS); float s3 = 0.f;
#pragma unroll
                for (int e = 0; e < 8; ++e) { const float y = acc[q][e] * rstd * lg[e] + lb[e]; const float sw = y * fast_sigmoid(y); acc[q][e] = sw; s3 += sw * sw; }
                const float rr = 1.0f / sqrtf(wave_sum(s3) * (1.0f / DCONV) + EPS);
                v4u o; o.x = pk2(acc[q][0] * rr, acc[q][1] * rr); o.y = pk2(acc[q][2] * rr, acc[q][3] * rr); o.z = pk2(acc[q][4] * rr, acc[q][5] * rr); o.w = pk2(acc[q][6] * rr, acc[q][7] * rr);
                *(GAS v4u*)(Y + ((size_t)b * SEQ + s0 + sb + q) * DMODEL + DATT + 8 * F.lane) = o;
            }
        }
    }
    __syncthreads();
}

namespace topk {
typedef float f32x16 __attribute__((ext_vector_type(16)));
typedef short bf16x8 __attribute__((ext_vector_type(8)));
constexpr int SKL_OFF = 0, LUT_OFF = 65536, LUT_STRIDE = 36, TOPK_LDS = LUT_OFF + NWAVES * 64 * LUT_STRIDE;
static_assert(TOPK_LDS <= RING_BYTES, "topk LDS");
__device__ __forceinline__ float vmaxf(float a, float b) { float r; asm("v_max_f32_e32 %0, %1, %2" : "=v"(r) : "v"(a), "v"(b)); return r; }
__device__ __forceinline__ float vminf(float a, float b) { float r; asm("v_min_f32_e32 %0, %1, %2" : "=v"(r) : "v"(a), "v"(b)); return r; }
#define TK_CE(x, y) do { const float hi_ = vmaxf(x, y), lo_ = vminf(x, y); x = hi_; y = lo_; } while (0)
constexpr int SA[63] = {0,2,4,6,8,10,12,14,0,1,4,5,8,9,12,13,1,5,9,13,0,1,2,3,8,9,10,11,2,3,10,11,1,3,5,9,11,13,0,1,2,3,4,5,6,7,4,5,6,7,2,3,6,7,10,11,1,3,5,7,9,11,13};
constexpr int SB[63] = {1,3,5,7,9,11,13,15,2,3,6,7,10,11,14,15,2,6,10,14,4,5,6,7,12,13,14,15,4,5,12,13,2,4,6,10,12,14,8,9,10,11,12,13,14,15,8,9,10,11,4,5,8,9,12,13,2,4,6,8,10,12,14};
constexpr int MA[32] = {0,1,2,3,4,5,6,7,0,1,2,3,8,9,10,11,0,1,4,5,8,9,12,13,0,2,4,6,8,10,12,14};
constexpr int MB[32] = {8,9,10,11,12,13,14,15,4,5,6,7,12,13,14,15,2,3,6,7,10,11,14,15,1,3,5,7,9,11,13,15};
constexpr int CAND_A[50] = {0,0,0,0,0,0,0,0,0,0,0,0,0,0,0,0,1,1,1,1,1,1,1,1,2,2,2,2,2,3,3,3,3,4,4,4,5,5,6,6,7,7,8,9,10,11,12,13,14,15};
constexpr int CAND_B[50] = {0,1,2,3,4,5,6,7,8,9,10,11,12,13,14,15,0,1,2,3,4,5,6,7,0,1,2,3,4,0,1,2,3,0,1,2,0,1,0,1,0,1,0,0,0,0,0,0,0,0};
__device__ __forceinline__ void sort16(float (&v)[16]) {
#pragma unroll
    for (int i = 0; i < 63; ++i) TK_CE(v[SA[i]], v[SB[i]]);
}
__device__ __forceinline__ void bitonic16(float (&v)[16]) {
#pragma unroll
    for (int i = 0; i < 32; ++i) TK_CE(v[MA[i]], v[MB[i]]);
}
__device__ __forceinline__ void merge16(float (&a)[16], const float (&b)[16]) {
#pragma unroll
    for (int i = 0; i < 16; ++i) a[i] = vmaxf(a[i], b[15 - i]);
    bitonic16(a);
}
__device__ __forceinline__ void top16_of_tiles(const f32x16 (&acc)[4], int hi, float (&top)[16]) {
    float w[16];
#pragma unroll
    for (int blk = 0; blk < 4; ++blk) {
#pragma unroll
        for (int r = 0; r < 16; ++r) { const unsigned key = (unsigned)(blk * 32 + (r & 3) + 8 * (r >> 2)) + 4u * (unsigned)hi;
            const float pv = __uint_as_float((__float_as_uint(acc[blk][r]) & 0xffffff80u) | key);
            if (blk == 0) top[r] = pv; else w[r] = pv; }
        if (blk == 0) sort16(top); else { sort16(w); merge16(top, w); }
    }
    float lo[16], hi_[16];
#pragma unroll
    for (int i = 0; i < 16; ++i) { const auto rr = __builtin_amdgcn_permlane32_swap(__float_as_uint(top[i]), __float_as_uint(top[i]), false, false); lo[i] = __uint_as_float(rr[0]); hi_[i] = __uint_as_float(rr[1]); }
#pragma unroll
    for (int i = 0; i < 16; ++i) top[i] = vmaxf(lo[i], hi_[15 - i]);
    bitonic16(top);
}
}

__device__ __forceinline__ void p5_topk(Frame& F) {
    PHASE_IDS(F);
    using namespace topk;
    const bf16* QP = (const bf16*)(F.ws + WS_QP); const bf16* SK = (const bf16*)(F.ws + WS_SK);
    unsigned short* SEL = (unsigned short*)(F.ws + WS_SEL); float* GATE = (float*)(F.ws + WS_GATE);
    LAS unsigned char* skl = F.lds + RING_OFF + SKL_OFF; LAS unsigned char* lut = F.lds + RING_OFF + LUT_OFF + F.tid * LUT_STRIDE;
    { v4u sk_[8];
#pragma unroll
      for (int k = 0; k < 8; ++k) { const int i = F.tid + k * NWAVES * 64, row = i >> 4, c = i & 15; sk_[k] = *(const GAS v4u*)(SK + (size_t)row * PHALF + c * 8); }
#pragma unroll
      for (int k = 0; k < 8; ++k) { const int i = F.tid + k * NWAVES * 64, row = i >> 4, c = i & 15; *(LAS v4u*)(skl + row * 256 + ((c ^ (row & 15)) << 4)) = sk_[k]; } }
    __syncthreads();
    const int gw = F.vcu * NWAVES + F.wave, NGW = F.G * NWAVES, tok = F.lane & 31, hi = F.lane >> 5;
#pragma unroll 1
    for (int un = gw; un < (T / 32) * PH; un += NGW) {
        const int tg = un >> 3, h = un & 7; const size_t trow = (size_t)tg * 32 + tok;
        const unsigned char* qblk = (const unsigned char*)QP + (((size_t)tg * 8 + h) * 16) * 1024 + F.lane * 16;
        float v1[16], v2[16];
#pragma unroll
        for (int half = 0; half < 2; ++half) {
            bf16x8 bq[8];
#pragma unroll
            for (int ks = 0; ks < 8; ++ks) bq[ks] = *(const GAS bf16x8*)(qblk + (half * 8 + ks) * 1024);
            f32x16 acc[4];
#pragma unroll
            for (int blk = 0; blk < 4; ++blk) { acc[blk] = f32x16{};
                const int key = blk * 32 + tok;
#pragma unroll
                for (int ks = 0; ks < 8; ++ks) { const bf16x8 a = *(const LAS bf16x8*)(skl + half * 32768 + key * 256 + (((2 * ks + hi) ^ (key & 15)) << 4));
                    acc[blk] = __builtin_amdgcn_mfma_f32_32x32x16_bf16(a, bq[ks], acc[blk], 0, 0, 0); } }
            if (half == 0) top16_of_tiles(acc, hi, v1); else top16_of_tiles(acc, hi, v2);
        }
#pragma unroll
        for (int i = 0; i < 16; ++i) { lut[i] = (unsigned char)(__float_as_uint(v1[i]) & 0x7fu); lut[16 + i] = (unsigned char)(__float_as_uint(v2[i]) & 0x7fu); }
        float c[4][16];
#pragma unroll
        for (int n = 0; n < 64; ++n) {
            if (n < 50) { const int a = CAND_A[n], b = CAND_B[n];
                const float s = __uint_as_float(__float_as_uint(v1[a]) & 0xffffff80u) + __uint_as_float(__float_as_uint(v2[b]) & 0xffffff80u);
                c[n >> 4][n & 15] = __uint_as_float((__float_as_uint(s) & 0xffffff00u) | (unsigned)((a << 4) | b)); }
            else c[n >> 4][n & 15] = -INFINITY;
        }
        sort16(c[0]); sort16(c[1]); merge16(c[0], c[1]); sort16(c[2]); merge16(c[0], c[2]); sort16(c[3]); merge16(c[0], c[3]);
        float g[16]; float sum = 0.f; const float m0 = __uint_as_float(__float_as_uint(c[0][0]) & 0xffffff00u);
#pragma unroll
        for (int i = 0; i < 16; ++i) { g[i] = __builtin_amdgcn_exp2f((__uint_as_float(__float_as_uint(c[0][i]) & 0xffffff00u) - m0) * LOG2E); sum += g[i]; }
        const float inv = __builtin_amdgcn_rcpf(sum);
        asm volatile("s_waitcnt lgkmcnt(0)" ::: "memory");
        unsigned ids[16];
#pragma unroll
        for (int i = 0; i < 16; ++i) { const unsigned code = __float_as_uint(c[0][i]) & 0xffu; ids[i] = (unsigned)lut[code >> 4] * NKEY + (unsigned)lut[16 + (code & 15)]; }
        if (hi == 0) {
            v4u s0, s1; s0.x = ids[0] | (ids[1] << 16); s0.y = ids[2] | (ids[3] << 16); s0.z = ids[4] | (ids[5] << 16); s0.w = ids[6] | (ids[7] << 16);
            s1.x = ids[8] | (ids[9] << 16); s1.y = ids[10] | (ids[11] << 16); s1.z = ids[12] | (ids[13] << 16); s1.w = ids[14] | (ids[15] << 16);
            GAS v4u* sp = (GAS v4u*)(SEL + trow * NSEL + h * PK); sp[0] = s0; sp[1] = s1;
        } else {
            GAS f32x4* gp = (GAS f32x4*)(GATE + trow * NSEL + h * PK);
#pragma unroll
            for (int i = 0; i < 4; ++i) gp[i] = (f32x4){g[4 * i] * inv, g[4 * i + 1] * inv, g[4 * i + 2] * inv, g[4 * i + 3] * inv};
        }
        asm volatile("s_waitcnt lgkmcnt(0)" ::: "memory");
    }
    __syncthreads();
}

constexpr float USCALE = 96.0f * 14.0f, VSCALE = 6.0f;
constexpr size_t SLICE_BYTES = (size_t)NEXP * 128;
typedef float f32x2v __attribute__((ext_vector_type(2)));
typedef _Float16 h2v __attribute__((ext_vector_type(2)));
__device__ __forceinline__ float gelu_tanh(float x) {
    const float u = 1.5957691216057308f * (x + 0.044715f * x * x * x);
    return x * __builtin_amdgcn_rcpf(1.0f + __builtin_amdgcn_exp2f(-u * LOG2E));
}
__device__ __forceinline__ float dpp_sum8(float v) {
    v += __builtin_bit_cast(float, __builtin_amdgcn_update_dpp(0, __builtin_bit_cast(int, v), 0xB1, 0xf, 0xf, true));
    v += __builtin_bit_cast(float, __builtin_amdgcn_update_dpp(0, __builtin_bit_cast(int, v), 0x4E, 0xf, 0xf, true));
    v += __builtin_bit_cast(float, __builtin_amdgcn_update_dpp(0, __builtin_bit_cast(int, v), 0x141, 0xf, 0xf, true));
    return v;
}
template <int NSL> __device__ __forceinline__ void slice_of_block(Frame& F, int which, int& s, int& gws, int& nws) {
#if SLICE_BY_XCC
    LAS unsigned* slot = (LAS unsigned*)(F.lds + MISC_OFF) + 16;
    if (F.tid == 0) {
        unsigned ok = (F.MISC[8] != 0u) ? 1u : 0u; unsigned* bw = (unsigned*)(F.ctl + CW_BAR); const unsigned x = xb_xcc_id(); unsigned mine = 0u;
        for (unsigned j = 0; j < 16; ++j) { const unsigned cnt = xb_ld(&bw[XB_XCNT(j)]); ok &= (j < 8) ? (cnt > 0u) : (cnt == 0u); if (j < 8 && (j & (NSL - 1)) == (x & (NSL - 1))) mine += cnt; }
        unsigned rank = 0u;
        if (ok) rank = xb_add((unsigned*)(F.ctl + CW_XRANK + (which * 16 + (int)(x & (NSL - 1))) * 64), 1u);
        slot[0] = ok; slot[1] = rank; slot[2] = x & (NSL - 1); slot[3] = mine;
    }
    __syncthreads();
    const unsigned ok = slot[0], rank = slot[1], x = slot[2], mine = slot[3];
    __syncthreads();
    if (ok) { s = (int)x; gws = (int)rank * NWAVES + F.wave; nws = (int)mine * NWAVES; return; }
#endif
    s = (int)(blockIdx.x & (NSL - 1)); gws = (int)(blockIdx.x / NSL) * NWAVES + F.wave; nws = ((F.G - s + NSL - 1) / NSL) * NWAVES;
}
struct TokIdx { v4u i0, i1; };
__device__ __forceinline__ unsigned sel_of(const TokIdx& I, int b) { const unsigned w = b < 8 ? I.i0[b >> 1] : I.i1[(b - 8) >> 1]; return (b & 1) ? (w >> 16) : (w & 0xffffu); }
#define LD_ROW(I, b) __builtin_bit_cast(v4u, __builtin_amdgcn_raw_buffer_load_b128(rsrc, (int)((sel_of(I, (b)) & EMASK) * 128u + lane16), 0, 0))
template <unsigned EMASK> __device__ __forceinline__ void p6_experts_u(Frame& F, float* PD, int which) {
    PHASE_IDS(F);
    const unsigned char* H1Q = F.ws + WS_H1Q; const unsigned short* SEL = (const unsigned short*)(F.ws + WS_SEL);
    int s, gws, nws; slice_of_block<4>(F, which, s, gws, nws);
    const __amdgpu_buffer_rsrc_t rsrc = __builtin_amdgcn_make_buffer_rsrc((void*)(F.ws + WS_EU + (size_t)s * SLICE_BYTES), 0, (int)SLICE_BYTES, 0x00020000);
    const unsigned lane16 = 16u * (F.lane & 7); const int g = F.lane >> 3, c = F.lane & 7;
    const unsigned short* selp = SEL + 16 * g; const unsigned char* hp = H1Q + 256 * s + 32 * c;
    struct HP { v4u h[2]; };
#define LD_IDX(I, H, tt) do { const size_t t_ = (size_t)((tt) < T ? (tt) : T - 1); I.i0 = *(const GAS v4u*)(selp + t_ * NSEL); I.i1 = *(const GAS v4u*)(selp + t_ * NSEL + 8); \
        H.h[0] = *(const GAS v4u*)(hp + t_ * DMODEL); H.h[1] = *(const GAS v4u*)(hp + t_ * DMODEL + 16); } while (0)
    TokIdx In, In2; HP hc, hn, h2; v4u r[16];
    int t = gws;
    if (t >= T) return;
    { TokIdx Ic; LD_IDX(Ic, hc, t); LD_IDX(In, hn, t + nws);
#pragma unroll
      for (int b = 0; b < 16; ++b) r[b] = LD_ROW(Ic, b); }
#pragma unroll 1
    for (; t < T; t += nws) {
        LD_IDX(In2, h2, t + 2 * nws);
        int hs = 0;
#pragma unroll
        for (int w = 0; w < 8; ++w) hs = __builtin_amdgcn_sdot4(0x01010101, (int)hc.h[w >> 2][w & 3], hs, false);
        const int seed = -8 * hs;
        float v0 = 0.f, v1 = 0.f;
#pragma unroll
        for (int b = 0; b < 16; ++b) {
            asm volatile("" : "+v"(r[b]));
            int a0 = seed, a1 = 0;
#pragma unroll
            for (int q = 0; q < 4; ++q) { const unsigned x = r[b][q];
                a0 = __builtin_amdgcn_sdot4((int)(x & 0x0F0F0F0Fu), (int)hc.h[q >> 1][2 * (q & 1)], a0, false);
                a1 = __builtin_amdgcn_sdot4((int)((x >> 4) & 0x0F0F0F0Fu), (int)hc.h[q >> 1][2 * (q & 1) + 1], a1, false); }
            float pr = dpp_sum8((float)(a0 + a1)); asm volatile("" : "+v"(pr));
            if (b & 1) v1 = (c == (b >> 1)) ? pr : v1; else v0 = (c == (b >> 1)) ? pr : v0;
            r[b] = LD_ROW(In, b);
        }
        *(GAS f32x2v*)(PD + ((size_t)t * 4 + s) * NSEL + 16 * g + 2 * c) = (f32x2v){v0, v1};
        In = In2; hc = hn; hn = h2;
    }
#undef LD_IDX
}
__device__ __forceinline__ void p6b_reduce(Frame& F) {
    PHASE_IDS(F);
    const float* PD = (const float*)(F.ws + WS_PD); const float* GATE = (const float*)(F.ws + WS_GATE); const float* SS1P = (const float*)(F.ws + WS_SS1P); float* WACT = (float*)(F.ws + WS_WACT);
    const int gw = F.vcu * NWAVES + F.wave, NGW = F.G * NWAVES;
#pragma unroll 1
    for (int t = gw; t < T; t += NGW) {
        float ssv = F.lane < 16 ? SS1P[(size_t)t * 16 + F.lane] : 0.f; ssv = wave_sum(ssv);
        const float rs2 = (1.0f / USCALE) / sqrtf(ssv * (1.0f / DMODEL) + EPS);
        f32x2v acc = (f32x2v){0.f, 0.f};
#pragma unroll
        for (int sl = 0; sl < 4; ++sl) acc += *(const GAS f32x2v*)(PD + ((size_t)t * 4 + sl) * NSEL + 2 * F.lane);
        const f32x2v gt = *(const GAS f32x2v*)(GATE + (size_t)t * NSEL + 2 * F.lane);
        const float w0_ = gt.x * gelu_tanh(acc.x * rs2), w1_ = gt.y * gelu_tanh(acc.y * rs2);
        ((GAS unsigned*)(F.ws + WS_WH))[(size_t)t * (NSEL / 2) + F.lane] = __builtin_bit_cast(unsigned, __builtin_amdgcn_cvt_pkrtz(w0_, w1_));
#if SELFCHECK
        *(GAS f32x2v*)(WACT + (size_t)t * NSEL + 2 * F.lane) = (f32x2v){w0_, w1_};
#endif
    }
}
__device__ __forceinline__ float xchg32(float send, bool up) { const auto rr = __builtin_amdgcn_permlane32_swap(__float_as_uint(send), __float_as_uint(send), false, false); return __uint_as_float(up ? rr[0] : rr[1]); }
__device__ __forceinline__ void p7_experts_v(Frame& F) {
    constexpr unsigned EMASK = 0xffffu;
    PHASE_IDS(F);
    const bf16* H1B = (const bf16*)(F.ws + WS_H1B); const unsigned short* SEL = (const unsigned short*)(F.ws + WS_SEL); const unsigned* WH = (const unsigned*)(F.ws + WS_WH);
    bf16* H2B = (bf16*)(F.ws + WS_H2B); float* SS2P = (float*)(F.ws + WS_SS2);
    int s, gws, nws; slice_of_block<4>(F, 1, s, gws, nws);
    const __amdgpu_buffer_rsrc_t rsrc = __builtin_amdgcn_make_buffer_rsrc((void*)(F.ws + WS_EV + (size_t)s * SLICE_BYTES), 0, (int)SLICE_BYTES, 0x00020000);
    const unsigned lane16 = 16u * (F.lane & 7); const int g = F.lane >> 3, c = F.lane & 7;
    const bool up32 = (F.lane & 32) != 0, up16 = (F.lane & 16) != 0, up8 = (F.lane & 8) != 0;
    const int k0 = (up32 ? 16 : 0) + (up16 ? 8 : 0) + (up8 ? 4 : 0);
    const unsigned short* selp = SEL + 16 * g; const unsigned* wp = WH + 8 * g; const bf16* hp = H1B + 256 * s + 32 * c + k0;
    typedef unsigned u32x2v __attribute__((ext_vector_type(2)));
#define LD_IDXW(I, W, HR, tt) do { const size_t t_ = (size_t)((tt) < T ? (tt) : T - 1); I.i0 = *(const GAS v4u*)(selp + t_ * NSEL); I.i1 = *(const GAS v4u*)(selp + t_ * NSEL + 8); \
        W[0] = *(const GAS v4u*)(wp + t_ * (NSEL / 2)); W[1] = *(const GAS v4u*)(wp + t_ * (NSEL / 2) + 4); HR = *(const GAS u32x2v*)(hp + t_ * DMODEL); } while (0)
    TokIdx In, In2; v4u wc[2], wn[2], w2[2]; u32x2v hrc, hrn, hr2; v4u r[16];
    int t = gws;
    if (t >= T) return;
    { TokIdx Ic; LD_IDXW(Ic, wc, hrc, t); LD_IDXW(In, wn, hrn, t + nws);
#pragma unroll
      for (int b = 0; b < 16; ++b) r[b] = LD_ROW(Ic, b); }
#pragma unroll 1
    for (; t < T; t += nws) {
        LD_IDXW(In2, w2, hr2, t + 2 * nws);
        h2v ov[16];
#pragma unroll
        for (int k = 0; k < 16; ++k) ov[k] = (h2v){(_Float16)0.f, (_Float16)0.f};
#pragma unroll
        for (int b = 0; b < 16; ++b) {
            const unsigned wu_ = (b >> 3) ? ((((b >> 1) & 3) == 0) ? wc[1].x : (((b >> 1) & 3) == 1) ? wc[1].y : (((b >> 1) & 3) == 2) ? wc[1].z : wc[1].w) : ((((b >> 1) & 3) == 0) ? wc[0].x : (((b >> 1) & 3) == 1) ? wc[0].y : (((b >> 1) & 3) == 2) ? wc[0].z : wc[0].w);
            const h2v wp_ = __builtin_bit_cast(h2v, wu_); const h2v wv = (b & 1) ? (h2v){wp_.y, wp_.y} : (h2v){wp_.x, wp_.x};
            asm volatile("" : "+v"(r[b]));
#pragma unroll
            for (int q = 0; q < 4; ++q) { ov[4 * q] += wv * __builtin_amdgcn_cvt_scalef32_pk_f16_fp4(r[b][q], 1.0f, 0); ov[4 * q + 1] += wv * __builtin_amdgcn_cvt_scalef32_pk_f16_fp4(r[b][q], 1.0f, 1);
                ov[4 * q + 2] += wv * __builtin_amdgcn_cvt_scalef32_pk_f16_fp4(r[b][q], 1.0f, 2); ov[4 * q + 3] += wv * __builtin_amdgcn_cvt_scalef32_pk_f16_fp4(r[b][q], 1.0f, 3); }
            r[b] = LD_ROW(In, b);
        }
#pragma unroll
        for (int i = 0; i < 8; ++i) { const h2v keep = up32 ? ov[8 + i] : ov[i], send = up32 ? ov[i] : ov[8 + i];
            ov[i] = keep + __builtin_bit_cast(h2v, __float_as_uint(xchg32(__uint_as_float(__builtin_bit_cast(unsigned, send)), up32))); }
#pragma unroll
        for (int i = 0; i < 4; ++i) { const h2v keep = up16 ? ov[4 + i] : ov[i], send = up16 ? ov[i] : ov[4 + i];
            ov[i] = keep + __builtin_bit_cast(h2v, (unsigned)__shfl_xor((int)__builtin_bit_cast(unsigned, send), 16)); }
        float o[4];
#pragma unroll
        for (int i = 0; i < 2; ++i) { const h2v keep = up8 ? ov[2 + i] : ov[i], send = up8 ? ov[i] : ov[2 + i];
            const h2v got = __builtin_bit_cast(h2v, (unsigned)__shfl_xor((int)__builtin_bit_cast(unsigned, send), 8));
            o[2 * i] = (float)keep.x + (float)got.x; o[2 * i + 1] = (float)keep.y + (float)got.y; }
        const float a0 = __uint_as_float(hrc.x << 16) + o[0] * (1.0f / VSCALE), a1 = __uint_as_float(hrc.x & 0xffff0000u) + o[1] * (1.0f / VSCALE);
        const float a2 = __uint_as_float(hrc.y << 16) + o[2] * (1.0f / VSCALE), a3 = __uint_as_float(hrc.y & 0xffff0000u) + o[3] * (1.0f / VSCALE);
        *(GAS u32x2v*)(H2B + (size_t)t * DMODEL + 256 * s + 32 * c + k0) = (u32x2v){pk2(a0, a1), pk2(a2, a3)};
        const float ss = wave_sum((a0 * a0 + a1 * a1) + (a2 * a2 + a3 * a3));
        if (F.lane == 0) SS2P[(size_t)t * 4 + s] = ss;
        In = In2; hrc = hrn; hrn = hr2;
#pragma unroll
        for (int q = 0; q < 2; ++q) { wc[q] = wn[q]; wn[q] = w2[q]; }
    }
#undef LD_ROW
#undef LD_IDXW
}

constexpr int N_PHASES = 10;
struct Args { const float* in[23]; float* out; unsigned char* ws; int ph_lo, ph_hi; };
__global__ void __launch_bounds__(NWAVES * 64, 2) mega_fwd(Args args) {
    extern __shared__ __attribute__((aligned(16))) unsigned char lds[];
    Frame F;
    F.lds = (LAS unsigned char*)lds;
    F.MISC = (volatile LAS unsigned*)(F.lds + MISC_OFF);
    F.tid = threadIdx.x; F.lane = F.tid & 63; F.wave = __builtin_amdgcn_readfirstlane(F.tid >> 6);
    F.G = gridDim.x; { const int bx = blockIdx.x; F.vcu = (F.G % 8 == 0) ? (bx % 8) * (F.G / 8) + bx / 8 : bx; }
    F.ws = args.ws; F.ctl = (gu32*)(args.ws + WS_CTL); F.out = args.out;
#pragma unroll
    for (int i = 0; i < 23; ++i) F.in[i] = args.in[i];
    for (int u = F.tid; u < (LDS_BYTES - LDSCTL_OFF) / 4; u += NWAVES * 64) ((LAS unsigned*)(F.lds + LDSCTL_OFF))[u] = 0u;
    __syncthreads();
    const int lo = args.ph_lo, hi = args.ph_hi;
    XcdBarrier bar; bar.bar = (unsigned*)(F.ctl + CW_BAR); bar.x = 0; bar.st = nullptr;
    if (hi - lo > 1) bar = xcd_barrier_post((unsigned*)(F.ctl + CW_BAR), F.MISC + 8);
#define IN(k) ((((PH_MASK) >> (k)) & 1) && lo <= (k) && (k) < hi)
#define SEAM(k) do { if (IN(k) && IN((k) + 1)) xcd_barrier(bar); } while (0)

    if (IN(0)) { p0_prologue(F); SEAM(0); }

    if (IN(1)) {
        p1_scan(F);
        pg8::Gemm g{(const pg8::bf16_t*)(F.ws + WS_XB), (const pg8::bf16_t*)(F.ws + WS_WI), T, NINP, DMODEL};
        pg8::StaticOrder S; S.init(T, NINP, F.G, (int)blockIdx.x);
        { const float* RS1 = (const float*)(F.ws + WS_RS1); LAS float* tab = (LAS float*)(F.lds + RSA_OFF); pg8::Unit u;
          float tv_[8]; int nu_ = 0;
#pragma unroll
          for (int i = 0; i < 8; ++i) { const bool ok_ = S.next(i, u); tv_[i] = (ok_ && F.tid < 256) ? RS1[u.pm * 256 + F.tid] : 0.f; nu_ += ok_ ? 1 : 0; }
#pragma unroll
          for (int i = 0; i < 8; ++i) if (i < nu_ && F.tid < 256) tab[i * 256 + F.tid] = tv_[i];
          __syncthreads(); }
        pg8::EpiInProj E{(pg8::bf16_t*)(F.ws + WS_QKV), (pg8::bf16_t*)(F.ws + WS_U), RSA_OFF - RING_OFF, F.in[I_Q_NORM], F.in[I_K_NORM]};
        pg8::gemm_phase<pg8::EpiInProj, pg8::StaticOrder, true, true>(F.lds + RING_OFF, g, S, E);
        SEAM(1);
    }

    if (IN(2)) {
        static_assert(attn_body::LDS_BYTES <= RING_BYTES, "attention LDS");
        const attn_body::AttnTensors AT{(const attn_body::bf16*)(F.ws + WS_QKV), (const attn_body::bf16*)(F.ws + WS_QKV) + 512, (const attn_body::bf16*)(F.ws + WS_QKV) + 1024,
                                        (attn_body::bf16*)(F.ws + WS_Y), (const float*)(F.ws + WS_G), (float*)(F.ws + WS_SSA)};
        const attn_body::StaticOrder S((int)F.G, (int)blockIdx.x);
        for (int r_ = 0; r_ < ATTN_REPS; ++r_) attn_body::attn_phase<attn_body::StaticOrder>((char*)lds + RING_OFF, AT, S);
        for (int r_ = 0; r_ < CONV_REPS; ++r_) p2_conv(F);
        SEAM(2);
    }

    if (IN(3)) {
        pg8::Gemm g{(const pg8::bf16_t*)(F.ws + WS_Y), (const pg8::bf16_t*)(F.ws + WS_WO), T, DMODEL, DMODEL};
        pg8::StaticOrder S; S.init(T, DMODEL, F.G, (int)blockIdx.x);
        { const float* SSA = (const float*)(F.ws + WS_SSA); LAS float* tab = (LAS float*)(F.lds + RSA_OFF); pg8::Unit u;
          for (int i = 0; i < 8 && S.next(i, u); ++i) if (F.tid < 256) { const int row = u.pm * 256 + F.tid;
              const f32x4 s0 = *(const f32x4*)(SSA + (size_t)row * 8), s1 = *(const f32x4*)(SSA + (size_t)row * 8 + 4);
              tab[i * 256 + F.tid] = 1.0f / sqrtf(((s0.x + s0.y) + (s0.z + s0.w) + (s1.x + s1.y) + (s1.z + s1.w)) * (1.0f / DATT) + EPS); }
          __syncthreads(); }
        pg8::EpiOutProj E{(const pg8::bf16_t*)(F.ws + WS_XB), (pg8::bf16_t*)(F.ws + WS_H1B), (float*)(F.ws + WS_SS1P), (const float*)(F.ws + WS_SSA), F.ws + WS_H1Q, RSA_OFF - RING_OFF};
        pg8::gemm_phase<pg8::EpiOutProj, pg8::StaticOrder, true, true>(F.lds + RING_OFF, g, S, E);
        SEAM(3);
    }
    if (IN(4)) {
        pg8::Gemm g{(const pg8::bf16_t*)(F.ws + WS_H1B), (const pg8::bf16_t*)(F.ws + WS_WQ), T, PH * PQ, DMODEL};
        pg8::StaticOrder S; S.init(T, PH * PQ, F.G, (int)blockIdx.x);
        { const float* SS1P = (const float*)(F.ws + WS_SS1P); LAS float* tab = (LAS float*)(F.lds + RSA_OFF); pg8::Unit u;
          for (int i0 = 0; i0 < 8; i0 += 4) {
          f32x4 tb_[4][4]; int nu_ = 0;
#pragma unroll
          for (int i = 0; i < 4; ++i) { const bool ok_ = S.next(i0 + i, u); const float* sp = SS1P + ((ok_ && F.tid < 256) ? (size_t)(u.pm * 256 + F.tid) : 0) * 16;
#pragma unroll
              for (int q4_ = 0; q4_ < 4; ++q4_) tb_[i][q4_] = *(const f32x4*)(sp + 4 * q4_); nu_ += ok_ ? 1 : 0; }
#pragma unroll
          for (int i = 0; i < 4; ++i) if (i < nu_ && F.tid < 256) { float s = 0.f;
#pragma unroll
              for (int q4_ = 0; q4_ < 4; ++q4_) { const f32x4 v = tb_[i][q4_]; s += (v.x + v.y) + (v.z + v.w); }
              tab[(i0 + i) * 256 + F.tid] = 1.0f / sqrtf(s * (1.0f / DMODEL) + EPS); }
          if (nu_ < 4) break; }
          __syncthreads(); }
        pg8::EpiRowScale E{(pg8::bf16_t*)(F.ws + WS_QP), 0, RSA_OFF - RING_OFF};
        pg8::gemm_phase<pg8::EpiRowScale, pg8::StaticOrder, true, true>(F.lds + RING_OFF, g, S, E);
        SEAM(4);
    }
    if (IN(5)) { p5_topk(F); SEAM(5); }
    if (IN(6)) {
        pg8::Gemm g{(const pg8::bf16_t*)(F.ws + WS_PB), (const pg8::bf16_t*)(F.ws + WS_WP), T, DMODEL, DPLE};
        pg8::StaticOrder S; S.init(T, DMODEL, F.G, (int)blockIdx.x);
        pg8::EpiRowScale E{(pg8::bf16_t*)(F.ws + WS_PLE), DMODEL, -1};
        pg8::gemm_phase<pg8::EpiRowScale, pg8::StaticOrder, true, true>(F.lds + RING_OFF, g, S, E);
        p6_experts_u<0xffffu>(F, (float*)(F.ws + WS_PD), 0);
#if PROBE_U
        p6_experts_u<PROBE_U_MASK>(F, F.out, 2);
#endif
        SEAM(6);
    }
    if (IN(7)) { p6b_reduce(F); SEAM(7); }
    if (IN(8)) { p7_experts_v(F); SEAM(8); }
    if (IN(9)) {
        pg8::Gemm g{(const pg8::bf16_t*)(F.ws + WS_H2B), (const pg8::bf16_t*)(F.ws + WS_WG), T, DMODEL, DMODEL};
        pg8::StaticOrder S; S.init(T, DMODEL, F.G, (int)blockIdx.x);
        { const float* SS2P = (const float*)(F.ws + WS_SS2); LAS float* tab = (LAS float*)(F.lds + RSA_OFF); pg8::Unit u;
          for (int i = 0; i < 8 && S.next(i, u); ++i) if (F.tid < 256) { const f32x4 v0 = *(const f32x4*)(SS2P + (size_t)(u.pm * 256 + F.tid) * 4);
              tab[i * 256 + F.tid] = 1.0f / sqrtf(((v0.x + v0.y) + (v0.z + v0.w)) * (1.0f / DMODEL) + EPS); }
          __syncthreads(); }
        pg8::EpiFinal E{(const pg8::bf16_t*)(F.ws + WS_H2B), (const pg8::bf16_t*)(F.ws + WS_PLE), RSA_OFF - RING_OFF, F.out};
        pg8::gemm_phase<pg8::EpiFinal, pg8::StaticOrder, true, true>(F.lds + RING_OFF, g, S, E);
    }

#undef IN
#undef SEAM
}

#if SELFCHECK
namespace chk {
constexpr int NS = 64;
__device__ __forceinline__ int sample_token(int i) {
    switch (i) { case 0: return 0; case 1: return 2047; case 2: return 2048; case 3: return T - 1; case 4: return 255; case 5: return 256; case 6: return 31; case 7: return 2048 * 7 + 1000; default: break; }
    return (int)(((long)i * 7919 + 13) % T);
}
__device__ __forceinline__ float bf2f(unsigned short v) { return __uint_as_float((unsigned)v << 16); }
__device__ float block_sum(float v, float* red) {
    for (int o = 1; o < 64; o <<= 1) v += __shfl_xor(v, o);
    const int w = threadIdx.x >> 6, nw = blockDim.x >> 6;
    __syncthreads(); if ((threadIdx.x & 63) == 0) red[w] = v; __syncthreads();
    float t = 0.f; for (int i = 0; i < nw; ++i) t += red[i];
    return t;
}
__device__ float block_max(float v, float* red) {
    for (int o = 1; o < 64; o <<= 1) v = fmaxf(v, __shfl_xor(v, o));
    const int w = threadIdx.x >> 6, nw = blockDim.x >> 6;
    __syncthreads(); if ((threadIdx.x & 63) == 0) red[w] = v; __syncthreads();
    float t = red[0]; for (int i = 1; i < nw; ++i) t = fmaxf(t, red[i]);
    return t;
}
__device__ void verdict(unsigned* code, int bit, float d2, float r2, float tol) { if (threadIdx.x == 0 && !(d2 <= tol * tol * r2 + 1e-10f)) atomicOr(code, 1u << bit); }

__global__ void __launch_bounds__(256) chk_inproj(Args a) {
    __shared__ float zs[NIN]; __shared__ float xs[DMODEL]; __shared__ float msq[16]; __shared__ float red[8];
    const int t = sample_token(blockIdx.x), tid = threadIdx.x; unsigned* code = (unsigned*)(a.ws + WS_CTL) + CW_CODE;
    const float* x = a.in[I_X] + (size_t)t * DMODEL; float s = 0.f;
    for (int k = tid; k < DMODEL; k += 256) s += x[k] * x[k];
    const float rs = 1.0f / sqrtf(block_sum(s, red) / DMODEL + EPS);
    for (int k = tid; k < DMODEL; k += 256) xs[k] = x[k] * rs * a.in[I_LN_MIX][k];
    __syncthreads();
    for (int c = tid; c < NIN; c += 256) { float acc = 0.f; const float* w = a.in[I_W_IN] + c; for (int k = 0; k < DMODEL; ++k) acc += xs[k] * w[(size_t)k * NIN]; zs[c] = acc; }
    __syncthreads();
    if (tid < 16) { float m = 0.f; for (int d = 0; d < 64; ++d) { const float v = zs[64 * tid + d]; m += v * v; } msq[tid] = m / 64.f; }
    __syncthreads();
    const unsigned short* QKV = (const unsigned short*)(a.ws + WS_QKV) + (size_t)t * 1536; const unsigned short* U = (const unsigned short*)(a.ws + WS_U) + (size_t)t * 512;
    float d2[5] = {0, 0, 0, 0, 0}, r2[5] = {0, 0, 0, 0, 0};
    for (int i = tid; i < 512; i += 256) { const int h = i >> 6, d = i & 63;
        float e = zs[i] / sqrtf(msq[h] + EPS) * a.in[I_Q_NORM][d] * pg8::ATT_C2, v = bf2f(QKV[i]); d2[0] += (e - v) * (e - v); r2[0] += e * e;
        e = zs[512 + i] / sqrtf(msq[8 + h] + EPS) * a.in[I_K_NORM][d]; v = bf2f(QKV[512 + i]); d2[1] += (e - v) * (e - v); r2[1] += e * e;
        e = zs[1024 + i]; v = bf2f(QKV[1024 + i]); d2[2] += (e - v) * (e - v); r2[2] += e * e;
        e = zs[COL_A + i] / (1.f + expf(-zs[COL_G + i])); v = bf2f(U[i]); d2[3] += (e - v) * (e - v); r2[3] += e * e; }
    if (tid < 8) { const float z = zs[COL_F + tid] + a.in[I_B_FGATE][tid]; const float e = (fminf(z, 0.f) - log1pf(expf(-fabsf(z)))) * LOG2E, v = ((const float*)(a.ws + WS_LF))[(size_t)t * 8 + tid]; d2[4] += (e - v) * (e - v); r2[4] += e * e; }
    for (int g = 0; g < 5; ++g) { const float dd = block_sum(d2[g], red), rr = block_sum(r2[g], red); verdict(code, g, dd, rr, 2e-2f); }
}
__global__ void chk_scan(Args a) {
    const int i = threadIdx.x; unsigned* code = (unsigned*)(a.ws + WS_CTL) + CW_CODE;
    const int bh = (i * 5) % (BATCH * NH), s = i == 0 ? 0 : (i == 1 ? SEQ - 1 : (i * 331 + 77) % SEQ), b = bh >> 3, h = bh & 7;
    const float* LF = (const float*)(a.ws + WS_LF); double acc = 0.0; for (int u = 0; u <= s; ++u) acc += LF[((size_t)b * SEQ + u) * 8 + h];
    const float v = ((const float*)(a.ws + WS_G))[(size_t)bh * SEQ + s];
    if (!(fabsf(v - (float)acc) <= 2e-3f * (1.f + fabsf((float)acc)))) atomicOr(code, 1u << 5);
}
__global__ void __launch_bounds__(256) chk_attn(Args a) {
    __shared__ float l[SEQ]; __shared__ float qs[64]; __shared__ float part[4][64]; __shared__ float red[8];
    const int t = sample_token(blockIdx.x), h = blockIdx.x & 7, tid = threadIdx.x, b = t / SEQ, st = t % SEQ; unsigned* code = (unsigned*)(a.ws + WS_CTL) + CW_CODE;
    const unsigned short* QKV = (const unsigned short*)(a.ws + WS_QKV); const float* G = (const float*)(a.ws + WS_G) + (size_t)(b * NH + h) * SEQ;
    if (tid < 64) qs[tid] = bf2f(QKV[(size_t)t * 1536 + 64 * h + tid]);
    __syncthreads();
    float mx = -INFINITY;
    for (int s = tid; s <= st; s += 256) { const unsigned short* kr = QKV + ((size_t)b * SEQ + s) * 1536 + 512 + 64 * h; float acc = 0.f; for (int d = 0; d < 64; ++d) acc += qs[d] * bf2f(kr[d]);
        acc += G[st] - G[s]; l[s] = acc; mx = fmaxf(mx, acc); }
    mx = block_max(mx, red);
    float sm = 0.f; for (int s = tid; s <= st; s += 256) { const float p = exp2f(l[s] - mx); l[s] = p; sm += p; }
    sm = block_sum(sm, red);
    { const int d = tid & 63, pt = tid >> 6; float acc = 0.f; for (int s = pt; s <= st; s += 4) acc += l[s] * bf2f(QKV[((size_t)b * SEQ + s) * 1536 + 1024 + 64 * h + d]); part[pt][d] = acc; }
    __syncthreads();
    float d2 = 0.f, r2 = 0.f, e2 = 0.f;
    if (tid < 64) { const float e = (part[0][tid] + part[1][tid] + part[2][tid] + part[3][tid]) / sm, v = bf2f(((const unsigned short*)(a.ws + WS_Y))[(size_t)t * 1024 + 64 * h + tid]); d2 = (e - v) * (e - v); r2 = e * e; e2 = e * e; }
    d2 = block_sum(d2, red); r2 = block_sum(r2, red); verdict(code, 6, d2, r2, 3e-2f);
    if (tid == 0) { const float v = ((const float*)(a.ws + WS_SSA))[(size_t)t * 8 + h]; if (!(fabsf(v - r2) <= 0.05f * r2 + 1e-6f)) atomicOr(code, 1u << 7); }
}
__global__ void __launch_bounds__(512) chk_conv(Args a) {
    __shared__ float red[8];
    const int t = sample_token(blockIdx.x), c = threadIdx.x, b = t / SEQ, st = t % SEQ; unsigned* code = (unsigned*)(a.ws + WS_CTL) + CW_CODE;
    const unsigned short* U = (const unsigned short*)(a.ws + WS_U);
    float y = a.in[I_CONV_B][c];
    for (int j = 0; j < CW; ++j) { const int s = st - 30 + j; if (s >= 0) y += a.in[I_CONV_W][j * DCONV + c] * bf2f(U[((size_t)b * SEQ + s) * DCONV + c]); }
    const float mu = block_sum(y, red) / DCONV; const float var = block_sum((y - mu) * (y - mu), red) / DCONV;
    const float ln = (y - mu) / sqrtf(var + LN_EPS) * a.in[I_CONV_LN_G][c] + a.in[I_CONV_LN_B][c]; const float sw = ln / (1.f + expf(-ln));
    const float ss = block_sum(sw * sw, red) / DCONV; const float e = sw / sqrtf(ss + EPS);
    const float v = bf2f(((const unsigned short*)(a.ws + WS_Y))[(size_t)t * 1024 + 512 + c]);
    const float d2 = block_sum((e - v) * (e - v), red), r2 = block_sum(e * e, red); verdict(code, 8, d2, r2, 2e-2f);
}
__device__ __forceinline__ size_t qp_elem(int t, int n) { const int head = n >> 8, w = n & 255, half = w >> 7, cc = w & 127; return pg8::qpf_byte(t, head, half, cc >> 4, (cc >> 3) & 1) / 2 + (cc & 7); }
__device__ void dense_row(const float* a, int K, const float* W, int ldw, int N, float* out) {
    for (int n = threadIdx.x; n < N; n += blockDim.x) { float acc = 0.f; for (int k = 0; k < K; ++k) acc += a[k] * W[(size_t)k * ldw + n]; out[n] = acc; }
}
__global__ void __launch_bounds__(256) chk_outproj(Args a) {
    __shared__ float ys[DMODEL]; __shared__ float hs[DMODEL]; __shared__ float red[8];
    const int t = sample_token(blockIdx.x), tid = threadIdx.x; unsigned* code = (unsigned*)(a.ws + WS_CTL) + CW_CODE;
    const unsigned short* Y = (const unsigned short*)(a.ws + WS_Y) + (size_t)t * DMODEL;
    float s = 0.f; for (int c = tid; c < DATT; c += 256) { const float v = bf2f(Y[c]); s += v * v; }
    const float rsa = 1.0f / sqrtf(block_sum(s, red) / DATT + EPS);
    for (int c = tid; c < DMODEL; c += 256) ys[c] = c < DATT ? bf2f(Y[c]) * rsa * a.in[I_ATTN_OUT_NORM][c] : bf2f(Y[c]) * a.in[I_CONV_OUT_NORM][c - DATT];
    __syncthreads();
    dense_row(ys, DMODEL, a.in[I_W_OUT], DMODEL, DMODEL, hs);
    __syncthreads();
    float d2 = 0.f, r2 = 0.f;
    for (int n = tid; n < DMODEL; n += 256) { const float e = a.in[I_X][(size_t)t * DMODEL + n] + hs[n], v = bf2f(((const unsigned short*)(a.ws + WS_H1B))[(size_t)t * DMODEL + n]); d2 += (e - v) * (e - v); r2 += e * e; }
    d2 = block_sum(d2, red); r2 = block_sum(r2, red); verdict(code, 9, d2, r2, 2e-2f);
    if (tid == 0) { float ss = 0.f; for (int i = 0; i < 16; ++i) ss += ((const float*)(a.ws + WS_SS1P))[(size_t)t * 16 + i]; if (!(fabsf(ss - r2) <= 0.03f * r2)) atomicOr(code, 1u << 10); }
}
__global__ void __launch_bounds__(256) chk_peerq(Args a) {
    __shared__ float xs[DMODEL]; __shared__ float qs[PH * PQ]; __shared__ float red[8];
    const int t = sample_token(blockIdx.x), tid = threadIdx.x; unsigned* code = (unsigned*)(a.ws + WS_CTL) + CW_CODE;
    const unsigned short* H = (const unsigned short*)(a.ws + WS_H1B) + (size_t)t * DMODEL;
    float s = 0.f; for (int c = tid; c < DMODEL; c += 256) { const float v = bf2f(H[c]); s += v * v; }
    const float rs = 1.0f / sqrtf(block_sum(s, red) / DMODEL + EPS);
    for (int c = tid; c < DMODEL; c += 256) xs[c] = bf2f(H[c]) * rs * a.in[I_LN_FFN][c];
    __syncthreads();
    dense_row(xs, DMODEL, a.in[I_W_PEER_Q], PH * PQ, PH * PQ, qs);
    __syncthreads();
    float d2 = 0.f, r2 = 0.f;
    for (int n = tid; n < PH * PQ; n += 256) { const float e = qs[n], v = bf2f(((const unsigned short*)(a.ws + WS_QP))[qp_elem(t, n)]); d2 += (e - v) * (e - v); r2 += e * e; }
    d2 = block_sum(d2, red); r2 = block_sum(r2, red); verdict(code, 11, d2, r2, 2e-2f);
}
__global__ void __launch_bounds__(256) chk_topk(Args a) {
    __shared__ float s1[NKEY], s2[NKEY]; __shared__ float red[8]; __shared__ int bad;
    const int t = sample_token(blockIdx.x), h = (blockIdx.x * 3) & 7, tid = threadIdx.x; unsigned* code = (unsigned*)(a.ws + WS_CTL) + CW_CODE;
    const unsigned short* QPp = (const unsigned short*)(a.ws + WS_QP);
    if (tid == 0) bad = 0;
    { const int k = tid & 127, half = tid >> 7; const float* sk = (half ? a.in[I_SUB_KEYS2] : a.in[I_SUB_KEYS1]) + (size_t)k * PHALF; float acc = 0.f;
      for (int d = 0; d < PHALF; ++d) acc += bf2f(QPp[qp_elem(t, h * PQ + half * PHALF + d)]) * sk[d];
      if (half) s2[k] = acc; else s1[k] = acc; }
    __syncthreads();
    const unsigned short* sel = (const unsigned short*)(a.ws + WS_SEL) + (size_t)t * NSEL + h * PK; const float* gate = (const float*)(a.ws + WS_GATE) + (size_t)t * NSEL + h * PK;
    float cs[PK]; float mx = -INFINITY;
    for (int i = 0; i < PK; ++i) { const int e = sel[i]; cs[i] = s1[e >> 7] + s2[e & 127]; mx = fmaxf(mx, cs[i]); }
    for (int i = 0; i < PK; ++i) {
        int cnt = 0; for (int c = tid; c < NKEY * NKEY; c += 256) cnt += (s1[c >> 7] + s2[c & 127] > cs[i] + 2e-2f) ? 1 : 0;
        const float tot = block_sum((float)cnt, red); if (tid == 0 && tot >= 16.f) bad = 1;
        for (int j = 0; j < i; ++j) if (tid == 0 && sel[j] == sel[i]) bad = 1;
    }
    if (tid == 0) { float sum = 0.f; for (int i = 0; i < PK; ++i) sum += expf(cs[i] - mx);
        for (int i = 0; i < PK; ++i) { const float e = expf(cs[i] - mx) / sum; if (!(fabsf(gate[i] - e) <= 0.02f * e + 1e-4f)) bad = 1; }
        if (bad) atomicOr(code, 1u << 12); }
}
__global__ void __launch_bounds__(256) chk_experts(Args a) {
    __shared__ float xs[DMODEL]; __shared__ float ws_[NSEL]; __shared__ float red[8];
    const int t = sample_token(blockIdx.x), tid = threadIdx.x; unsigned* code = (unsigned*)(a.ws + WS_CTL) + CW_CODE;
    const unsigned short* H = (const unsigned short*)(a.ws + WS_H1B) + (size_t)t * DMODEL;
    float s = 0.f; for (int c = tid; c < DMODEL; c += 256) { const float v = bf2f(H[c]); s += v * v; }
    const float rs = 1.0f / sqrtf(block_sum(s, red) / DMODEL + EPS);
    for (int c = tid; c < DMODEL; c += 256) xs[c] = bf2f(H[c]) * rs * a.in[I_LN_FFN][c];
    __syncthreads();
    const unsigned short* sel = (const unsigned short*)(a.ws + WS_SEL) + (size_t)t * NSEL; const float* gate = (const float*)(a.ws + WS_GATE) + (size_t)t * NSEL;
    float d2 = 0.f, r2 = 0.f;
    if (tid < NSEL) { const float* u = a.in[I_EXPERT_U] + (size_t)sel[tid] * DMODEL; float acc = 0.f; for (int d = 0; d < DMODEL; ++d) acc += u[d] * xs[d];
        const float act = 0.5f * acc * (1.f + tanhf(0.7978845608028654f * (acc + 0.044715f * acc * acc * acc))); const float e = gate[tid] * act, v = ((const float*)(a.ws + WS_WACT))[(size_t)t * NSEL + tid];
        ws_[tid] = e; d2 = (e - v) * (e - v); r2 = e * e; }
    d2 = block_sum(d2, red); r2 = block_sum(r2, red); verdict(code, 13, d2, r2, 2.5e-1f);
    __syncthreads();
    d2 = 0.f; r2 = 0.f;
    for (int d = tid; d < DMODEL; d += 256) { float acc = bf2f(H[d]); for (int j = 0; j < NSEL; ++j) acc += ws_[j] * a.in[I_EXPERT_V][(size_t)sel[j] * DMODEL + d];
        const float v = bf2f(((const unsigned short*)(a.ws + WS_H2B))[(size_t)t * DMODEL + d]); d2 += (acc - v) * (acc - v); r2 += acc * acc; }
    d2 = block_sum(d2, red); r2 = block_sum(r2, red); verdict(code, 14, d2, r2, 5e-2f);
    if (tid == 0) { float ss = 0.f; for (int i = 0; i < 4; ++i) ss += ((const float*)(a.ws + WS_SS2))[(size_t)t * 4 + i]; if (!(fabsf(ss - r2) <= 0.03f * r2)) atomicOr(code, 1u << 15); }
}
__global__ void __launch_bounds__(256) chk_ple(Args a) {
    __shared__ float ps[DPLE]; __shared__ float os[DMODEL]; __shared__ float red[8];
    const int t = sample_token(blockIdx.x), tid = threadIdx.x; unsigned* code = (unsigned*)(a.ws + WS_CTL) + CW_CODE;
    for (int c = tid; c < DPLE; c += 256) ps[c] = a.in[I_P][(size_t)t * DPLE + c];
    __syncthreads();
    dense_row(ps, DPLE, a.in[I_W_PL_PROJ], DMODEL, DMODEL, os);
    __syncthreads();
    float d2 = 0.f, r2 = 0.f;
    for (int n = tid; n < DMODEL; n += 256) { const float e = os[n], v = bf2f(((const unsigned short*)(a.ws + WS_PLE))[(size_t)t * DMODEL + n]); d2 += (e - v) * (e - v); r2 += e * e; }
    d2 = block_sum(d2, red); r2 = block_sum(r2, red); verdict(code, 16, d2, r2, 2e-2f);
}
__global__ void __launch_bounds__(256) chk_final(Args a) {
    __shared__ float xs[DMODEL]; __shared__ float gs[DMODEL]; __shared__ float red[8];
    const int t = sample_token(blockIdx.x), tid = threadIdx.x; unsigned* code = (unsigned*)(a.ws + WS_CTL) + CW_CODE;
    const unsigned short* H = (const unsigned short*)(a.ws + WS_H2B) + (size_t)t * DMODEL;
    float s = 0.f; for (int c = tid; c < DMODEL; c += 256) { const float v = bf2f(H[c]); s += v * v; }
    const float rs = 1.0f / sqrtf(block_sum(s, red) / DMODEL + EPS);
    for (int c = tid; c < DMODEL; c += 256) xs[c] = bf2f(H[c]) * rs * a.in[I_LN_PL][c];
    __syncthreads();
    dense_row(xs, DMODEL, a.in[I_W_PL_GATE], DMODEL, DMODEL, gs);
    __syncthreads();
    float d2 = 0.f, r2 = 0.f;
    for (int n = tid; n < DMODEL; n += 256) { const float e = bf2f(H[n]) + bf2f(((const unsigned short*)(a.ws + WS_PLE))[(size_t)t * DMODEL + n]) / (1.f + expf(-gs[n])), v = a.out[(size_t)t * DMODEL + n]; d2 += (e - v) * (e - v); r2 += e * e; }
    d2 = block_sum(d2, red); r2 = block_sum(r2, red); verdict(code, 17, d2, r2, 1e-2f);
}

__global__ void finish(Args a, int complete) {
    const unsigned code = ((const unsigned*)(a.ws + WS_CTL))[CW_CODE];
    const float add = code ? 1000.f * (float)(1 + __builtin_ctz(code)) : 0.f;
    for (size_t i = (size_t)blockIdx.x * blockDim.x + threadIdx.x; i < (size_t)T * DMODEL; i += (size_t)gridDim.x * blockDim.x) a.out[i] = (complete ? a.out[i] : 0.f) + add;
}
}
#endif

extern "C" void kernel_launch(void* const* d_in, const int* in_sizes, int n_in, void* d_out, int out_size, void* d_ws, size_t ws_size, hipStream_t stream) {
    static int grid = 0;
    if (grid == 0) {
        if (n_in != 23 || in_sizes[0] != T * DMODEL || out_size != T * DMODEL || ws_size < WS_END) { fprintf(stderr, "kernel_launch: unexpected problem (n_in %d, in0 %d, out %d, ws %zu); nothing launched\n", n_in, n_in > 0 ? in_sizes[0] : -1, out_size, ws_size); grid = -1; return; }
        int dev = 0, cus = 0, per_cu = 0;
        if (hipGetDevice(&dev) != hipSuccess || hipDeviceGetAttribute(&cus, hipDeviceAttributeMultiprocessorCount, dev) != hipSuccess) { grid = -1; return; }
        if (hipFuncSetAttribute((const void*)mega_fwd, hipFuncAttributeMaxDynamicSharedMemorySize, LDS_BYTES) != hipSuccess) { fprintf(stderr, "kernel_launch: hipFuncSetAttribute failed\n"); grid = -1; return; }
        if (hipOccupancyMaxActiveBlocksPerMultiprocessor(&per_cu, (const void*)mega_fwd, NWAVES * 64, LDS_BYTES) != hipSuccess || per_cu < 1) { fprintf(stderr, "kernel_launch: occupancy query says %d\n", per_cu); per_cu = 1; }
        (void)hipGetLastError();
        grid = cus;
    }
    if (grid < 0) return;
    (void)hipMemsetAsync((char*)d_ws + WS_CTL, 0, CTL_ZERO_BYTES, stream);
    Args a{};
    for (int i = 0; i < 23; ++i) a.in[i] = (const float*)d_in[i];
    a.out = (float*)d_out; a.ws = (unsigned char*)d_ws;
    constexpr int LASTP = LAST_PHASE < N_PHASES - 1 ? LAST_PHASE : N_PHASES - 1;
#if MK_ONE_LAUNCH
    a.ph_lo = 0; a.ph_hi = LASTP + 1;
    void* kargs[] = {&a};
    hipError_t e = hipLaunchCooperativeKernel((const void*)mega_fwd, dim3(grid), dim3(NWAVES * 64), kargs, LDS_BYTES, stream);
    if (e != hipSuccess) fprintf(stderr, "kernel_launch: cooperative launch failed: %s (grid %d)\n", hipGetErrorString(e), grid);
#else
    for (int ph = 0; ph <= LASTP; ++ph) {
        a.ph_lo = ph; a.ph_hi = ph + 1;
        for (int rep = 0; rep < 1 + (((REPEAT_MASK) >> ph) & 1) * (REPEAT_N - 1); ++rep) hipLaunchKernelGGL(mega_fwd, dim3(grid), dim3(NWAVES * 64), LDS_BYTES, stream, a);
#if SELFCHECK
        if (ph == 1) { hipLaunchKernelGGL(chk::chk_inproj, dim3(chk::NS), dim3(256), 0, stream, a); hipLaunchKernelGGL(chk::chk_scan, dim3(1), dim3(64), 0, stream, a); }
        if (ph == 2) { hipLaunchKernelGGL(chk::chk_attn, dim3(chk::NS), dim3(256), 0, stream, a); hipLaunchKernelGGL(chk::chk_conv, dim3(chk::NS), dim3(512), 0, stream, a); }
                if (ph == 3) hipLaunchKernelGGL(chk::chk_outproj, dim3(chk::NS), dim3(256), 0, stream, a);
        if (ph == 4) hipLaunchKernelGGL(chk::chk_peerq, dim3(chk::NS), dim3(256), 0, stream, a);
        if (ph == 5) hipLaunchKernelGGL(chk::chk_topk, dim3(chk::NS), dim3(256), 0, stream, a);
        if (ph == 6) hipLaunchKernelGGL(chk::chk_ple, dim3(chk::NS), dim3(256), 0, stream, a);
        if (ph == 8) hipLaunchKernelGGL(chk::chk_experts, dim3(chk::NS), dim3(256), 0, stream, a);
        if (ph == 9) hipLaunchKernelGGL(chk::chk_final, dim3(chk::NS), dim3(256), 0, stream, a);

#endif
    }
#endif
#if SELFCHECK
    hipLaunchKernelGGL(chk::finish, dim3(2048), dim3(256), 0, stream, a, (int)(LASTP == N_PHASES - 1));
#endif
}
```

```cpp
#include <hip/hip_runtime.h>
#include <hip/hip_bf16.h>
#include <cstdio>
#include <cstdint>
#include <cmath>

#define MK_ONE_LAUNCH 1
#define SELFCHECK 0
#ifndef LAST_PHASE
#define LAST_PHASE 99
#endif

#ifndef SLICE_BY_XCC
#define SLICE_BY_XCC 1
#endif
#ifndef ATTN_REPS
#define ATTN_REPS 1
#endif
#ifndef CONV_REPS
#define CONV_REPS 1
#endif
#ifndef PROBE_U
#define PROBE_U 0
#endif
#ifndef PROBE_U_MASK
#define PROBE_U_MASK 0xffffu
#endif
#ifndef REPEAT_MASK
#define REPEAT_MASK 0
#endif
#ifndef REPEAT_N
#define REPEAT_N 2
#endif
#ifndef PROBE_MODE
#define PROBE_MODE 0
#endif
#ifndef PROBE_N
#define PROBE_N 4
#endif
#ifndef PROBE_PH
#define PROBE_PH 3
#endif
#ifndef CONV_SPLIT
#define CONV_SPLIT 1
#endif
#ifndef CONV_V_PH
#define CONV_V_PH 5
#endif
#ifndef P0_SPLIT
#define P0_SPLIT 0
#endif
#ifndef ATTN_DYNAMIC
#define ATTN_DYNAMIC 1
#endif
#ifndef TOPK_LOCAL
#define TOPK_LOCAL 1
#endif
#ifndef V_INWAVE_W
#define V_INWAVE_W 0
#endif
#ifndef CONV_IN_SEAMS
#define CONV_IN_SEAMS 1
#endif
#ifndef PLE_SPLIT
#define PLE_SPLIT 1
#endif
#ifndef P_LATE
#define P_LATE 1
#endif
#ifndef PD_F16
#define PD_F16 1
#endif
#ifndef U_DOT8
#define U_DOT8 1
#endif
#ifndef PH_MASK
#define PH_MASK 0x3ff
#endif

constexpr int BATCH = 16, SEQ = 2048, DMODEL = 1024, T = BATCH * SEQ;
constexpr int DATT = 512, NH = 8, HD = 64, DCONV = 512, CW = 31;
constexpr int NIN = 2568, NINP = 2560;
constexpr int COL_F = 1536, COL_A = 1544, COL_G = 2056;
constexpr int NKEY = 128, NEXP = 16384, PH = 8, PQ = 256, PHALF = 128, PK = 16, NSEL = PH * PK;
constexpr int DPLE = 256;
constexpr float EPS = 1e-6f, LN_EPS = 1e-5f;
constexpr float LOG2E = 1.4426950408889634f;

namespace pg8 {
#define PG8_LAS __attribute__((address_space(3)))
typedef unsigned short bf16_t;
typedef short bf16x8 __attribute__((ext_vector_type(8)));
typedef float f32x4 __attribute__((ext_vector_type(4)));
typedef unsigned u32x4 __attribute__((ext_vector_type(4)));
constexpr int BM = 256, BK = 64, HALF = 128, HTB = HALF * BK * 2  , STAGE_BYTES = 8 * HTB, NXCD = 8, WGM = 8;

__host__ __device__ __forceinline__ int lds_byte(int r, int c) { const int st = (r >> 4) * 2 + (c >> 5), rr = r & 15, cc = c & 31, ob = rr * 64 + cc * 2; return st * 1024 + (ob ^ (((ob >> 9) & 1) << 5)); }
__host__ __device__ __forceinline__ void stage_rc(int b, int& R, int& C) { const int st = b / 1024, sb = b % 1024, swz = sb ^ (((sb >> 9) & 1) << 5); R = (st >> 1) * 16 + swz / 64; C = (st & 1) * 32 + (swz % 64) / 2; }
__host__ __device__ __forceinline__ int perm32(int rho) { const int n = rho >> 4, i = rho & 15; return 8 * (i >> 2) + 4 * n + (i & 3); }

struct Unit { int pm, pn; };
struct Gemm { const bf16_t* A; const bf16_t* Bt; int M, N, K; };

struct StaticOrder {
    int nM, nN, nwg, G, c;
    __host__ __device__ __forceinline__ void init(int M, int N, int G_, int c_) { nM = M / BM; nN = N / BM; nwg = nM * nN; G = G_; c = c_; }
    __host__ __device__ __forceinline__ bool next(int i, Unit& u) const {
        const long L = (long)i * G + c; if (L >= nwg) return false;
        int wgid = (int)L; { const int q = nwg / NXCD, r = nwg % NXCD, xcd = wgid % NXCD, off = wgid / NXCD; wgid = (xcd < r ? xcd * (q + 1) : r * (q + 1) + (xcd - r) * q) + off; }
        const int nig = WGM * nN, gid = wgid / nig, fm = gid * WGM, gsz = (nM - fm) < WGM ? (nM - fm) : WGM;
        u.pm = fm + ((wgid % nig) % gsz); u.pn = (wgid % nig) / gsz; return true;
    }
    __device__ __forceinline__ void a_ready(const Unit&) const {}
    __device__ __forceinline__ void done(const Unit&) const {}
};

template <int I0, int N> struct SubOrder {
    StaticOrder S;
    __device__ __forceinline__ bool next(int i, Unit& u) const { return i < N && S.next(I0 + i, u); }
    __device__ __forceinline__ void a_ready(const Unit&) const {}
    __device__ __forceinline__ void done(const Unit&) const {}
};

template <class Epi, class Sched, bool ALIGN_EPI = false, bool SP2 = false>
__device__ __forceinline__ void gemm_phase(PG8_LAS unsigned char* lds, const Gemm g, const Sched& S, const Epi& E) {
    int tid_ = threadIdx.x; asm volatile("" : "+v"(tid_));
    const int tid = tid_, wid = __builtin_amdgcn_readfirstlane(tid >> 6), lane = tid & 63, wr = wid >> 2, wc = wid & 3, fr = lane & 15, fq = lane >> 4;
    const int K = g.K, nt = K / BK;
    unsigned voffA[2], voffB[2];
#pragma unroll
    for (int i = 0; i < 2; ++i) { int R, C; stage_rc(tid * 16 + i * 8192, R, C); const int Rb = Epi::PERM ? ((R & ~31) + perm32(R & 31)) : R;
        voffA[i] = (unsigned)(R * K + C) * 2u; voffB[i] = (unsigned)(Rb * K + C) * 2u; }
    const size_t kstep = (size_t)(BK * 2);
    const size_t hstep = (size_t)HALF * K * 2;
    const size_t tstep = 2 * hstep;
    const unsigned ldsw = (unsigned)wid * 1024u;
    const int aoff = lds_byte(wr * 64 + fr, fq * 8), boff = lds_byte(wc * 32 + fr, fq * 8);
#define PG8_SA(b, h) (((b) * 2 + (h)) * HTB)
#define PG8_SB(b, h) ((4 + (b) * 2 + (h)) * HTB)
#define PG8_STAGE(bufoff, gbase, voff) do { _Pragma("unroll") for (int _i = 0; _i < 2; ++_i) \
        __builtin_amdgcn_global_load_lds((const unsigned*)((const char*)(gbase) + (voff)[_i]), (PG8_LAS unsigned*)(lds + (bufoff) + ldsw + _i * 8192), 16, 0, 0); } while (0)
#define PG8_LDA(dst, b, h) do { _Pragma("unroll") for (int m = 0; m < 4; ++m) _Pragma("unroll") for (int k = 0; k < 2; ++k) dst[m][k] = *(const PG8_LAS bf16x8*)(lds + PG8_SA(b, h) + aoff + m * 2048 + k * 1024); } while (0)
#define PG8_LDB(dst, b, h) do { _Pragma("unroll") for (int n = 0; n < 2; ++n) _Pragma("unroll") for (int k = 0; k < 2; ++k) dst[n][k] = *(const PG8_LAS bf16x8*)(lds + PG8_SB(b, h) + boff + n * 2048 + k * 1024); } while (0)
#define PG8_MMA(ai, bj, At, Bt) do { __builtin_amdgcn_s_setprio(1); _Pragma("unroll") for (int m = 0; m < 4; ++m) _Pragma("unroll") for (int n = 0; n < 2; ++n) _Pragma("unroll") for (int k = 0; k < 2; ++k) \
        acc[ai][bj][m][n] = __builtin_amdgcn_mfma_f32_16x16x32_bf16(Bt[n][k], At[m][k], acc[ai][bj][m][n], 0, 0, 0); __builtin_amdgcn_s_setprio(0); } while (0)
#define PG8_WAIT_V(n) asm volatile("s_waitcnt vmcnt(" #n ")" ::: "memory")
#define PG8_WAIT_L(n) asm volatile("s_waitcnt lgkmcnt(" #n ")" ::: "memory")
#define PG8_BAR __builtin_amdgcn_s_barrier()
#define PG8_SCHED __builtin_amdgcn_sched_barrier(0)
    Unit cur, nxt; int ui = 0;
    if (!S.next(0, cur)) return;
    f32x4 acc[2][2][4][2];
#pragma unroll
    for (int a = 0; a < 2; ++a)
#pragma unroll
        for (int b = 0; b < 2; ++b)
#pragma unroll
            for (int m = 0; m < 4; ++m)
#pragma unroll
                for (int n = 0; n < 2; ++n) acc[a][b][m][n] = (f32x4){0.f, 0.f, 0.f, 0.f};
    bf16x8 At[4][2], B0[2][2], B1[2][2];
    const char* cA = (const char*)g.A + (size_t)cur.pm * tstep; const char* cB = (const char*)g.Bt + (size_t)cur.pn * tstep;
    S.a_ready(cur);
    if constexpr (SP2) {
        PG8_STAGE(PG8_SB(0, 0), cB, voffB); PG8_STAGE(PG8_SB(0, 1), cB + hstep, voffB); PG8_STAGE(PG8_SA(0, 0), cA, voffA); PG8_STAGE(PG8_SA(0, 1), cA + hstep, voffA);
        if (wr == 1) PG8_BAR;
        PG8_WAIT_V(2); PG8_BAR;
        PG8_STAGE(PG8_SB(1, 0), cB + kstep, voffB); PG8_STAGE(PG8_SA(1, 0), cA + kstep, voffA); PG8_STAGE(PG8_SB(1, 1), cB + hstep + kstep, voffB);
        PG8_WAIT_V(6); PG8_BAR;
    } else {
        PG8_STAGE(PG8_SB(0, 0), cB, voffB); PG8_STAGE(PG8_SA(0, 0), cA, voffA); PG8_STAGE(PG8_SB(0, 1), cB + hstep, voffB); PG8_STAGE(PG8_SA(0, 1), cA + hstep, voffA);
        if (wr == 1) PG8_BAR;
        PG8_WAIT_V(4); PG8_BAR;
        PG8_STAGE(PG8_SB(1, 0), cB + kstep, voffB); PG8_STAGE(PG8_SA(1, 0), cA + kstep, voffA); PG8_STAGE(PG8_SB(1, 1), cB + hstep + kstep, voffB);
        PG8_WAIT_V(6); PG8_BAR;
    }
    for (;;) {
        const bool has_next = S.next(ui + 1, nxt);
        const char* nA = has_next ? (const char*)g.A + (size_t)nxt.pm * tstep : cA; const char* nB = has_next ? (const char*)g.Bt + (size_t)nxt.pn * tstep : cB;
        for (int t = 0; t < nt; t += 2) {
            if constexpr (Epi::MIDK > 0) { if (t == Epi::MIDK) E.mid(acc, cur, ui, lds, wr, wc, fr, fq); }
            const bool last = (t == nt - 2);
            const char* a1 = cA + (size_t)(t + 1) * kstep;
            const char* a2 = last ? nA : cA + (size_t)(t + 2) * kstep; const char* b2 = last ? nB : cB + (size_t)(t + 2) * kstep;
            const char* a3 = a2 + kstep; const char* b3 = b2 + kstep;
            if (last && has_next) S.a_ready(nxt);
            if constexpr (SP2) {
            PG8_LDB(B0, 0, 0); PG8_LDB(B1, 0, 1); PG8_SCHED; PG8_LDA(At, 0, 0); PG8_STAGE(PG8_SA(1, 1), a1 + hstep, voffA);
            PG8_WAIT_V(8); PG8_WAIT_L(0); PG8_BAR; PG8_MMA(0, 0, At, B0); PG8_MMA(0, 1, At, B1); PG8_BAR; PG8_SCHED;
            PG8_LDA(At, 0, 1); PG8_STAGE(PG8_SB(0, 0), b2, voffB); PG8_STAGE(PG8_SB(0, 1), b2 + hstep, voffB); PG8_STAGE(PG8_SA(0, 0), a2, voffA);
            PG8_WAIT_V(8); PG8_WAIT_L(0); PG8_BAR; PG8_MMA(1, 0, At, B0); PG8_MMA(1, 1, At, B1); PG8_BAR; PG8_SCHED;
            PG8_LDB(B0, 1, 0); PG8_LDB(B1, 1, 1); PG8_SCHED; PG8_LDA(At, 1, 0); PG8_STAGE(PG8_SA(0, 1), a2 + hstep, voffA);
            PG8_WAIT_V(8); PG8_WAIT_L(0); PG8_BAR; PG8_MMA(0, 0, At, B0); PG8_MMA(0, 1, At, B1); PG8_BAR; PG8_SCHED;
            PG8_LDA(At, 1, 1); PG8_STAGE(PG8_SB(1, 0), b3, voffB); PG8_STAGE(PG8_SB(1, 1), b3 + hstep, voffB); PG8_STAGE(PG8_SA(1, 0), a3, voffA);
            PG8_WAIT_V(8); PG8_WAIT_L(0); PG8_BAR; PG8_MMA(1, 0, At, B0); PG8_MMA(1, 1, At, B1); PG8_BAR; PG8_SCHED;
            } else {
            PG8_LDB(B0, 0, 0); PG8_SCHED; PG8_LDA(At, 0, 0); PG8_STAGE(PG8_SA(1, 1), a1 + hstep, voffA);
            PG8_WAIT_L(8); PG8_BAR; PG8_WAIT_L(0); PG8_MMA(0, 0, At, B0); PG8_BAR; PG8_SCHED;
            PG8_LDB(B1, 0, 1); PG8_STAGE(PG8_SB(0, 0), b2, voffB);
            PG8_BAR; PG8_WAIT_L(0); PG8_MMA(0, 1, At, B1); PG8_BAR;
            PG8_LDA(At, 0, 1); PG8_STAGE(PG8_SA(0, 0), a2, voffA);
            PG8_BAR; PG8_WAIT_L(0); PG8_MMA(1, 0, At, B0); PG8_BAR; PG8_SCHED;
            PG8_STAGE(PG8_SB(0, 1), b2 + hstep, voffB);
            PG8_WAIT_V(6); PG8_BAR; PG8_MMA(1, 1, At, B1); PG8_BAR;
            PG8_LDB(B0, 1, 0); PG8_SCHED; PG8_LDA(At, 1, 0); PG8_STAGE(PG8_SA(0, 1), a2 + hstep, voffA);
            PG8_WAIT_L(8); PG8_BAR; PG8_WAIT_L(0); PG8_MMA(0, 0, At, B0); PG8_BAR; PG8_SCHED;
            PG8_LDB(B1, 1, 1); PG8_STAGE(PG8_SB(1, 0), b3, voffB);
            PG8_BAR; PG8_WAIT_L(0); PG8_MMA(0, 1, At, B1); PG8_BAR;
            PG8_LDA(At, 1, 1); PG8_STAGE(PG8_SA(1, 0), a3, voffA);
            PG8_BAR; PG8_WAIT_L(0); PG8_MMA(1, 0, At, B0); PG8_BAR; PG8_SCHED;
            PG8_STAGE(PG8_SB(1, 1), b3 + hstep, voffB);
            PG8_WAIT_V(6); PG8_BAR; PG8_MMA(1, 1, At, B1); PG8_BAR;
            }
        }
        if constexpr (ALIGN_EPI) { if (wr == 0) PG8_BAR; }
        if constexpr (!Epi::AFTER_DRAIN) { E(acc, cur, ui, lds, wr, wc, fr, fq); S.done(cur); }
        if (!has_next) break;
#pragma unroll
        for (int a = 0; a < 2; ++a)
#pragma unroll
            for (int b = 0; b < 2; ++b)
#pragma unroll
                for (int m = 0; m < 4; ++m)
#pragma unroll
                    for (int n = 0; n < 2; ++n) acc[a][b][m][n] = (f32x4){0.f, 0.f, 0.f, 0.f};
        cur = nxt; cA = nA; cB = nB; ++ui;
        if constexpr (ALIGN_EPI) { if (wr == 1) PG8_BAR; }
    }
    PG8_WAIT_V(0);
    if constexpr (!ALIGN_EPI) { if (wr == 0) PG8_BAR; }
    PG8_BAR;
    if constexpr (Epi::AFTER_DRAIN) { E.fused(acc, cur, wr, wc, fr, fq, lds, wid, lane); S.done(cur); }
#undef PG8_SA
#undef PG8_SB
#undef PG8_STAGE
#undef PG8_LDA
#undef PG8_LDB
#undef PG8_MMA
#undef PG8_WAIT_V
#undef PG8_WAIT_L
#undef PG8_BAR
#undef PG8_SCHED
}
}
namespace pg8 {
typedef float f32x2_t __attribute__((ext_vector_type(2))); typedef __bf16 bf16x2_t __attribute__((ext_vector_type(2)));
__device__ __forceinline__ unsigned cvt_pk_bf16(float lo, float hi) { f32x2_t v = {lo, hi}; bf16x2_t b = __builtin_convertvector(v, bf16x2_t); return __builtin_bit_cast(unsigned, b); }
__device__ __forceinline__ u32x4 pack8(const f32x4 a, const f32x4 b) { u32x4 w; w.x = cvt_pk_bf16(a[0], a[1]); w.y = cvt_pk_bf16(a[2], a[3]); w.z = cvt_pk_bf16(b[0], b[1]); w.w = cvt_pk_bf16(b[2], b[3]); return w; }
__device__ __forceinline__ float bf_lo(unsigned w) { return __uint_as_float(w << 16); }
__device__ __forceinline__ float bf_hi(unsigned w) { return __uint_as_float(w & 0xffff0000u); }
__device__ __forceinline__ float sigmoidf_fast(float v) { return __builtin_amdgcn_rcpf(1.0f + __builtin_amdgcn_exp2f(-v * 1.4426950408889634f)); }
constexpr float ATT_C2 = 0.125f * 1.4426950408889634f;

struct EpiInProj {
    static constexpr bool PERM = true, AFTER_DRAIN = false; static constexpr int MIDK = 0;
    bf16_t* QKV; bf16_t* U; int tab_off; const float* qn; const float* kn;
    __device__ __forceinline__ void mid(f32x4 (&)[2][2][4][2], const Unit&, int, PG8_LAS unsigned char*, int, int, int, int) const {}
    __device__ __forceinline__ void operator()(const f32x4 (&acc)[2][2][4][2], const Unit& u, int ui, PG8_LAS unsigned char* lds, int wr, int wc, int fr, int fq) const {
        const int row0 = u.pm * BM + wr * 64 + fr; const PG8_LAS float* tab = (const PG8_LAS float*)(lds + tab_off) + ui * BM + wr * 64 + fr;
        if (u.pn < 6) {
            const int kind = u.pn >> 1, head = 4 * (u.pn & 1) + wc;
            f32x4 gs[2][2];
#pragma unroll
            for (int bj = 0; bj < 2; ++bj)
#pragma unroll
                for (int n = 0; n < 2; ++n) { const int d = 32 * bj + 8 * fq + 4 * n;
                    gs[bj][n] = kind == 0 ? *(const f32x4*)(qn + d) * ATT_C2 : (kind == 1 ? *(const f32x4*)(kn + d) : (f32x4){1.f, 1.f, 1.f, 1.f}); }
            bf16_t* base = QKV + kind * 512 + head * 64 + 8 * fq;
#pragma unroll
            for (int ai = 0; ai < 2; ++ai)
#pragma unroll
                for (int m = 0; m < 4; ++m) { const int row = row0 + ai * HALF + m * 16; const float rs = tab[ai * HALF + m * 16];
                    f32x4 z[2][2]; float ss = 0.f;
#pragma unroll
                    for (int bj = 0; bj < 2; ++bj)
#pragma unroll
                        for (int n = 0; n < 2; ++n) { z[bj][n] = acc[ai][bj][m][n] * rs; const f32x4 q = z[bj][n] * z[bj][n]; ss += (q[0] + q[1]) + (q[2] + q[3]); }
                    float inv = 1.f;
                    if (kind < 2) { ss += __shfl_xor(ss, 16); ss += __shfl_xor(ss, 32); inv = __builtin_amdgcn_rsqf(ss * (1.0f / 64.0f) + 1e-6f); }
#pragma unroll
                    for (int bj = 0; bj < 2; ++bj) *(u32x4*)(base + (size_t)row * 1536 + 32 * bj) = pack8(z[bj][0] * inv * gs[bj][0], z[bj][1] * inv * gs[bj][1]); }
        } else {
            bf16_t* base = U + 128 * (u.pn - 6) + 32 * wc + 8 * fq;
#pragma unroll
            for (int ai = 0; ai < 2; ++ai)
#pragma unroll
                for (int m = 0; m < 4; ++m) { const int row = row0 + ai * HALF + m * 16; const float rs = tab[ai * HALF + m * 16];
                    f32x4 uu[2];
#pragma unroll
                    for (int n = 0; n < 2; ++n) { const f32x4 a = acc[ai][0][m][n] * rs, g = acc[ai][1][m][n] * rs;
                        uu[n] = (f32x4){a[0] * sigmoidf_fast(g[0]), a[1] * sigmoidf_fast(g[1]), a[2] * sigmoidf_fast(g[2]), a[3] * sigmoidf_fast(g[3])}; }
                    *(u32x4*)(base + (size_t)row * 512) = pack8(uu[0], uu[1]); }
        }
    }
};

template <int MODE> struct EpiOutProjT {
    static constexpr bool PERM = true, AFTER_DRAIN = false; static constexpr int MIDK = 8;
    const bf16_t* x; bf16_t* H1B; float* SS1P; const float* SSA; unsigned char* H1Q;
    int rsa_off;
    __device__ __forceinline__ void mid(f32x4 (&acc)[2][2][4][2], const Unit& u, int ui, PG8_LAS unsigned char* lds, int wr, int wc, int fr, int fq) const {
        const PG8_LAS float* tab = (const PG8_LAS float*)(lds + rsa_off) + ui * BM + wr * 64 + fr;
#pragma unroll
        for (int ai = 0; ai < 2; ++ai)
#pragma unroll
            for (int m = 0; m < 4; ++m) { const float rsa = tab[ai * HALF + m * 16];
#pragma unroll
                for (int bj = 0; bj < 2; ++bj)
#pragma unroll
                    for (int n = 0; n < 2; ++n) acc[ai][bj][m][n] *= rsa; }
    }
    __device__ __forceinline__ void operator()(const f32x4 (&acc)[2][2][4][2], const Unit& u, int ui, PG8_LAS unsigned char* lds, int wr, int wc, int fr, int fq) const {
        const int row0 = u.pm * BM + wr * 64 + fr, col0 = u.pn * BM + wc * 32 + 8 * fq;
        if constexpr (MODE == 1) { f32x4 s_ = acc[0][0][0][0];
#pragma unroll
            for (int i_ = 1; i_ < 32; ++i_) s_ += acc[i_ >> 4][(i_ >> 3) & 1][(i_ >> 1) & 3][i_ & 1];
            if ((s_[0] + s_[1]) + (s_[2] + s_[3]) == 12345.0f) SS1P[0] = 1.f; return; }
        u32x4 xv[2][4][2];
#pragma unroll
        for (int ai = 0; ai < 2; ++ai)
#pragma unroll
            for (int m = 0; m < 4; ++m)
#pragma unroll
                for (int bj = 0; bj < 2; ++bj) { const unsigned off = (unsigned)(row0 + ai * HALF + m * 16) * 1024u + (unsigned)(col0 + bj * HALF);
                    if constexpr (MODE != 3) xv[ai][m][bj] = *(const u32x4*)(x + off); else xv[ai][m][bj] = (u32x4){0u, 0u, 0u, 0u}; }
#pragma unroll
        for (int ai = 0; ai < 2; ++ai) {
#pragma unroll
            for (int m = 0; m < 4; ++m) { const int row = row0 + ai * HALF + m * 16; float ss = 0.f;
#pragma unroll
                for (int bj = 0; bj < 2; ++bj) { const unsigned off = (unsigned)row * 1024u + (unsigned)(col0 + bj * HALF);
                    const u32x4 xw = xv[ai][m][bj]; f32x4 h0, h1;
                    h0[0] = bf_lo(xw.x) + acc[ai][bj][m][0][0]; h0[1] = bf_hi(xw.x) + acc[ai][bj][m][0][1]; h0[2] = bf_lo(xw.y) + acc[ai][bj][m][0][2]; h0[3] = bf_hi(xw.y) + acc[ai][bj][m][0][3];
                    h1[0] = bf_lo(xw.z) + acc[ai][bj][m][1][0]; h1[1] = bf_hi(xw.z) + acc[ai][bj][m][1][1]; h1[2] = bf_lo(xw.w) + acc[ai][bj][m][1][2]; h1[3] = bf_hi(xw.w) + acc[ai][bj][m][1][3];
                    ss += (h0[0] * h0[0] + h0[1] * h0[1]) + (h0[2] * h0[2] + h0[3] * h0[3]) + (h1[0] * h1[0] + h1[1] * h1[1]) + (h1[2] * h1[2] + h1[3] * h1[3]);
                    if constexpr (MODE == 2) { if (ss == 12345.0f) *(u32x4*)(H1B + off) = pack8(h0, h1); } else *(u32x4*)(H1B + off) = pack8(h0, h1);
#if U_DOT8
#define Q8(v) __float_as_uint(__builtin_fmaf(__builtin_amdgcn_fmed3f((v), -119.0f / 14.0f, 119.0f / 14.0f), 14.0f, 12582912.0f))
#else
#define Q8(v) __float_as_uint(__builtin_fmaf(__builtin_amdgcn_fmed3f((v), -127.0f / 14.0f, 127.0f / 14.0f), 14.0f, 12582912.0f))
#endif
#define PK4(a, b, c, d) (__builtin_amdgcn_perm(Q8(b), Q8(a), 0x0c0c0400u) | __builtin_amdgcn_perm(Q8(d), Q8(c), 0x04000c0cu))
                    { unsigned ev = PK4(h0[0], h0[2], h1[0], h1[2]), od = PK4(h0[1], h0[3], h1[1], h1[3]);
#if U_DOT8
                      { const unsigned ae = (((ev >> 4) & 0x0F0F0F0Fu) + ((ev >> 3) & 0x01010101u)) & 0x0F0F0F0Fu, ao = (((od >> 4) & 0x0F0F0F0Fu) + ((od >> 3) & 0x01010101u)) & 0x0F0F0F0Fu;
                        const unsigned be = ev & 0x0F0F0F0Fu, bo = od & 0x0F0F0F0Fu; ev = ae | (ao << 4); od = be | (bo << 4); }
#endif
#undef PK4
#undef Q8
                      if constexpr (MODE == 2) { if (ss == 12345.0f) *(unsigned long long*)(H1Q + off) = (unsigned long long)ev | ((unsigned long long)od << 32); } else *(unsigned long long*)(H1Q + off) = (unsigned long long)ev | ((unsigned long long)od << 32); } }
                ss += __shfl_xor(ss, 16); ss += __shfl_xor(ss, 32);
                if (fq == 0) SS1P[(unsigned)row * 16u + (unsigned)(u.pn * 4 + wc)] = ss; }
        }
    }
};
typedef EpiOutProjT<0> EpiOutProj;

__host__ __device__ __forceinline__ size_t qpf_byte(int row, int head, int half, int ks, int hi) { return ((((size_t)(row >> 5) * 8 + head) * 2 + half) * 8 + ks) * 1024 + (size_t)(hi * 32 + (row & 31)) * 16; }
struct EpiRowScale {
    static constexpr bool PERM = true, AFTER_DRAIN = false; static constexpr int MIDK = 0;
    bf16_t* O; int ldc; int tab_off;
    __device__ __forceinline__ void mid(f32x4 (&)[2][2][4][2], const Unit&, int, PG8_LAS unsigned char*, int, int, int, int) const {}
    __device__ __forceinline__ void operator()(const f32x4 (&acc)[2][2][4][2], const Unit& u, int ui, PG8_LAS unsigned char* lds, int wr, int wc, int fr, int fq) const {
        const int row0 = u.pm * BM + wr * 64 + fr, col0 = u.pn * BM + wc * 32 + 8 * fq; const PG8_LAS float* tab = (const PG8_LAS float*)(lds + (tab_off < 0 ? 0 : tab_off)) + ui * BM + wr * 64 + fr;
#pragma unroll
        for (int ai = 0; ai < 2; ++ai)
#pragma unroll
            for (int m = 0; m < 4; ++m) { const int row = row0 + ai * HALF + m * 16; const float rs = tab_off < 0 ? 1.0f : tab[ai * HALF + m * 16];
#pragma unroll
                for (int bj = 0; bj < 2; ++bj) { const u32x4 w = pack8(acc[ai][bj][m][0] * rs, acc[ai][bj][m][1] * rs);
                    if (ldc > 0) *(u32x4*)(O + ((unsigned)row * (unsigned)ldc + (unsigned)(col0 + bj * HALF))) = w;
                    else *(u32x4*)((unsigned char*)O + qpf_byte(row, u.pn, bj, 2 * wc + (fq >> 1), fq & 1)) = w; } }
    }
};

struct EpiFinal {
    static constexpr bool PERM = true, AFTER_DRAIN = false; static constexpr int MIDK = 0;
    const bf16_t* H2B; const bf16_t* PLE; int tab_off; float* out;
    typedef __fp16 h2_t __attribute__((ext_vector_type(2)));
    __device__ __forceinline__ void mid(f32x4 (&)[2][2][4][2], const Unit&, int, PG8_LAS unsigned char*, int, int, int, int) const {}
    template <int AI> __device__ __forceinline__ void loads(u32x4 (&hh)[2][4][2], u32x4 (&pp)[2][4][2], int row0, int col0) const {
#pragma unroll
        for (int m = 0; m < 4; ++m)
#pragma unroll
            for (int bj = 0; bj < 2; ++bj) { const unsigned off = (unsigned)(row0 + AI * HALF + m * 16) * 1024u + (unsigned)(col0 + bj * HALF); hh[AI][m][bj] = *(const u32x4*)(H2B + off); pp[AI][m][bj] = *(const u32x4*)(PLE + off); }
    }
    template <int AI, int M0, int M1> __device__ __forceinline__ void gates(const f32x4 (&acc)[2][2][4][2], h2_t (&gk)[2][4][2][4], const PG8_LAS float* tab) const {
#pragma unroll
        for (int m = M0; m < M1; ++m) { const float rs = tab[AI * HALF + m * 16] * -1.4426950408889634f;
#define sigmoidf_fast(v) __builtin_amdgcn_rcpf(1.0f + __builtin_amdgcn_exp2f(v))
#pragma unroll
            for (int bj = 0; bj < 2; ++bj) { const f32x4 a0 = acc[AI][bj][m][0] * rs, a1 = acc[AI][bj][m][1] * rs;
                gk[AI][m][bj][0] = __builtin_amdgcn_cvt_pkrtz(sigmoidf_fast(a0[0]), sigmoidf_fast(a0[1])); gk[AI][m][bj][1] = __builtin_amdgcn_cvt_pkrtz(sigmoidf_fast(a0[2]), sigmoidf_fast(a0[3]));
                gk[AI][m][bj][2] = __builtin_amdgcn_cvt_pkrtz(sigmoidf_fast(a1[0]), sigmoidf_fast(a1[1])); gk[AI][m][bj][3] = __builtin_amdgcn_cvt_pkrtz(sigmoidf_fast(a1[2]), sigmoidf_fast(a1[3])); } }
#undef sigmoidf_fast
    }
    template <int AI> __device__ __forceinline__ void outs(const u32x4 (&hh)[2][4][2], const u32x4 (&pp)[2][4][2], const h2_t (&gk)[2][4][2][4], int row0, int col0) const {
#pragma unroll
        for (int m = 0; m < 4; ++m)
#pragma unroll
            for (int bj = 0; bj < 2; ++bj) { const unsigned off = (unsigned)(row0 + AI * HALF + m * 16) * 1024u + (unsigned)(col0 + bj * HALF);
                const u32x4 h = hh[AI][m][bj], p = pp[AI][m][bj];
                f32x4 o0, o1;
                o0[0] = __builtin_fmaf((float)gk[AI][m][bj][0][0], bf_lo(p.x), bf_lo(h.x)); o0[1] = __builtin_fmaf((float)gk[AI][m][bj][0][1], bf_hi(p.x), bf_hi(h.x));
                o0[2] = __builtin_fmaf((float)gk[AI][m][bj][1][0], bf_lo(p.y), bf_lo(h.y)); o0[3] = __builtin_fmaf((float)gk[AI][m][bj][1][1], bf_hi(p.y), bf_hi(h.y));
                o1[0] = __builtin_fmaf((float)gk[AI][m][bj][2][0], bf_lo(p.z), bf_lo(h.z)); o1[1] = __builtin_fmaf((float)gk[AI][m][bj][2][1], bf_hi(p.z), bf_hi(h.z));
                o1[2] = __builtin_fmaf((float)gk[AI][m][bj][3][0], bf_lo(p.w), bf_lo(h.w)); o1[3] = __builtin_fmaf((float)gk[AI][m][bj][3][1], bf_hi(p.w), bf_hi(h.w));
                *(f32x4*)(out + off) = o0; *(f32x4*)(out + off + 4) = o1; }
    }
    __device__ __forceinline__ void operator()(const f32x4 (&acc)[2][2][4][2], const Unit& u, int ui, PG8_LAS unsigned char* lds, int wr, int wc, int fr, int fq) const {
        const int row0 = u.pm * BM + wr * 64 + fr, col0 = u.pn * BM + wc * 32 + 8 * fq; const PG8_LAS float* tab = (const PG8_LAS float*)(lds + tab_off) + ui * BM + wr * 64 + fr;
        u32x4 hh[2][4][2], pp[2][4][2]; h2_t gk[2][4][2][4];
        loads<0>(hh, pp, row0, col0);  __builtin_amdgcn_sched_barrier(0);
        gates<0, 0, 4>(acc, gk, tab);  gates<1, 0, 3>(acc, gk, tab); __builtin_amdgcn_sched_barrier(0);
        loads<1>(hh, pp, row0, col0);  __builtin_amdgcn_sched_barrier(0);
        gates<1, 3, 4>(acc, gk, tab);  __builtin_amdgcn_sched_barrier(0);
        outs<0>(hh, pp, gk, row0, col0); outs<1>(hh, pp, gk, row0, col0);
    }
};
}

#include <hip/hip_bf16.h>
namespace attn_body {
using bf16=__hip_bfloat16;
using bf16x8=__attribute__((ext_vector_type(8)))short;
using s16x4=__attribute__((ext_vector_type(4)))short;
using f32x16=__attribute__((ext_vector_type(16)))float;
using u32x4=__attribute__((ext_vector_type(4)))unsigned;
typedef float f32x4_t __attribute__((ext_vector_type(4)));
constexpr int BATCH=16,NHEAD=8,SEQ=2048,D=64,DMI=1536,DMO=1024;
constexpr int NW=8,QBLK=32,QB=QBLK*NW,KVBLK=64,NQB=SEQ/QB;
constexpr int ATTN_UNIT_ROWS=QB;
__device__ __forceinline__ int crow(int r,int hi){return (r&3)+8*(r>>2)+4*hi;}
#define SBAR() __builtin_amdgcn_sched_barrier(0)
__device__ __forceinline__ void cmask(f32x16&p0,f32x16&p1,int jb,int qrel,int hi){
  const float NEG=-INFINITY; int kb=64*jb+4*hi;
  #pragma unroll
  for(int r=0;r<16;++r){int kv=kb+(r&3)+8*(r>>2); if(kv>qrel)p0[r]=NEG; if(kv+32>qrel)p1[r]=NEG;}
}

constexpr int NSLOT=3, SLOTB=8192;
constexpr int LDS_K=0, LDS_V=NSLOT*SLOTB, LDS_WS=2*NSLOT*SLOTB, LDS_OST=LDS_WS+NW*64*4, LDS_GB=LDS_OST+NW*4096, LDS_BYTES=LDS_GB+SEQ*4;
constexpr float SKIP_THR=-100.0f;
constexpr float C2=0.125f*1.4426950408889634f;
__device__ __forceinline__ void glds16(const void*gsrc,unsigned lds_dst){unsigned keep;
  asm volatile("s_mov_b32 %0, m0\n\ts_mov_b32 m0, %2\n\ts_nop 0\n\tglobal_load_lds_dwordx4 %1, off\n\ts_mov_b32 m0, %0":"=&s"(keep):"v"(gsrc),"s"(lds_dst):"memory");}
__device__ __forceinline__ float max3f(float a,float b,float c){float r;asm("v_max3_f32 %0, %1, %2, %3":"=v"(r):"v"(a),"v"(b),"v"(c));return r;}
__device__ __forceinline__ float max2f(float a,float b){float r;asm("v_max_f32_e32 %0, %1, %2":"=v"(r):"v"(a),"v"(b));return r;}
__device__ __forceinline__ float fadd_s(float a,float b){float r;asm("v_add_f32_e32 %0, %1, %2":"=v"(r):"v"(a),"v"(b));return r;}
__device__ __forceinline__ float fsub_s(float a,float b){float r;asm("v_sub_f32_e32 %0, %1, %2":"=v"(r):"v"(a),"v"(b));return r;}
typedef float f32x2_t __attribute__((ext_vector_type(2))); typedef __bf16 bf16x2_t __attribute__((ext_vector_type(2)));
__device__ __forceinline__ unsigned cvtpk_s(float lo,float hi){f32x2_t v={lo,hi};bf16x2_t b=__builtin_convertvector(v,bf16x2_t);return __builtin_bit_cast(unsigned,b);}
#define WAIT_BAR(N) asm volatile("s_waitcnt vmcnt(" #N ") lgkmcnt(0)\n\ts_barrier":::"memory")

__device__ __forceinline__ void qkt(f32x16&p0,f32x16&p1,const char*Kslot,const bf16x8*qr,const f32x16&c0,const f32x16&c1,int r32,int hi){
  const char*kb=Kslot+hi*1024+r32*16;
  #pragma unroll
  for(int d0=0;d0<4;++d0){
    const bf16x8 b0=*reinterpret_cast<const bf16x8*>(kb+d0*2048);
    const bf16x8 b1=*reinterpret_cast<const bf16x8*>(kb+d0*2048+512);
    if(d0==0){p0=__builtin_amdgcn_mfma_f32_32x32x16_bf16(b0,qr[0],c0,0,0,0);p1=__builtin_amdgcn_mfma_f32_32x32x16_bf16(b1,qr[0],c1,0,0,0);}
    else{p0=__builtin_amdgcn_mfma_f32_32x32x16_bf16(b0,qr[d0],p0,0,0,0);p1=__builtin_amdgcn_mfma_f32_32x32x16_bf16(b1,qr[d0],p1,0,0,0);}}
}
typedef __attribute__((address_space(3))) const char* lds_cptr;
typedef short v4i16_t __attribute__((ext_vector_type(4)));
__device__ __forceinline__ void kload8(bf16x8*kf,lds_cptr kp){
  kf[0]=*(const __attribute__((address_space(3))) bf16x8*)(kp);      kf[1]=*(const __attribute__((address_space(3))) bf16x8*)(kp+512);
  kf[2]=*(const __attribute__((address_space(3))) bf16x8*)(kp+2048); kf[3]=*(const __attribute__((address_space(3))) bf16x8*)(kp+2560);
  kf[4]=*(const __attribute__((address_space(3))) bf16x8*)(kp+4096); kf[5]=*(const __attribute__((address_space(3))) bf16x8*)(kp+4608);
  kf[6]=*(const __attribute__((address_space(3))) bf16x8*)(kp+6144); kf[7]=*(const __attribute__((address_space(3))) bf16x8*)(kp+6656);
}
__device__ __forceinline__ void kload2(bf16x8*kf,lds_cptr kp,int j){ kf[2*j]=*(const __attribute__((address_space(3))) bf16x8*)(kp+j*2048); kf[2*j+1]=*(const __attribute__((address_space(3))) bf16x8*)(kp+j*2048+512); }
__device__ __forceinline__ s16x4 vtr(lds_cptr p){ return __builtin_bit_cast(s16x4,__builtin_amdgcn_ds_read_tr16_b64_v4i16((__attribute__((address_space(3))) v4i16_t*)p)); }
__device__ __forceinline__ float rowmax(const f32x16&p0,const f32x16&p1){
  float a=max3f(p0[0],p0[1],p1[0]),b=max3f(p0[2],p0[3],p1[1]);a=max3f(a,p1[2],p1[3]);
  #pragma unroll
  for(int r=4;r<16;r+=4){a=max3f(a,p0[r],p0[r+1]);b=max3f(b,p0[r+2],p0[r+3]);a=max3f(a,p1[r],p1[r+1]);b=max3f(b,p1[r+2],p1[r+3]);}
  const float m=max2f(a,b);
  auto rr=__builtin_amdgcn_permlane32_swap(__float_as_uint(m),__float_as_uint(m),false,false);
  return max2f(__uint_as_float(rr[0]),__uint_as_float(rr[1]));
}
__device__ __forceinline__ void pv(f32x16*o,int vb,bf16x8 pa0,bf16x8 pa1,bf16x8 pa2,bf16x8 pa3){
  #pragma unroll
  for(int d0=0;d0<2;++d0){s16x4 lo[4],hi[4];
    #pragma unroll
    for(int ks=0;ks<4;++ks){
      asm volatile("ds_read_b64_tr_b16 %0,%1 offset:%c2":"=&v"(lo[ks]):"v"(vb),"i"(d0*4096+ks*1024):"memory");
      asm volatile("ds_read_b64_tr_b16 %0,%1 offset:%c2":"=&v"(hi[ks]):"v"(vb),"i"(d0*4096+ks*1024+512):"memory");}
    asm volatile("s_waitcnt lgkmcnt(0)":::"memory");SBAR();
    #define PK(k) (bf16x8){lo[k][0],lo[k][1],lo[k][2],lo[k][3],hi[k][0],hi[k][1],hi[k][2],hi[k][3]}
    o[d0]=__builtin_amdgcn_mfma_f32_32x32x16_bf16(pa0,PK(0),o[d0],0,0,0);
    o[d0]=__builtin_amdgcn_mfma_f32_32x32x16_bf16(pa1,PK(1),o[d0],0,0,0);
    o[d0]=__builtin_amdgcn_mfma_f32_32x32x16_bf16(pa2,PK(2),o[d0],0,0,0);
    o[d0]=__builtin_amdgcn_mfma_f32_32x32x16_bf16(pa3,PK(3),o[d0],0,0,0);
    #undef PK
  }
}

#ifndef ATTN_STORE16
#define ATTN_STORE16(p,v) (*(u32x4*)(p)=(v))
#endif
template<int THRL> __device__ __forceinline__ void attn_unit(int b,int h,int qb,const bf16*Q,const bf16*__restrict__ K,const bf16*__restrict__ V,bf16*O,const float*Gf,float*SSA,char*shm,float skip_thr=SKIP_THR,float sref=0.5f*(-SKIP_THR-37.5f)){
  int tid_=threadIdx.x; asm volatile("":"+v"(tid_)); const int tid=tid_,lane=tid&63,r32=lane&31,hi=lane>>5; const int wid=__builtin_amdgcn_readfirstlane(tid>>6);
  const long rowbase=(long)b*SEQ; const int q0=qb*QB;
  const float*Gbh=Gf+((long)b*NHEAD+h)*SEQ; const float g0=Gbh[q0];
  int ts; { const int ntf=(q0+QB)/KVBLK, j_=2*lane; const bool dead_=(j_+6<=ntf) && (g0-Gbh[(j_+6<=ntf)?64*(j_+1)+63:0]<skip_thr);
    ts=2*__builtin_popcountll(__ballot(dead_)); ts=__builtin_amdgcn_readfirstlane(ts); }
  const bf16*Qw=Q+(rowbase+q0+wid*QBLK)*DMI+h*D;
  const bf16*Kh=K+(rowbase+64*ts)*DMI+h*D,*Vh=V+(rowbase+64*ts)*DMI+h*D;
  typedef __attribute__((address_space(3))) char* lds_wptr; const lds_wptr shm3w=(lds_wptr)shm;
  const unsigned lds0=(unsigned)(uintptr_t)shm;
  float*wsf=(float*)(shm+LDS_WS)+wid*64;
  const bf16*ksrc=Kh+(long)lane*DMI+wid*8;
  const bf16*vsrc=Vh+(long)(16*(wid&3)+(lane>>2))*DMI+(wid>>2)*32+(lane&3)*8;
  const unsigned kdst=lds0+LDS_K+wid*1024, vdst=lds0+LDS_V+wid*1024;
  #define DMA_K(t,slot) glds16(ksrc+(long)(t)*KVBLK*DMI,(unsigned)__builtin_amdgcn_readfirstlane(kdst+(slot)))
  #define DMA_V(t,slot) glds16(vsrc+(long)(t)*KVBLK*DMI,(unsigned)__builtin_amdgcn_readfirstlane(vdst+(slot)))
  const int vb0=(int)(lds0+LDS_V)+((lane>>4)&1)*32+(lane&3)*8+(4*hi+((lane&15)>>2))*64;
  const char*Kbase=shm+LDS_K; bf16x8 kf[8];
  const lds_cptr shm3=(lds_cptr)shm; const lds_cptr kp0=shm3+LDS_K+hi*1024+r32*16; const lds_cptr vp0=shm3+LDS_V+((lane>>4)&1)*32+(lane&3)*8+(4*hi+((lane&15)>>2))*64;
  const int NT=(q0+QB)/KVBLK-ts;
  DMA_K(0,0);DMA_V(0,0);DMA_K(1,SLOTB);
  { __attribute__((address_space(3))) float*gbw=(__attribute__((address_space(3))) float*)(shm3w+LDS_GB);
    float gv_[4];
    _Pragma("unroll") for(int k_=0;k_<4;++k_){const int s_=64*ts+tid+k_*NW*64; gv_[k_]=Gbh[s_<q0+QB?s_:q0];}
    _Pragma("unroll") for(int k_=0;k_<4;++k_){const int s_=64*ts+tid+k_*NW*64; if(s_<q0+QB)gbw[s_-64*ts]=g0-gv_[k_];} }
  bf16x8 qr[4];
  #pragma unroll
  for(int d0=0;d0<4;++d0)qr[d0]=*reinterpret_cast<const bf16x8*>(&Qw[(long)r32*DMI+d0*16+hi*8]);
  float mhat=0.f,l_reg=0.f;f32x16 o[2];o[0]=f32x16{};o[1]=f32x16{}; const float nm=__uint_as_float(__float_as_uint(-(sref+(g0-Gbh[q0+wid*QBLK+r32])))&0xffff0000u); const f32x16 zero16=f32x16{};
  bf16x8 kx=(bf16x8){0,0,0,0,0,0,0,0}, qx=(bf16x8){0,0,0,0,0,0,0,0}; if(hi==0){ kx[0]=(short)0x3F80; qx[0]=(short)(__float_as_uint(nm)>>16); }
  const __attribute__((address_space(3))) char*gbp0=(const __attribute__((address_space(3))) char*)(shm3w+LDS_GB)+hi*16;
  #define CBIAS(CA,CB,t) do{ const __attribute__((address_space(3))) char*gp_=gbp0+(t)*256; _Pragma("unroll") for(int g_=0;g_<4;++g_){ \
      const f32x4_t a_=*(const __attribute__((address_space(3))) f32x4_t*)(gp_+g_*32), b_=*(const __attribute__((address_space(3))) f32x4_t*)(gp_+128+g_*32); \
      _Pragma("unroll") for(int j_=0;j_<4;++j_){ CA[4*g_+j_]+=a_[j_]+nm; CB[4*g_+j_]+=b_[j_]+nm; } } }while(0)
  #define BLOAD(CA,CB,t) do{ const __attribute__((address_space(3))) char*gp_=gbp0+(t)*256; _Pragma("unroll") for(int g_=0;g_<4;++g_){ \
      const f32x4_t a_=*(const __attribute__((address_space(3))) f32x4_t*)(gp_+g_*32), b_=*(const __attribute__((address_space(3))) f32x4_t*)(gp_+128+g_*32); \
      _Pragma("unroll") for(int j_=0;j_<4;++j_){ CA[4*g_+j_]=a_[j_]; CB[4*g_+j_]=b_[j_]; } } }while(0)
  #define NMADD(CA,CB) do{ _Pragma("unroll") for(int r_=0;r_<16;++r_){ CA[r_]+=nm; CB[r_]+=nm; } }while(0)
  const int qrel=wid*QBLK+r32;
  #define CMASK(P0,P1,t) do{int jb_=(t)-(NT-4); if(jb_>=0){int hm_=hi,qm_=qrel; asm volatile("":"+v"(hm_),"+v"(qm_)); cmask(P0,P1,jb_,qm_,hm_);}}while(0)
  bool resc=false;
  #define START(P0,P1) do{ resc=false; \
    _Pragma("unroll") for(int r=0;r<16;++r)P0[r]=__builtin_amdgcn_exp2f(P0[r]); }while(0)
  #define RESC() do{ if(resc){ asm volatile("s_waitcnt lgkmcnt(0)":::"memory"); \
      _Pragma("unroll") for(int d_=0;d_<2;++d_) _Pragma("unroll") for(int r=0;r<16;++r)o[d_][r]*=wsf[crow(r,hi)]; } }while(0)
  f32x16 pA0,pA1,pB0,pB1;
  int sl_prev=0,sl_cur=0,sl_next=SLOTB;
  #define ROT() do{sl_prev=sl_cur;sl_cur=sl_next;sl_next=(sl_next==(NSLOT-1)*SLOTB)?0:sl_next+SLOTB;}while(0)
  DMA_K(2,2*SLOTB);
  WAIT_BAR(3);
  qkt(pA0,pA1,Kbase,qr,zero16,zero16,r32,hi);asm volatile("s_nop 15\n\ts_nop 7":"+v"(pA0),"+v"(pA1));CBIAS(pA0,pA1,0);CMASK(pA0,pA1,0);
  START(pA0,pA1);
  _Pragma("unroll") for(int r=0;r<16;++r)pA1[r]=__builtin_amdgcn_exp2f(pA1[r]);
  WAIT_BAR(0);
  DMA_K(3,0);DMA_V(1,SLOTB);
  ROT();
  kload8(kf,kp0+sl_cur);
  WAIT_BAR(2);
  s16x4 vlo[8],vhi[8]; u32x4 pw0,pw1,pw2,pw3;
  #define PKW(P,B) cvtpk_s(P[B],P[B+1])
  #define PAF(k) __builtin_bit_cast(bf16x8,pw##k)
  #define VFR(i) (bf16x8){vlo[i][0],vlo[i][1],vlo[i][2],vlo[i][3],vhi[i][0],vhi[i][1],vhi[i][2],vhi[i][3]}
  #define PIN(x) asm volatile("":"+v"(x))
  #define MX3(a,b,c) __builtin_fmaxf(__builtin_fmaxf((a),(b)),(c))
  #define GAPA(MF,A0,A1,A2,A3,W0,W1,PW) do{ MF; sacc+=A0; sacc+=A1; sacc+=A2; sacc+=A3; PIN(sacc); W0; W1; PIN(PW); SBAR(); }while(0)
  #define EX(v) __builtin_amdgcn_exp2f(v)
  #define GAPB(MF,X,B) do{ MF; X[B]=EX(X[B]); X[B+1]=EX(X[B+1]); X[B+2]=EX(X[B+2]); X[B+3]=EX(X[B+3]); PIN(X); SBAR(); }while(0)
  #define VRD(i) do{ vlo[i]=vtr(vp_+(((i)>>2)*4096+((i)&3)*1024)); vhi[i]=vtr(vp_+(((i)>>2)*4096+((i)&3)*1024+512)); }while(0)
  #define KRD(G,j) do{ if(G){ kload2(kf,kp0+sl_next,j); SBAR(); } }while(0)
  #define STEP(C0,C1,P0,P1,t,GK,GV,GL) do{ SBAR(); \
    C0=__builtin_amdgcn_mfma_f32_32x32x16_bf16(kx,qx,C0,0,0,0); C1=__builtin_amdgcn_mfma_f32_32x32x16_bf16(kx,qx,C1,0,0,0); SBAR(); \
    const lds_cptr vp_=vp0+sl_prev; \
    VRD(0); SBAR(); float sacc=(P0[0]+P0[1]); \
    GAPA(C0=__builtin_amdgcn_mfma_f32_32x32x16_bf16(kf[0],qr[0],C0,0,0,0), P0[2],P0[3],P0[4],P0[5],     pw0[0]=PKW(P0,0), pw0[1]=PKW(P0,2), pw0); \
    VRD(4); SBAR(); GAPA(C1=__builtin_amdgcn_mfma_f32_32x32x16_bf16(kf[1],qr[0],C1,0,0,0), P0[6],P0[7],P0[8],P0[9],     pw0[2]=PKW(P0,4), pw0[3]=PKW(P0,6), pw0); \
    VRD(1); SBAR(); GAPA(C0=__builtin_amdgcn_mfma_f32_32x32x16_bf16(kf[2],qr[1],C0,0,0,0),   P0[10],P0[11],P0[12],P0[13], pw1[0]=PKW(P0,8), pw1[1]=PKW(P0,10), pw1); \
    VRD(5); SBAR(); GAPA(C1=__builtin_amdgcn_mfma_f32_32x32x16_bf16(kf[3],qr[1],C1,0,0,0),   P0[14],P0[15],P1[0],P1[1],   pw1[2]=PKW(P0,12),pw1[3]=PKW(P0,14), pw1); \
    VRD(2); SBAR(); GAPA(C0=__builtin_amdgcn_mfma_f32_32x32x16_bf16(kf[4],qr[2],C0,0,0,0),   P1[2],P1[3],P1[4],P1[5],     pw2[0]=PKW(P1,0), pw2[1]=PKW(P1,2), pw2); \
    VRD(6); SBAR(); GAPA(C1=__builtin_amdgcn_mfma_f32_32x32x16_bf16(kf[5],qr[2],C1,0,0,0),   P1[6],P1[7],P1[8],P1[9],     pw2[2]=PKW(P1,4), pw2[3]=PKW(P1,6), pw2); \
    VRD(3); SBAR(); GAPA(C0=__builtin_amdgcn_mfma_f32_32x32x16_bf16(kf[6],qr[3],C0,0,0,0),   P1[10],P1[11],P1[12],P1[13], pw3[0]=PKW(P1,8), pw3[1]=PKW(P1,10), pw3); \
    VRD(7); SBAR(); GAPA(C1=__builtin_amdgcn_mfma_f32_32x32x16_bf16(kf[7],qr[3],C1,0,0,0),   P1[14],P1[15],0.f,0.f,       pw3[2]=PKW(P1,12),pw3[3]=PKW(P1,14), pw3); \
    l_reg+=sacc; \
    if(GK){DMA_K((t)+3,sl_cur);} if(GV){DMA_V((t)+1,sl_next);} \
    CMASK(C0,C1,t); \
    { const float rm=__builtin_fmaxf(C0[0],C1[0]); resc=false; \
      if(__builtin_expect(__any(rm>(float)THRL),0)){ const float dl=__builtin_fmaxf(rm,0.f); mhat+=dl; \
        _Pragma("unroll") for(int r=0;r<16;++r){C0[r]-=dl;C1[r]-=dl;} \
        const float f=__builtin_amdgcn_exp2f(-dl); l_reg*=f; if(hi==0)wsf[r32]=f; resc=true; } } \
    SBAR(); \
    if((t)+1<NT){ BLOAD(P0,P1,(t)+1); } \
    GAPB(o[0]=__builtin_amdgcn_mfma_f32_32x32x16_bf16(PAF(0),VFR(0),o[0],0,0,0), C0,0); \
    GAPB(o[1]=__builtin_amdgcn_mfma_f32_32x32x16_bf16(PAF(0),VFR(4),o[1],0,0,0), C0,4); \
    KRD(GL,0); GAPB(o[0]=__builtin_amdgcn_mfma_f32_32x32x16_bf16(PAF(1),VFR(1),o[0],0,0,0), C0,8); \
    KRD(GL,1); GAPB(o[1]=__builtin_amdgcn_mfma_f32_32x32x16_bf16(PAF(1),VFR(5),o[1],0,0,0), C0,12); \
    KRD(GL,2); GAPB(o[0]=__builtin_amdgcn_mfma_f32_32x32x16_bf16(PAF(2),VFR(2),o[0],0,0,0), C1,0); \
    KRD(GL,3); GAPB(o[1]=__builtin_amdgcn_mfma_f32_32x32x16_bf16(PAF(2),VFR(6),o[1],0,0,0), C1,4); \
    GAPB(o[0]=__builtin_amdgcn_mfma_f32_32x32x16_bf16(PAF(3),VFR(3),o[0],0,0,0), C1,8); \
    GAPB(o[1]=__builtin_amdgcn_mfma_f32_32x32x16_bf16(PAF(3),VFR(7),o[1],0,0,0), C1,12); \
    }while(0)
  BLOAD(pB0,pB1,1);
  int t=1;
  #undef CMASK
  #define CMASK(P0,P1,t) do{}while(0)
  for(;t+5<NT;t+=2){
    STEP(pB0,pB1,pA0,pA1,t,true,true,true);     WAIT_BAR(2); RESC(); ROT();
    STEP(pA0,pA1,pB0,pB1,t+1,true,true,true);   WAIT_BAR(2); RESC(); ROT();
  }
  #undef CMASK
  #define CMASK(P0,P1,t) do{int jb_=(t)-(NT-4); if(jb_>=0){int hm_=hi,qm_=qrel; asm volatile("":"+v"(hm_),"+v"(qm_)); cmask(P0,P1,jb_,qm_,hm_);}}while(0)
  #define ENDW(tt) do{ if((tt)+3<NT){WAIT_BAR(2);} else if((tt)+2<NT){WAIT_BAR(1);} else {WAIT_BAR(0);} }while(0)
  for(;t+1<NT;t+=2){
    STEP(pB0,pB1,pA0,pA1,t,(t+3<NT),(t+1<NT),(t+1<NT));       ENDW(t);   RESC(); ROT();
    STEP(pA0,pA1,pB0,pB1,t+1,(t+4<NT),(t+2<NT),(t+2<NT));     ENDW(t+1); RESC(); ROT();
  }
  STEP(pB0,pB1,pA0,pA1,NT-1,false,false,false); RESC();
  { float sacc=pB0[0]+pB0[1]; _Pragma("unroll") for(int r=2;r<16;++r)sacc+=pB0[r]; _Pragma("unroll") for(int r=0;r<16;++r)sacc+=pB1[r]; l_reg+=sacc;
    pw0=(u32x4){PKW(pB0,0),PKW(pB0,2),PKW(pB0,4),PKW(pB0,6)};pw1=(u32x4){PKW(pB0,8),PKW(pB0,10),PKW(pB0,12),PKW(pB0,14)};pw2=(u32x4){PKW(pB1,0),PKW(pB1,2),PKW(pB1,4),PKW(pB1,6)};pw3=(u32x4){PKW(pB1,8),PKW(pB1,10),PKW(pB1,12),PKW(pB1,14)};
    SBAR(); pv(o,vb0+sl_cur,PAF(0),PAF(1),PAF(2),PAF(3)); }
  #undef PKW
  #undef PAF
  #undef VFR
  #undef PIN
  #undef MX3
  #undef GAPA
  #undef GAPB
  #undef EX
  #undef VRD
  #undef KRD
  #undef STEP
  #undef ENDW
  {auto rr=__builtin_amdgcn_permlane32_swap(__float_as_uint(l_reg),__float_as_uint(l_reg),false,false);l_reg=__uint_as_float(rr[0])+__uint_as_float(rr[1]);}
  if(hi==0)wsf[32+r32]=l_reg;asm volatile("s_waitcnt lgkmcnt(0)":::"memory");
  float rli[16];
  #pragma unroll
  for(int r=0;r<16;++r)rli[r]=__builtin_amdgcn_rcpf(wsf[32+crow(r,hi)]);
  bf16*Ow=O+(rowbase+q0+wid*QBLK)*DMO+h*D;
  { bf16*stg=(bf16*)(shm+LDS_OST)+wid*2048;
    #pragma unroll
    for(int r=0;r<16;++r){const int orow=crow(r,hi);
      #pragma unroll
      for(int d0=0;d0<2;++d0)stg[orow*64+d0*32+r32]=__float2bfloat16(o[d0][r]*rli[r]);}
    asm volatile("s_waitcnt lgkmcnt(0)":::"memory");
    int le_=lane; asm volatile("":"+v"(le_));
    #pragma unroll
    for(int i=0;i<4;++i){const int row=i*8+(le_>>3),ch=le_&7; const u32x4 v=*(const u32x4*)(stg+row*64+ch*8); ATTN_STORE16(Ow+(unsigned)(row*DMO+ch*8),v);
      float q_=0.f; _Pragma("unroll") for(int e_=0;e_<4;++e_){const float lo_=__uint_as_float(v[e_]<<16),hi_=__uint_as_float(v[e_]&0xffff0000u); q_+=lo_*lo_+hi_*hi_;}
      q_+=__shfl_xor(q_,1);q_+=__shfl_xor(q_,2);q_+=__shfl_xor(q_,4); if(ch==0)SSA[(rowbase+q0+wid*QBLK+row)*NHEAD+h]=q_; } }
  asm volatile("s_waitcnt lgkmcnt(0)\n\ts_barrier":::"memory");
  #undef DMA_K
  #undef DMA_V
  #undef CMASK
  #undef START
  #undef RESC
  #undef ROT
  #undef CBIAS
  #undef BLOAD
  #undef NMADD
}
constexpr int ATTN_LDS_BYTES=LDS_BYTES;
struct AttnTensors { const bf16* Q; const bf16* K; const bf16* V; bf16* O; const float* G; float* SSA; };
struct AttnUnit { int bh; int qb; };
struct StaticOrder {
  int vcu,G;
  __device__ __forceinline__ explicit StaticOrder(int grid,int block):vcu((grid%8==0)?(block%8)*(grid/8)+block/8:block),G(grid){}
  __device__ __forceinline__ bool next(int i,AttnUnit&u)const{
    if(G==256){ if(i>=4)return false; const int hf=vcu&1; u.bh=vcu>>1; u.qb=(i==0)?7-hf:(i==1)?hf:(i==2)?5-hf:2+hf; return true; }
    const int L=i*G+vcu; if(L>=BATCH*NHEAD*NQB)return false; u.bh=L/NQB; u.qb=NQB-1-(L%NQB); return true; }
  __device__ __forceinline__ void a_ready(const AttnUnit&)const{}
  __device__ __forceinline__ void done(const AttnUnit&)const{}
};
template<class Sched,int THRL=100> __device__ __forceinline__ void attn_phase(char*lds,const AttnTensors&T,const Sched&S){
  AttnUnit u;
  for(int i=0;S.next(i,u);++i){ S.a_ready(u); attn_unit<THRL>(u.bh/NHEAD,u.bh%NHEAD,u.qb,T.Q,T.K,T.V,T.O,T.G,T.SSA,lds); S.done(u); }
}
#undef SBAR
#undef WAIT_BAR
}
constexpr size_t MiB = 1u << 20;
constexpr size_t WS_CTL = 0, CTL_ZERO_BYTES = 128 * 1024;
constexpr size_t WS_WI = 1 * MiB;
constexpr size_t WS_WO = 6 * MiB;
constexpr size_t WS_WQ = 8 * MiB;
constexpr size_t WS_WG = 12 * MiB;
constexpr size_t WS_WP = 14 * MiB;
constexpr size_t WS_SK = 14 * MiB + 512 * 1024;
constexpr size_t WS_RS1 = 15 * MiB;
constexpr size_t WS_RS2 = 15 * MiB + 512 * 1024;
constexpr size_t WS_SS2 = 20 * MiB + 1024 * 1024;
constexpr size_t WS_LF = 16 * MiB;
constexpr size_t WS_G = 17 * MiB;
constexpr size_t WS_SSA = 18 * MiB;
constexpr size_t WS_SS1P = 19 * MiB;
constexpr size_t WS_EU = 22 * MiB;
constexpr size_t WS_EV = 54 * MiB;
constexpr size_t WS_PB = 86 * MiB;
constexpr size_t WS_XB = 102 * MiB;
constexpr size_t WS_QKV = 166 * MiB;
constexpr size_t WS_QP = 102 * MiB;
constexpr size_t WS_PLE = 294 * MiB;
constexpr size_t WS_U = 262 * MiB;
constexpr size_t WS_Y = 294 * MiB;
constexpr size_t WS_H2B = 102 * MiB;
constexpr size_t WS_H1B = 358 * MiB;
constexpr size_t WS_SEL = 422 * MiB;
constexpr size_t WS_GATE = 430 * MiB;
constexpr size_t WS_WACT = 446 * MiB;
constexpr size_t WS_PD = 166 * MiB;
constexpr size_t WS_H1Q = 262 * MiB;
constexpr size_t WS_WH = 462 * MiB;
constexpr size_t WS_END = 470 * MiB;
constexpr int CW_CODE = 2;
constexpr int CW_ATQ = 64;
constexpr int CW_BAR = 4096;
constexpr int CW_XRANK = 16384;

constexpr int RING_OFF = 0, RING_BYTES = 131072;
constexpr int LDSCTL_OFF = RING_BYTES, MISC_OFF = LDSCTL_OFF + 320;
constexpr int SCAN_OFF = LDSCTL_OFF + 1024;
constexpr int RSA_OFF = LDSCTL_OFF + 2048;
constexpr int LDS_BYTES = 147456;

#define GAS __attribute__((address_space(1)))
#define LAS __attribute__((address_space(3)))
typedef unsigned short bf16;
typedef unsigned v4u __attribute__((ext_vector_type(4)));
typedef float f32x4 __attribute__((ext_vector_type(4)));
typedef short bf16x8 __attribute__((ext_vector_type(8)));
typedef GAS unsigned gu32;
typedef GAS unsigned long long gu64;
#define RLX_AGENT __ATOMIC_RELAXED, __HIP_MEMORY_SCOPE_AGENT
#define LDS_WAIT() asm volatile("s_waitcnt lgkmcnt(0)" ::: "memory")
#define VM_WAIT() asm volatile("s_waitcnt vmcnt(0)" ::: "memory")
__device__ __forceinline__ unsigned long long rt() { return __builtin_amdgcn_s_memrealtime(); }
__device__ __forceinline__ unsigned f2bf(float f) { unsigned u = __builtin_bit_cast(unsigned, f); return (u + 0x7fffu + ((u >> 16) & 1u)) >> 16; }
typedef float pk2_f32x2 __attribute__((ext_vector_type(2))); typedef __bf16 pk2_bf16x2 __attribute__((ext_vector_type(2)));
__device__ __forceinline__ unsigned pk2(float lo, float hi) { const pk2_f32x2 v = {lo, hi}; const pk2_bf16x2 q = __builtin_convertvector(v, pk2_bf16x2); return __builtin_bit_cast(unsigned, q); }

#define XB_TMO      128
#define XB_XCNT(j)  (256  + 64 * (j))
#define XB_XSUB(j)  (1280 + 64 * (j))
#define XB_XGEN(j)  (2304 + 64 * (j))
#define XB_TOP      3328
#define XB_TOPGEN   3392
#define XCD_BAR_WORDS 3456
#define XB_SPIN_CAP (1u << 18)

__device__ __forceinline__ unsigned xb_ld(unsigned* p)              { return __hip_atomic_load(p, __ATOMIC_RELAXED, __HIP_MEMORY_SCOPE_AGENT); }
__device__ __forceinline__ unsigned xb_add(unsigned* p, unsigned v) { return __hip_atomic_fetch_add(p, v, __ATOMIC_RELAXED, __HIP_MEMORY_SCOPE_AGENT); }
__device__ __forceinline__ unsigned xb_xcc_id() { return (unsigned)__builtin_amdgcn_s_getreg((3 << 11) | 20) & 0xFu; }
#define XB_SPIN(cond, bar) do { unsigned _sp = 0; while (cond) { __builtin_amdgcn_s_sleep(1); \
    if ((++_sp & 255u) == 0u) { if (xb_ld(&(bar)[XB_TMO])) break; if (_sp > XB_SPIN_CAP) { atomicAdd(&(bar)[XB_TMO], 1u); break; } } } } while (0)

struct XcdBarrier {
    unsigned* bar; unsigned x;
    volatile LAS unsigned* st;
};

__device__ __forceinline__ XcdBarrier xcd_barrier_post(unsigned* bar, volatile LAS unsigned* st) {
    XcdBarrier b; b.bar = bar; b.x = xb_xcc_id(); b.st = st;
    if (threadIdx.x == 0) (void)xb_add(&bar[XB_XCNT(b.x)], 1u);
    return b;
}
__device__ __forceinline__ void xcd_barrier_complete(unsigned* bar, unsigned x, unsigned& nloc, unsigned& nx) {
    const unsigned G = gridDim.x * gridDim.y * gridDim.z;
    unsigned sum, cnt, mine, sp = 0u;
    for (;;) {
        sum = 0u; cnt = 0u; mine = 0u;
#pragma unroll
        for (unsigned j = 0; j < 16; ++j) { const unsigned c = xb_ld(&bar[XB_XCNT(j)]); sum += c; cnt += (c > 0u) ? 1u : 0u; mine = (j == x) ? c : mine; }
        if (sum == G) break;
        __builtin_amdgcn_s_sleep(1);
        if ((++sp & 255u) == 0u) { if (xb_ld(&bar[XB_TMO])) break; if (sp > XB_SPIN_CAP) { atomicAdd(&bar[XB_TMO], 1u); break; } }
    }
    nloc = mine > 0u ? mine : 1u; nx = cnt > 0u ? cnt : 1u;
}

__device__ __forceinline__ void xcd_barrier(const XcdBarrier& b) {
    asm volatile("s_waitcnt vmcnt(0)" ::: "memory");
    __syncthreads();
    if (threadIdx.x == 0) {
        unsigned* bar = b.bar;
        __builtin_amdgcn_s_waitcnt(0);
        unsigned nloc = b.st[0], nx = b.st[1];
        if (nloc == 0u) { xcd_barrier_complete(bar, b.x, nloc, nx); b.st[0] = nloc; b.st[1] = nx; }
        const unsigned old = xb_add(&bar[XB_XSUB(b.x)], 1u);
        const unsigned gen = old / nloc;
        if (old + 1u == (gen + 1u) * nloc) {
            __builtin_amdgcn_fence(__ATOMIC_RELEASE, "agent");
            asm volatile("s_waitcnt vmcnt(0)" ::: "memory");
            const unsigned og = xb_add(&bar[XB_TOP], 1u);
            const unsigned tg = og / nx;
            if (og + 1u == (tg + 1u) * nx) xb_add(&bar[XB_TOPGEN], 1u);
            else XB_SPIN(xb_ld(&bar[XB_TOPGEN]) == tg, bar);
            __builtin_amdgcn_fence(__ATOMIC_ACQUIRE, "agent");
            xb_add(&bar[XB_XGEN(b.x)], 1u);
            asm volatile("s_waitcnt vmcnt(0)" ::: "memory");
        } else {
            XB_SPIN(xb_ld(&bar[XB_XGEN(b.x)]) == gen, bar);
            __builtin_amdgcn_fence(__ATOMIC_ACQUIRE, "agent");
            asm volatile("s_waitcnt vmcnt(0)" ::: "memory");
        }
    }
    __syncthreads();
}

__device__ __forceinline__ void xcd_barrier_arrive(const XcdBarrier& b) {
    asm volatile("s_waitcnt vmcnt(0)" ::: "memory");
    __syncthreads();
    if (threadIdx.x == 0) {
        unsigned* bar = b.bar;
        __builtin_amdgcn_s_waitcnt(0);
        unsigned nloc = b.st[0], nx = b.st[1];
        if (nloc == 0u) { xcd_barrier_complete(bar, b.x, nloc, nx); b.st[0] = nloc; b.st[1] = nx; }
        const unsigned old = xb_add(&bar[XB_XSUB(b.x)], 1u);
        const unsigned gen = old / nloc;
        unsigned role = 0u, tg = 0u;
        if (old + 1u == (gen + 1u) * nloc) {
            __builtin_amdgcn_fence(__ATOMIC_RELEASE, "agent");
            asm volatile("s_waitcnt vmcnt(0)" ::: "memory");
            const unsigned og = xb_add(&bar[XB_TOP], 1u);
            tg = og / nx; role = (og + 1u == (tg + 1u) * nx) ? 2u : 1u;
            if (role == 2u) xb_add(&bar[XB_TOPGEN], 1u);
        }
        b.st[2] = role; b.st[3] = gen; b.st[4] = tg;
    }
}
__device__ __forceinline__ void xcd_barrier_wait(const XcdBarrier& b) {
    if (threadIdx.x == 0) {
        unsigned* bar = b.bar;
        const unsigned role = b.st[2], gen = b.st[3], tg = b.st[4];
        if (role != 0u) {
            if (role == 1u) XB_SPIN(xb_ld(&bar[XB_TOPGEN]) == tg, bar);
            __builtin_amdgcn_fence(__ATOMIC_ACQUIRE, "agent");
            xb_add(&bar[XB_XGEN(b.x)], 1u);
            asm volatile("s_waitcnt vmcnt(0)" ::: "memory");
        } else {
            XB_SPIN(xb_ld(&bar[XB_XGEN(b.x)]) == gen, bar);
            __builtin_amdgcn_fence(__ATOMIC_ACQUIRE, "agent");
            asm volatile("s_waitcnt vmcnt(0)" ::: "memory");
        }
    }
    __syncthreads();
}

constexpr int NWAVES = 8;
struct Frame {
    LAS unsigned char* lds;
    volatile LAS unsigned* MISC;
    gu32* ctl;
    int tid, lane, wave;
    int vcu, G;
    unsigned char* ws;
    const float* in[23];
    float* out;
};
enum { I_X = 0, I_P, I_LN_MIX, I_W_IN, I_B_FGATE, I_Q_NORM, I_K_NORM, I_CONV_W, I_CONV_B, I_CONV_LN_G, I_CONV_LN_B, I_ATTN_OUT_NORM, I_CONV_OUT_NORM, I_W_OUT,
       I_LN_FFN, I_W_PEER_Q, I_SUB_KEYS1, I_SUB_KEYS2, I_EXPERT_U, I_EXPERT_V, I_LN_PL, I_W_PL_GATE, I_W_PL_PROJ };

#define PHASE_IDS(F) do { int t_ = threadIdx.x; asm volatile("" : "+v"(t_)); F.tid = t_; F.lane = t_ & 63; F.wave = __builtin_amdgcn_readfirstlane(t_ >> 6); } while (0)
__device__ __forceinline__ float wave_sum(float v) {
    v += __builtin_bit_cast(float, __builtin_amdgcn_update_dpp(0, __builtin_bit_cast(int, v), 0xB1, 0xf, 0xf, true));
    v += __builtin_bit_cast(float, __builtin_amdgcn_update_dpp(0, __builtin_bit_cast(int, v), 0x4E, 0xf, 0xf, true));
    v += __builtin_bit_cast(float, __builtin_amdgcn_update_dpp(0, __builtin_bit_cast(int, v), 0x141, 0xf, 0xf, true));
    v += __builtin_bit_cast(float, __builtin_amdgcn_update_dpp(0, __builtin_bit_cast(int, v), 0x140, 0xf, 0xf, true));
    const int b = __builtin_bit_cast(int, v);
    const float s0 = __builtin_bit_cast(float, __builtin_amdgcn_readlane(b, 0)), s1 = __builtin_bit_cast(float, __builtin_amdgcn_readlane(b, 16));
    const float s2 = __builtin_bit_cast(float, __builtin_amdgcn_readlane(b, 32)), s3 = __builtin_bit_cast(float, __builtin_amdgcn_readlane(b, 48));
    return (s0 + s1) + (s2 + s3);
}
__device__ __forceinline__ float fast_sigmoid(float v) { return __builtin_amdgcn_rcpf(1.0f + __builtin_amdgcn_exp2f(-v * LOG2E)); }

__device__ __forceinline__ void p0_transpose_item(const float* W, int Nsrc, int K, int col0, const float* gain, bf16* WT, int n0, int k0, LAS float* scr, int lane) {
    float wv_[32];
#pragma unroll
    for (int i = 0; i < 32; ++i) wv_[i] = W[(size_t)(k0 + 2 * i + (lane >> 5)) * Nsrc + col0 + (lane & 31)];
#pragma unroll
    for (int i = 0; i < 32; ++i) { const int kk = 2 * i + (lane >> 5); const float g = gain ? gain[kk] : 1.0f; scr[kk * 33 + (lane & 31)] = wv_[i] * g; }
    LDS_WAIT(); asm volatile("" ::: "memory");
    const int c = lane & 7;
#pragma unroll
    for (int j = 0; j < 4; ++j) { const int n = (lane >> 3) + 8 * j; const LAS float* s = scr + (8 * c) * 33 + n;
        v4u o; o.x = pk2(s[0 * 33], s[1 * 33]); o.y = pk2(s[2 * 33], s[3 * 33]); o.z = pk2(s[4 * 33], s[5 * 33]); o.w = pk2(s[6 * 33], s[7 * 33]);
        *(GAS v4u*)(WT + (size_t)(n0 + n) * K + k0 + 8 * c) = o; }
    LDS_WAIT(); asm volatile("" ::: "memory");
}
__device__ __forceinline__ int inproj_src_col(int nb) {
    const int p0 = 32 * nb, pn = p0 >> 8, cp = p0 & 255;
    if (pn < 6) { const int bj = cp >> 7, wc = (cp >> 5) & 3; return 256 * pn + 64 * wc + 32 * bj; }
    const int pg = pn - 6; return cp < 128 ? COL_A + 128 * pg + cp : COL_G + 128 * pg + (cp - 128);
}
constexpr float U_QSCALE = 96.0f, H_QSCALE = 14.0f;
#if U_DOT8
__device__ __forceinline__ unsigned q4(float v) { return (unsigned)((int)__builtin_rintf(__builtin_amdgcn_fmed3f(v, -7.0f, 7.0f))) & 15u; }
#else
__device__ __forceinline__ unsigned q4(float v) { return (unsigned)((int)__builtin_rintf(__builtin_amdgcn_fmed3f(v, -7.0f, 7.0f)) + 8); }
#endif
__device__ __forceinline__ v4u cvt8(const f32x4 a, const f32x4 b) { v4u o; o.x = pk2(a.x, a.y); o.y = pk2(a.z, a.w); o.z = pk2(b.x, b.y); o.w = pk2(b.z, b.w); return o; }

template <bool DO_U, bool DO_V> __device__ __forceinline__ void p0_convert_experts(Frame& F) {
    const int gw = F.vcu * NWAVES + F.wave, NGW = F.G * NWAVES;
    const float* eu = F.in[I_EXPERT_U]; const float* ev = F.in[I_EXPERT_V]; const float* lnf = F.in[I_LN_FFN];
    unsigned char* EU4 = F.ws + WS_EU; unsigned char* EV4 = F.ws + WS_EV;
    f32x4 ls[4];
#pragma unroll
    for (int s = 0; s < 4; ++s) ls[s] = *(const f32x4*)(lnf + 256 * s + 4 * F.lane) * U_QSCALE;
#pragma unroll 1
    for (int e0 = 2 * gw; e0 < NEXP; e0 += 2 * NGW) {
        f32x4 a[2][4], b[2][4];
#pragma unroll
        for (int r = 0; r < 2; ++r)
#pragma unroll
            for (int s = 0; s < 4; ++s) { const size_t off = (size_t)(e0 + r) * DMODEL + 256 * s + 4 * F.lane; if constexpr (DO_U) a[r][s] = *(const GAS f32x4*)(eu + off); if constexpr (DO_V) b[r][s] = *(const GAS f32x4*)(ev + off); }
#pragma unroll
        for (int r = 0; r < 2; ++r)
#pragma unroll
            for (int s = 0; s < 4; ++s) { const size_t dst = (size_t)s * ((size_t)NEXP * 128) + (size_t)(e0 + r) * 128 + 2 * F.lane;
                if constexpr (DO_U) { const f32x4 t = a[r][s] * ls[s];
                    const unsigned pu = q4(t.x) | (q4(t.y) << 4) | (q4(t.z) << 8) | (q4(t.w) << 12);
                    *(GAS unsigned short*)(EU4 + dst) = (unsigned short)pu; }
                if constexpr (DO_V) { const f32x4 w = b[r][s] * 6.0f;
                    unsigned pv = 0u; pv = __builtin_amdgcn_cvt_scalef32_pk_fp4_f32(pv, w.x, w.y, 1.0f, 0); pv = __builtin_amdgcn_cvt_scalef32_pk_fp4_f32(pv, w.z, w.w, 1.0f, 1);
                    *(GAS unsigned short*)(EV4 + dst) = (unsigned short)(pv & 0xffffu); } }
    }
}
template <bool IS_V> __device__ __forceinline__ void convert_expert_rows(Frame& F, int rb, int re) {
    int tid_ = threadIdx.x; asm volatile("" : "+v"(tid_));
    const int lane = tid_ & 63, wave = __builtin_amdgcn_readfirstlane(tid_ >> 6);
    const int gw = F.vcu * NWAVES + wave, NGW = F.G * NWAVES;
    const float* src = IS_V ? F.in[I_EXPERT_V] : F.in[I_EXPERT_U]; const float* lnf = F.in[I_LN_FFN];
    unsigned char* dstb = F.ws + (IS_V ? WS_EV : WS_EU);
#pragma unroll 1
    for (int e0 = rb + 4 * gw; e0 < re; e0 += 4 * NGW) {
        f32x4 a[4][4];
#pragma unroll
        for (int r = 0; r < 4; ++r)
#pragma unroll
            for (int s = 0; s < 4; ++s) a[r][s] = *(const GAS f32x4*)(src + (size_t)(e0 + r) * DMODEL + 256 * s + 4 * lane);
        f32x4 ls[4];
#pragma unroll
        for (int s = 0; s < 4; ++s) ls[s] = IS_V ? (f32x4){6.0f, 6.0f, 6.0f, 6.0f} : *(const f32x4*)(lnf + 256 * s + 4 * lane) * U_QSCALE;
#pragma unroll
        for (int r = 0; r < 4; ++r)
#pragma unroll
            for (int s = 0; s < 4; ++s) { const size_t dst = (size_t)s * ((size_t)NEXP * 128) + (size_t)(e0 + r) * 128 + 2 * lane; const f32x4 t = a[r][s] * ls[s];
                unsigned pk;
                if constexpr (IS_V) { pk = 0u; pk = __builtin_amdgcn_cvt_scalef32_pk_fp4_f32(pk, t.x, t.y, 1.0f, 0); pk = __builtin_amdgcn_cvt_scalef32_pk_fp4_f32(pk, t.z, t.w, 1.0f, 1); }
                else pk = q4(t.x) | (q4(t.y) << 4) | (q4(t.z) << 8) | (q4(t.w) << 12);
                *(GAS unsigned short*)(dstb + dst) = (unsigned short)(pk & 0xffffu); }
    }
}

template <int PART> __device__ __forceinline__ void p0_prologue(Frame& F) {
    PHASE_IDS(F);
    LAS float* scr = (LAS float*)(F.lds + RING_OFF + F.wave * 16384);
    const int gw = F.vcu * NWAVES + F.wave, NGW = F.G * NWAVES;
    bf16* WI = (bf16*)(F.ws + WS_WI); bf16* WO = (bf16*)(F.ws + WS_WO); bf16* WQ = (bf16*)(F.ws + WS_WQ); bf16* WG = (bf16*)(F.ws + WS_WG); bf16* WP = (bf16*)(F.ws + WS_WP);
    auto part_a = [&]() __attribute__((always_inline)) {
    constexpr int I_IN = 16 * 80, I_OUT = 16 * 32, I_PQ = 16 * 64, I_GT = 16 * 32, I_PJ = 4 * 32, NITEMS = I_IN + I_OUT + I_PQ + I_GT + I_PJ;
    for (int it = (PART == 0 ? gw : I_IN + gw); it < (PART == 0 ? I_IN : NITEMS); it += NGW) {
        int r = it;
        if (r < I_IN) { const int kb = r / 80, nb = r % 80; p0_transpose_item(F.in[I_W_IN], NIN, DMODEL, inproj_src_col(nb), F.in[I_LN_MIX] + 64 * kb, WI, 32 * nb, 64 * kb, scr, F.lane); continue; } r -= I_IN;
        if (r < I_OUT) { const int kb = r / 32, nb = r % 32; const float* g = kb < 8 ? F.in[I_ATTN_OUT_NORM] + 64 * kb : F.in[I_CONV_OUT_NORM] + 64 * (kb - 8);
            p0_transpose_item(F.in[I_W_OUT], DMODEL, DMODEL, 32 * nb, g, WO, 32 * nb, 64 * kb, scr, F.lane); continue; } r -= I_OUT;
        if (r < I_PQ) { const int kb = r / 64, nb = r % 64; p0_transpose_item(F.in[I_W_PEER_Q], PH * PQ, DMODEL, 32 * nb, F.in[I_LN_FFN] + 64 * kb, WQ, 32 * nb, 64 * kb, scr, F.lane); continue; } r -= I_PQ;
        if (r < I_GT) { const int kb = r / 32, nb = r % 32; p0_transpose_item(F.in[I_W_PL_GATE], DMODEL, DMODEL, 32 * nb, F.in[I_LN_PL] + 64 * kb, WG, 32 * nb, 64 * kb, scr, F.lane); continue; } r -= I_GT;
        { const int kb = r / 32, nb = r % 32; p0_transpose_item(F.in[I_W_PL_PROJ], DMODEL, DPLE, 32 * nb, nullptr, WP, 32 * nb, 64 * kb, scr, F.lane); }
    }
    };
    auto part_b = [&]() __attribute__((always_inline)) {
    {
        float wf[4][4][8];
        const float* w_in = F.in[I_W_IN]; const float* lnm = F.in[I_LN_MIX];
#pragma unroll
        for (int j = 0; j < 4; ++j)
#pragma unroll
            for (int e = 0; e < 4; ++e) { const int k = 4 * F.lane + 256 * j + e; const float g = lnm[k];
                const f32x4 a = *(const f32x4*)(w_in + (size_t)k * NIN + COL_F), b = *(const f32x4*)(w_in + (size_t)k * NIN + COL_F + 4);
                wf[j][e][0] = a.x * g; wf[j][e][1] = a.y * g; wf[j][e][2] = a.z * g; wf[j][e][3] = a.w * g; wf[j][e][4] = b.x * g; wf[j][e][5] = b.y * g; wf[j][e][6] = b.z * g; wf[j][e][7] = b.w * g; }
        const float* x = F.in[I_X]; bf16* XB = (bf16*)(F.ws + WS_XB); float* RS1 = (float*)(F.ws + WS_RS1); float* LF = (float*)(F.ws + WS_LF);
        const float bfh = F.in[I_B_FGATE][F.lane & 7];
        f32x4 v[4], vn[4], vnn[4];
        if (gw < T) { const GAS f32x4* xr = (const GAS f32x4*)(x + (size_t)gw * DMODEL) + F.lane;
            const GAS f32x4* xr2 = (const GAS f32x4*)(x + (size_t)(gw + NGW < T ? gw + NGW : gw) * DMODEL) + F.lane;
#pragma unroll
            for (int j = 0; j < 4; ++j) v[j] = xr[64 * j];
#pragma unroll
            for (int j = 0; j < 4; ++j) vn[j] = xr2[64 * j]; }
#pragma unroll 1
        for (int m = gw; m < T; m += NGW) {
            { const int mn = m + 2 * NGW < T ? m + 2 * NGW : m; const GAS f32x4* xr = (const GAS f32x4*)(x + (size_t)mn * DMODEL) + F.lane;
#pragma unroll
              for (int j = 0; j < 4; ++j) vnn[j] = xr[64 * j]; }
            float s = 0.f; float d[8];
#pragma unroll
            for (int h = 0; h < 8; ++h) d[h] = 0.f;
#pragma unroll
            for (int j = 0; j < 4; ++j) { s += (v[j].x * v[j].x + v[j].y * v[j].y) + (v[j].z * v[j].z + v[j].w * v[j].w);
#pragma unroll
                for (int h = 0; h < 8; ++h) d[h] += (v[j].x * wf[j][0][h] + v[j].y * wf[j][1][h]) + (v[j].z * wf[j][2][h] + v[j].w * wf[j][3][h]); }
            const float rs = __builtin_amdgcn_rsqf(wave_sum(s) * (1.0f / DMODEL) + EPS);
            float mine = 0.f;
#pragma unroll
            for (int h = 0; h < 8; ++h) { const float t = wave_sum(d[h]); mine = ((F.lane & 7) == h) ? t : mine; }
            GAS unsigned long long* o8 = (GAS unsigned long long*)(XB + (size_t)m * DMODEL) + F.lane;
#pragma unroll
            for (int j = 0; j < 4; ++j) o8[64 * j] = (unsigned long long)pk2(v[j].x, v[j].y) | ((unsigned long long)pk2(v[j].z, v[j].w) << 32);
            if (F.lane == 0) RS1[m] = rs;
            if (F.lane < 8) { const float z = mine * rs + bfh;
                LF[(size_t)m * 8 + F.lane] = fminf(z, 0.f) * LOG2E - __builtin_amdgcn_logf(1.0f + __builtin_amdgcn_exp2f(-fabsf(z) * LOG2E)); }
#pragma unroll
            for (int j = 0; j < 4; ++j) { v[j] = vn[j]; vn[j] = vnn[j]; }
        }
    }
    };
    auto part_c = [&]() __attribute__((always_inline)) {
    {
        const size_t gt = (size_t)F.vcu * (NWAVES * 64) + F.tid, NGT = (size_t)F.G * NWAVES * 64;
        const float* p = F.in[I_P]; bf16* PB = (bf16*)(F.ws + WS_PB);
        if constexpr (PART == 2 || !P_LATE)
        for (size_t c0 = gt; c0 < (size_t)T * DPLE / 8; c0 += 4 * NGT) {
            f32x4 pa[4][2];
#pragma unroll
            for (int k = 0; k < 4; ++k) { const size_t c = c0 + k * NGT < (size_t)T * DPLE / 8 ? c0 + k * NGT : c0; const GAS f32x4* s = (const GAS f32x4*)(p + c * 8); pa[k][0] = s[0]; pa[k][1] = s[1]; }
#pragma unroll
            for (int k = 0; k < 4; ++k) { const size_t c = c0 + k * NGT; if (c < (size_t)T * DPLE / 8) *(GAS v4u*)(PB + c * 8) = cvt8(pa[k][0], pa[k][1]); }
        }
#if CONV_SPLIT == 3
        p0_convert_experts<true, true>(F);
#endif
        bf16* SK = (bf16*)(F.ws + WS_SK);
        if constexpr (PART != 2)
        for (size_t c = gt; c < (size_t)2 * NKEY * PHALF / 8; c += NGT) {
            const float* src = c < (size_t)NKEY * PHALF / 8 ? F.in[I_SUB_KEYS1] + c * 8 : F.in[I_SUB_KEYS2] + (c - NKEY * PHALF / 8) * 8;
            const GAS f32x4* s = (const GAS f32x4*)src; *(GAS v4u*)(SK + c * 8) = cvt8(s[0], s[1]);
        }
    }
    };
    if constexpr (PART == 0) { part_a(); part_b(); } else if constexpr (PART == 1) { part_a(); part_c(); } else part_c();
}

__device__ __forceinline__ void p1_scan(Frame& F) {
    PHASE_IDS(F);
    const float* LF = (const float*)(F.ws + WS_LF); float* Gc = (float*)(F.ws + WS_G);
    LAS float* wt = (LAS float*)(F.lds + SCAN_OFF);
    for (int bh = blockIdx.x; bh < BATCH * NH; bh += F.G) {
        const int b = bh >> 3, h = bh & 7;
        float v[4];
#pragma unroll
        for (int j = 0; j < 4; ++j) v[j] = LF[((size_t)b * SEQ + 4 * F.tid + j) * 8 + h];
        v[1] += v[0]; v[2] += v[1]; v[3] += v[2];
        float incl = v[3];
#pragma unroll
        for (int o = 1; o < 64; o <<= 1) { const float t = __shfl_up(incl, o); if (F.lane >= o) incl += t; }
        if (F.lane == 63) wt[F.wave] = incl;
        __syncthreads();
        float base = incl - v[3];
        for (int w = 0; w < F.wave; ++w) base += wt[w];
        f32x4 o; o.x = base + v[0]; o.y = base + v[1]; o.z = base + v[2]; o.w = base + v[3];
        *(GAS f32x4*)(Gc + (size_t)bh * SEQ + 4 * F.tid) = o;
        __syncthreads();
    }
}

constexpr int CONV_TOK = 64, CONV_UW = 0, CONV_CWL = (CONV_TOK + 30) * 1024, CONV_LDS = CONV_CWL + CW * 1024;
static_assert(CONV_LDS <= RING_BYTES, "conv LDS");
__device__ __forceinline__ v4u cvt8h(const f32x4 a, const f32x4 b) { v4u o; o.x = __builtin_bit_cast(unsigned, __builtin_amdgcn_cvt_pkrtz(a.x, a.y)); o.y = __builtin_bit_cast(unsigned, __builtin_amdgcn_cvt_pkrtz(a.z, a.w));
    o.z = __builtin_bit_cast(unsigned, __builtin_amdgcn_cvt_pkrtz(b.x, b.y)); o.w = __builtin_bit_cast(unsigned, __builtin_amdgcn_cvt_pkrtz(b.z, b.w)); return o; }
__device__ __forceinline__ unsigned bf2_to_h2(unsigned w) { return __builtin_bit_cast(unsigned, __builtin_amdgcn_cvt_pkrtz(__uint_as_float(w << 16), __uint_as_float(w & 0xffff0000u))); }
__device__ __forceinline__ v4u bf8_to_h8(const v4u w) { v4u o; o.x = bf2_to_h2(w.x); o.y = bf2_to_h2(w.y); o.z = bf2_to_h2(w.z); o.w = bf2_to_h2(w.w); return o; }
__device__ __forceinline__ void unpack8(const v4u w, float (&f)[8]) {
    f[0] = __uint_as_float(w.x << 16); f[1] = __uint_as_float(w.x & 0xffff0000u); f[2] = __uint_as_float(w.y << 16); f[3] = __uint_as_float(w.y & 0xffff0000u);
    f[4] = __uint_as_float(w.z << 16); f[5] = __uint_as_float(w.z & 0xffff0000u); f[6] = __uint_as_float(w.w << 16); f[7] = __uint_as_float(w.w & 0xffff0000u);
}
__device__ __forceinline__ void p2_conv_stage(Frame& F) {
    PHASE_IDS(F);
    LAS unsigned char* cwl = F.lds + RING_OFF + CONV_CWL;
    { const float* cw = F.in[I_CONV_W];
      f32x4 ca_[4][2];
#pragma unroll
      for (int k = 0; k < 4; ++k) { const int i = F.tid + k * NWAVES * 64; const GAS f32x4* s = (const GAS f32x4*)(cw + (i < CW * DCONV / 8 ? i : 0) * 8); ca_[k][0] = s[0]; ca_[k][1] = s[1]; }
#pragma unroll
      for (int k = 0; k < 4; ++k) { const int i = F.tid + k * NWAVES * 64; if (i < CW * DCONV / 8) *(LAS v4u*)(cwl + i * 16) = cvt8h(ca_[k][0], ca_[k][1]); } }
    LDS_WAIT();
}
__device__ __forceinline__ void p2_conv(Frame& F, bool stage) {
    PHASE_IDS(F);
    const bf16* U = (const bf16*)(F.ws + WS_U); bf16* Y = (bf16*)(F.ws + WS_Y);
    LAS unsigned char* uw = F.lds + RING_OFF + CONV_UW; LAS unsigned char* cwl = F.lds + RING_OFF + CONV_CWL;
    if (stage) { const float* cw = F.in[I_CONV_W];
      f32x4 ca_[4][2];
#pragma unroll
      for (int k = 0; k < 4; ++k) { const int i = F.tid + k * NWAVES * 64; const GAS f32x4* s = (const GAS f32x4*)(cw + (i < CW * DCONV / 8 ? i : 0) * 8); ca_[k][0] = s[0]; ca_[k][1] = s[1]; }
#pragma unroll
      for (int k = 0; k < 4; ++k) { const int i = F.tid + k * NWAVES * 64; if (i < CW * DCONV / 8) *(LAS v4u*)(cwl + i * 16) = cvt8h(ca_[k][0], ca_[k][1]); } }
    float cb[8], lg[8], lb[8];
    { const int c0 = 8 * F.lane;
#pragma unroll
      for (int e = 0; e < 8; ++e) { cb[e] = F.in[I_CONV_B][c0 + e]; lg[e] = F.in[I_CONV_LN_G][c0 + e]; lb[e] = F.in[I_CONV_LN_B][c0 + e]; } }
    const int NUNIT = T / CONV_TOK;
    for (int un = F.vcu; un < NUNIT; un += F.G) {
        const int b = un / (SEQ / CONV_TOK), s0 = (un % (SEQ / CONV_TOK)) * CONV_TOK;
        __syncthreads();
        { constexpr int NCH = ((CONV_TOK + 30) * 64 + NWAVES * 64 - 1) / (NWAVES * 64); v4u wv_[NCH];
#pragma unroll
          for (int k = 0; k < NCH; ++k) { const int i = F.tid + k * NWAVES * 64, r = i >> 6, ch = i & 63, s = s0 - 30 + r;
              wv_[k] = (v4u){0u, 0u, 0u, 0u}; if (i < (CONV_TOK + 30) * 64 && s >= 0) wv_[k] = *(const GAS v4u*)(U + ((size_t)b * SEQ + s) * DCONV + ch * 8); }
#pragma unroll
          for (int k = 0; k < NCH; ++k) { const int i = F.tid + k * NWAVES * 64, r = i >> 6, ch = i & 63; if (i < (CONV_TOK + 30) * 64) *(LAS v4u*)(uw + r * 1024 + ch * 16) = bf8_to_h8(wv_[k]); } }
        __syncthreads();
#pragma unroll 1
        for (int grp = 0; grp < 2; ++grp) {
            const int sb = 8 * F.wave + 4 * grp;
            typedef _Float16 h2c __attribute__((ext_vector_type(2)));
            h2c hacc[4][4];
#pragma unroll
            for (int q = 0; q < 4; ++q)
#pragma unroll
                for (int e = 0; e < 4; ++e) hacc[q][e] = (h2c){(_Float16)0.f, (_Float16)0.f};
            h2c wv[4][4];
            const LAS unsigned char* up = uw + sb * 1024 + F.lane * 16; const LAS unsigned char* wp = cwl + F.lane * 16;
#define LD_H8(D, P) do { const v4u t_ = *(const LAS v4u*)(P); const unsigned t0_ = t_.x, t1_ = t_.y, t2_ = t_.z, t3_ = t_.w; \
                D[0] = __builtin_bit_cast(h2c, t0_); D[1] = __builtin_bit_cast(h2c, t1_); D[2] = __builtin_bit_cast(h2c, t2_); D[3] = __builtin_bit_cast(h2c, t3_); } while (0)
#define CONV_ROW(RHO, RI) do { h2c ur[4]; LD_H8(ur, up + (RHO) * 1024); \
                if ((RI) < CW) LD_H8(wv[(RI) & 3], wp + (RHO) * 1024); \
                _Pragma("unroll") for (int q = 0; q < 4; ++q) { const int j = (RI) - q; if (j >= 0 && j < CW) { \
                    _Pragma("unroll") for (int e = 0; e < 4; ++e) hacc[q][e] += wv[j & 3][e] * ur[e]; } } \
                __builtin_amdgcn_sched_barrier(0); } while (0)
            CONV_ROW(0, 0); CONV_ROW(1, 1); CONV_ROW(2, 2); CONV_ROW(3, 3);
#pragma unroll 1
            for (int r4 = 4; r4 < 28; r4 += 4) { CONV_ROW(r4, 4); CONV_ROW(r4 + 1, 5); CONV_ROW(r4 + 2, 6); CONV_ROW(r4 + 3, 7); }
            CONV_ROW(28, 28); CONV_ROW(29, 29); CONV_ROW(30, 30); CONV_ROW(31, 31); CONV_ROW(32, 32); CONV_ROW(33, 33);
#undef CONV_ROW
#undef LD_H8
            float acc[4][8];
#pragma unroll
            for (int q = 0; q < 4; ++q)
#pragma unroll
                for (int e = 0; e < 4; ++e) { acc[q][2 * e] = (float)hacc[q][e].x + cb[2 * e]; acc[q][2 * e + 1] = (float)hacc[q][e].y + cb[2 * e + 1]; }
#pragma unroll
            for (int q = 0; q < 4; ++q) {
                float s = 0.f;
#pragma unroll
                for (int e = 0; e < 8; ++e) s += acc[q][e];
                const float mu = wave_sum(s) * (1.0f / DCONV); float s2 = 0.f;
#pragma unroll
                for (int e = 0; e < 8; ++e) { acc[q][e] -= mu; s2 += acc[q][e] * acc[q][e]; }
                const float rstd = __builtin_amdgcn_rsqf(wave_sum(s2) * (1.0f / DCONV) + LN_EPS); float s3 = 0.f;
#pragma unroll
                for (int e = 0; e < 8; ++e) { const float y = acc[q][e] * rstd * lg[e] + lb[e]; const float sw = y * fast_sigmoid(y); acc[q][e] = sw; s3 += sw * sw; }
                const float rr = __builtin_amdgcn_rsqf(wave_sum(s3) * (1.0f / DCONV) + EPS);
                v4u o; o.x = pk2(acc[q][0] * rr, acc[q][1] * rr); o.y = pk2(acc[q][2] * rr, acc[q][3] * rr); o.z = pk2(acc[q][4] * rr, acc[q][5] * rr); o.w = pk2(acc[q][6] * rr, acc[q][7] * rr);
                *(GAS v4u*)(Y + ((size_t)b * SEQ + s0 + sb + q) * DMODEL + DATT + 8 * F.lane) = o;
            }
        }
    }
    __syncthreads();
}

namespace topk {
typedef float f32x16 __attribute__((ext_vector_type(16)));
typedef short bf16x8 __attribute__((ext_vector_type(8)));
constexpr int SKL_OFF = 0, LUT_OFF = 65536, LUT_STRIDE = 36, TOPK_LDS = LUT_OFF + NWAVES * 64 * LUT_STRIDE;
static_assert(TOPK_LDS <= RING_BYTES, "topk LDS");
__device__ __forceinline__ float vmaxf(float a, float b) { float r; asm("v_max_f32_e32 %0, %1, %2" : "=v"(r) : "v"(a), "v"(b)); return r; }
__device__ __forceinline__ float vminf(float a, float b) { float r; asm("v_min_f32_e32 %0, %1, %2" : "=v"(r) : "v"(a), "v"(b)); return r; }
#define TK_CE(x, y) do { const float hi_ = vmaxf(x, y), lo_ = vminf(x, y); x = hi_; y = lo_; } while (0)
constexpr int SA[63] = {0,2,4,6,8,10,12,14,0,1,4,5,8,9,12,13,1,5,9,13,0,1,2,3,8,9,10,11,2,3,10,11,1,3,5,9,11,13,0,1,2,3,4,5,6,7,4,5,6,7,2,3,6,7,10,11,1,3,5,7,9,11,13};
constexpr int SB[63] = {1,3,5,7,9,11,13,15,2,3,6,7,10,11,14,15,2,6,10,14,4,5,6,7,12,13,14,15,4,5,12,13,2,4,6,10,12,14,8,9,10,11,12,13,14,15,8,9,10,11,4,5,8,9,12,13,2,4,6,8,10,12,14};
constexpr int MA[32] = {0,1,2,3,4,5,6,7,0,1,2,3,8,9,10,11,0,1,4,5,8,9,12,13,0,2,4,6,8,10,12,14};
constexpr int MB[32] = {8,9,10,11,12,13,14,15,4,5,6,7,12,13,14,15,2,3,6,7,10,11,14,15,1,3,5,7,9,11,13,15};
constexpr int CAND_A[50] = {0,0,0,0,0,0,0,0,0,0,0,0,0,0,0,0,1,1,1,1,1,1,1,1,2,2,2,2,2,3,3,3,3,4,4,4,5,5,6,6,7,7,8,9,10,11,12,13,14,15};
constexpr int CAND_B[50] = {0,1,2,3,4,5,6,7,8,9,10,11,12,13,14,15,0,1,2,3,4,5,6,7,0,1,2,3,4,0,1,2,3,0,1,2,0,1,0,1,0,1,0,0,0,0,0,0,0,0};
__device__ __forceinline__ void sort16(float (&v)[16]) {
#pragma unroll
    for (int i = 0; i < 63; ++i) TK_CE(v[SA[i]], v[SB[i]]);
}
__device__ __forceinline__ void bitonic16(float (&v)[16]) {
#pragma unroll
    for (int i = 0; i < 32; ++i) TK_CE(v[MA[i]], v[MB[i]]);
}
__device__ __forceinline__ void merge16(float (&a)[16], const float (&b)[16]) {
#pragma unroll
    for (int i = 0; i < 16; ++i) a[i] = vmaxf(a[i], b[15 - i]);
    bitonic16(a);
}
__device__ __forceinline__ void top16_of_tiles(const f32x16 (&acc)[4], int hi, float (&top)[16]) {
    float w[16];
#pragma unroll
    for (int blk = 0; blk < 4; ++blk) {
#pragma unroll
        for (int r = 0; r < 16; ++r) { const unsigned key = (unsigned)(blk * 32 + (r & 3) + 8 * (r >> 2)) + 4u * (unsigned)hi;
            const float pv = __uint_as_float((__float_as_uint(acc[blk][r]) & 0xffffff80u) | key);
            if (blk == 0) top[r] = pv; else w[r] = pv; }
        if (blk == 0) sort16(top); else { sort16(w); merge16(top, w); }
    }
    float lo[16], hi_[16];
#pragma unroll
    for (int i = 0; i < 16; ++i) { const auto rr = __builtin_amdgcn_permlane32_swap(__float_as_uint(top[i]), __float_as_uint(top[i]), false, false); lo[i] = __uint_as_float(rr[0]); hi_[i] = __uint_as_float(rr[1]); }
#pragma unroll
    for (int i = 0; i < 16; ++i) top[i] = vmaxf(lo[i], hi_[15 - i]);
    bitonic16(top);
}
}

__device__ __forceinline__ void p5_topk(Frame& F) {
    PHASE_IDS(F);
    using namespace topk;
    const bf16* QP = (const bf16*)(F.ws + WS_QP); const bf16* SK = (const bf16*)(F.ws + WS_SK);
    unsigned short* SEL = (unsigned short*)(F.ws + WS_SEL); float* GATE = (float*)(F.ws + WS_GATE);
    LAS unsigned char* skl = F.lds + RING_OFF + SKL_OFF; LAS unsigned char* lut = F.lds + RING_OFF + LUT_OFF + F.tid * LUT_STRIDE;
    { v4u sk_[8];
#pragma unroll
      for (int k = 0; k < 8; ++k) { const int i = F.tid + k * NWAVES * 64, row = i >> 4, c = i & 15; sk_[k] = *(const GAS v4u*)(SK + (size_t)row * PHALF + c * 8); }
#pragma unroll
      for (int k = 0; k < 8; ++k) { const int i = F.tid + k * NWAVES * 64, row = i >> 4, c = i & 15; *(LAS v4u*)(skl + row * 256 + ((c ^ (row & 15)) << 4)) = sk_[k]; } }
    __syncthreads();
#if CONV_SPLIT == 0
    const bool conv_first = F.wave < NWAVES / 2;
#elif CONV_SPLIT == 1
    const bool conv_first = (F.wave & 1) != 0;
#else
    const bool conv_first = true;
#endif
#if CONV_SPLIT != 3 && !CONV_IN_SEAMS
    if (conv_first) p0_convert_experts<true, CONV_V_PH == 5>(F);
#endif
    const int gw = F.vcu * NWAVES + F.wave, NGW = F.G * NWAVES, tok = F.lane & 31, hi = F.lane >> 5;
    bf16x8 bq[8];
#if TOPK_LOCAL
    pg8::StaticOrder SQ; SQ.init(T, PH * PQ, F.G, (int)blockIdx.x);
    pg8::Unit uq_; int ui_ = 0; int un = SQ.next(0, uq_) ? (((uq_.pm * 8 + F.wave) << 3) | uq_.pn) : (T / 32) * PH;
#define TOPK_NEXT(un_) ([&]() { pg8::Unit n_; return SQ.next(ui_ + 1, n_) ? (((n_.pm * 8 + F.wave) << 3) | n_.pn) : (T / 32) * PH; }())
#define TOPK_STEP() do { ++ui_; } while (0)
#else
    int un = gw;
#define TOPK_NEXT(un_) ((un_) + NGW)
#define TOPK_STEP() do {} while (0)
#endif
    if (un < (T / 32) * PH) { const unsigned char* q0 = (const unsigned char*)QP + (size_t)un * 16 * 1024 + F.lane * 16;
#pragma unroll
        for (int ks = 0; ks < 8; ++ks) bq[ks] = *(const GAS bf16x8*)(q0 + ks * 1024); }
#pragma unroll 1
    for (; un < (T / 32) * PH; ) {
        const int unn = TOPK_NEXT(un);
        const int tg = un >> 3, h = un & 7; const size_t trow = (size_t)tg * 32 + tok;
        const unsigned char* qblk = (const unsigned char*)QP + (size_t)un * 16 * 1024 + F.lane * 16;
        const unsigned char* qnext = (const unsigned char*)QP + (size_t)(unn < (T / 32) * PH ? unn : un) * 16 * 1024 + F.lane * 16;
        float v1[16], v2[16];
#pragma unroll
        for (int half = 0; half < 2; ++half) {
            f32x16 acc[4];
#pragma unroll
            for (int blk = 0; blk < 4; ++blk) { acc[blk] = f32x16{};
                const int key = blk * 32 + tok;
#pragma unroll
                for (int ks = 0; ks < 8; ++ks) { const bf16x8 a = *(const LAS bf16x8*)(skl + half * 32768 + key * 256 + (((2 * ks + hi) ^ (key & 15)) << 4));
                    acc[blk] = __builtin_amdgcn_mfma_f32_32x32x16_bf16(a, bq[ks], acc[blk], 0, 0, 0); } }
            { const unsigned char* qn = half == 0 ? qblk + 8 * 1024 : qnext;
#pragma unroll
              for (int ks = 0; ks < 8; ++ks) bq[ks] = *(const GAS bf16x8*)(qn + ks * 1024); }
            __builtin_amdgcn_sched_barrier(0);
            if (half == 0) top16_of_tiles(acc, hi, v1); else top16_of_tiles(acc, hi, v2);
        }
#pragma unroll
        for (int i = 0; i < 16; ++i) { lut[i] = (unsigned char)(__float_as_uint(v1[i]) & 0x7fu); lut[16 + i] = (unsigned char)(__float_as_uint(v2[i]) & 0x7fu); }
        float c[4][16];
#pragma unroll
        for (int n = 0; n < 64; ++n) {
            if (n < 50) { const int a = CAND_A[n], b = CAND_B[n];
                const float s = __uint_as_float(__float_as_uint(v1[a]) & 0xffffff80u) + __uint_as_float(__float_as_uint(v2[b]) & 0xffffff80u);
                c[n >> 4][n & 15] = __uint_as_float((__float_as_uint(s) & 0xffffff00u) | (unsigned)((a << 4) | b)); }
            else c[n >> 4][n & 15] = -INFINITY;
        }
        sort16(c[1]); merge16(c[0], c[1]); sort16(c[2]); merge16(c[0], c[2]); merge16(c[0], c[3]);
        float g[16]; float sum = 0.f; const float m0 = __uint_as_float(__float_as_uint(c[0][0]) & 0xffffff00u);
#pragma unroll
        for (int i = 0; i < 16; ++i) { g[i] = __builtin_amdgcn_exp2f((__uint_as_float(__float_as_uint(c[0][i]) & 0xffffff00u) - m0) * LOG2E); sum += g[i]; }
        const float inv = __builtin_amdgcn_rcpf(sum);
        asm volatile("s_waitcnt lgkmcnt(0)" ::: "memory");
        unsigned ids[16];
#pragma unroll
        for (int i = 0; i < 16; ++i) { const unsigned code = __float_as_uint(c[0][i]) & 0xffu; ids[i] = (unsigned)lut[code >> 4] * NKEY + (unsigned)lut[16 + (code & 15)]; }
        if (hi == 0) {
            v4u s0, s1; s0.x = ids[0] | (ids[1] << 16); s0.y = ids[2] | (ids[3] << 16); s0.z = ids[4] | (ids[5] << 16); s0.w = ids[6] | (ids[7] << 16);
            s1.x = ids[8] | (ids[9] << 16); s1.y = ids[10] | (ids[11] << 16); s1.z = ids[12] | (ids[13] << 16); s1.w = ids[14] | (ids[15] << 16);
            GAS v4u* sp = (GAS v4u*)(SEL + trow * NSEL + h * PK); sp[0] = s0; sp[1] = s1;
        } else {
            GAS f32x4* gp = (GAS f32x4*)(GATE + trow * NSEL + h * PK);
#pragma unroll
            for (int i = 0; i < 4; ++i) gp[i] = (f32x4){g[4 * i] * inv, g[4 * i + 1] * inv, g[4 * i + 2] * inv, g[4 * i + 3] * inv};
        }
        asm volatile("s_waitcnt lgkmcnt(0)" ::: "memory");
        un = unn; TOPK_STEP();
    }
#undef TOPK_NEXT
#undef TOPK_STEP
#if CONV_SPLIT != 3 && !CONV_IN_SEAMS
    if (!conv_first) p0_convert_experts<true, CONV_V_PH == 5>(F);
#endif
    __syncthreads();
}

constexpr float USCALE = 96.0f * 14.0f, VSCALE = 6.0f;
constexpr size_t SLICE_BYTES = (size_t)NEXP * 128;
typedef float f32x2v __attribute__((ext_vector_type(2)));
typedef _Float16 h2v __attribute__((ext_vector_type(2)));
__device__ __forceinline__ float gelu_tanh(float x) {
    const float u = 1.5957691216057308f * (x + 0.044715f * x * x * x);
    return x * __builtin_amdgcn_rcpf(1.0f + __builtin_amdgcn_exp2f(-u * LOG2E));
}
__device__ __forceinline__ float dpp_sum8(float v) {
    v += __builtin_bit_cast(float, __builtin_amdgcn_update_dpp(0, __builtin_bit_cast(int, v), 0xB1, 0xf, 0xf, true));
    v += __builtin_bit_cast(float, __builtin_amdgcn_update_dpp(0, __builtin_bit_cast(int, v), 0x4E, 0xf, 0xf, true));
    v += __builtin_bit_cast(float, __builtin_amdgcn_update_dpp(0, __builtin_bit_cast(int, v), 0x141, 0xf, 0xf, true));
    return v;
}
template <int NSL> __device__ __forceinline__ void slice_of_block(Frame& F, int which, int& s, int& gws, int& nws) {
#if SLICE_BY_XCC
    LAS unsigned* slot = (LAS unsigned*)(F.lds + MISC_OFF) + 16;
    if (F.tid == 0) {
        unsigned ok = (F.MISC[8] != 0u) ? 1u : 0u; unsigned* bw = (unsigned*)(F.ctl + CW_BAR); const unsigned x = xb_xcc_id(); unsigned mine = 0u;
        for (unsigned j = 0; j < 16; ++j) { const unsigned cnt = xb_ld(&bw[XB_XCNT(j)]); ok &= (j < 8) ? (cnt > 0u) : (cnt == 0u); if (j < 8 && (j & (NSL - 1)) == (x & (NSL - 1))) mine += cnt; }
        unsigned rank = 0u;
        if (ok) rank = xb_add((unsigned*)(F.ctl + CW_XRANK + (which * 16 + (int)(x & (NSL - 1))) * 64), 1u);
        slot[0] = ok; slot[1] = rank; slot[2] = x & (NSL - 1); slot[3] = mine;
    }
    __syncthreads();
    const unsigned ok = slot[0], rank = slot[1], x = slot[2], mine = slot[3];
    __syncthreads();
    if (ok) { s = (int)x; gws = (int)rank * NWAVES + F.wave; nws = (int)mine * NWAVES; return; }
#endif
    s = (int)(blockIdx.x & (NSL - 1)); gws = (int)(blockIdx.x / NSL) * NWAVES + F.wave; nws = ((F.G - s + NSL - 1) / NSL) * NWAVES;
}
struct TokIdx { v4u i0, i1; };
__device__ __forceinline__ unsigned sel_of(const TokIdx& I, int b) { const unsigned w = b < 8 ? I.i0[b >> 1] : I.i1[(b - 8) >> 1]; return (b & 1) ? (w >> 16) : (w & 0xffffu); }
#define LD_ROW(I, b) __builtin_bit_cast(v4u, __builtin_amdgcn_raw_buffer_load_b128(rsrc, (int)((sel_of(I, (b)) & EMASK) * 128u + lane16), 0, 0))
template <unsigned EMASK> __device__ __forceinline__ void p6_experts_u(Frame& F, float* PD, int which) {
    PHASE_IDS(F);
    const unsigned char* H1Q = F.ws + WS_H1Q; const unsigned short* SEL = (const unsigned short*)(F.ws + WS_SEL);
    int s, gws, nws; slice_of_block<4>(F, which, s, gws, nws);
    const __amdgpu_buffer_rsrc_t rsrc = __builtin_amdgcn_make_buffer_rsrc((void*)(F.ws + WS_EU + (size_t)s * SLICE_BYTES), 0, (int)SLICE_BYTES, 0x00020000);
    const unsigned lane16 = 16u * (F.lane & 7); const int g = F.lane >> 3, c = F.lane & 7;
    const unsigned short* selp = SEL + 16 * g; const unsigned char* hp = H1Q + 256 * s + 32 * c;
    struct HP { v4u h[2]; float rs; };
#if PD_F16
    const float* RS2u = (const float*)(F.ws + WS_RS2);
#define LD_RS(H, t_) H.rs = RS2u[t_]
#else
#define LD_RS(H, t_) H.rs = 0.f
#endif
#define LD_IDX(I, H, tt) do { const size_t t_ = (size_t)((tt) < T ? (tt) : T - 1); I.i0 = *(const GAS v4u*)(selp + t_ * NSEL); I.i1 = *(const GAS v4u*)(selp + t_ * NSEL + 8); \
        H.h[0] = *(const GAS v4u*)(hp + t_ * DMODEL); H.h[1] = *(const GAS v4u*)(hp + t_ * DMODEL + 16); LD_RS(H, t_); } while (0)
    TokIdx In, In2; HP hc, hn, h2; v4u r[16];
#if CONV_V_PH == 6
    if (which == 0 && (F.wave & 1)) p0_convert_experts<false, true>(F);
#endif
    int t = gws;
    if (t < T) {
    { TokIdx Ic; LD_IDX(Ic, hc, t); LD_IDX(In, hn, t + nws);
#pragma unroll
      for (int b = 0; b < 16; ++b) r[b] = LD_ROW(Ic, b); }
#pragma unroll 1
    for (; t < T; t += nws) {
        LD_IDX(In2, h2, t + 2 * nws);
#if U_DOT8
        const int seed = 0;
#else
        int hs = 0;
#pragma unroll
        for (int w = 0; w < 8; ++w) hs = __builtin_amdgcn_sdot4(0x01010101, (int)hc.h[w >> 2][w & 3], hs, false);
        const int seed = -8 * hs;
#endif
        float v0 = 0.f, v1 = 0.f; int pi_[16];
#pragma unroll
        for (int b = 0; b < 16; ++b) {
            asm volatile("" : "+v"(r[b]));
            int a0 = seed, a1 = 0;
#pragma unroll
#if U_DOT8
            for (int q = 0; q < 4; ++q) { const unsigned x = r[b][q];
                a0 = __builtin_amdgcn_sdot8((int)x, (int)hc.h[q >> 1][2 * (q & 1)], a0, false);
                a1 = __builtin_amdgcn_sdot8((int)x, (int)hc.h[q >> 1][2 * (q & 1) + 1], a1, false); }
            pi_[b] = 16 * a0 + a1;
#else
            for (int q = 0; q < 4; ++q) { const unsigned x = r[b][q];
                a0 = __builtin_amdgcn_sdot4((int)(x & 0x0F0F0F0Fu), (int)hc.h[q >> 1][2 * (q & 1)], a0, false);
                a1 = __builtin_amdgcn_sdot4((int)((x >> 4) & 0x0F0F0F0Fu), (int)hc.h[q >> 1][2 * (q & 1) + 1], a1, false); }
            float pr = dpp_sum8((float)(a0 + a1)); asm volatile("" : "+v"(pr));
#endif
#if !U_DOT8
            if (b & 1) v1 = (c == (b >> 1)) ? pr : v1; else v0 = (c == (b >> 1)) ? pr : v0;
#endif
            r[b] = LD_ROW(In, b);
        }
#if U_DOT8
        {
#pragma unroll
          for (int b = 0; b < 16; ++b) pi_[b] += __builtin_amdgcn_update_dpp(0, pi_[b], 0xB1, 0xf, 0xf, true);
#pragma unroll
          for (int b = 0; b < 16; ++b) pi_[b] += __builtin_amdgcn_update_dpp(0, pi_[b], 0x4E, 0xf, 0xf, true);
#pragma unroll
          for (int b = 0; b < 16; ++b) pi_[b] += __builtin_amdgcn_update_dpp(0, pi_[b], 0x141, 0xf, 0xf, true);
          int vi0 = 0, vi1 = 0;
#pragma unroll
          for (int b = 0; b < 16; ++b) { if (b & 1) vi1 = (c == (b >> 1)) ? pi_[b] : vi1; else vi0 = (c == (b >> 1)) ? pi_[b] : vi0; }
          v0 = (float)vi0; v1 = (float)vi1; }
#endif
#if PD_F16
        { const float r_ = hc.rs * (1.0f / USCALE); ((GAS unsigned*)PD)[((size_t)t * 4 + s) * (NSEL / 2) + 8 * g + c] = __builtin_bit_cast(unsigned, __builtin_amdgcn_cvt_pkrtz(v0 * r_, v1 * r_)); }
#else
        *(GAS f32x2v*)(PD + ((size_t)t * 4 + s) * NSEL + 16 * g + 2 * c) = (f32x2v){v0, v1};
#endif
        In = In2; hc = hn; hn = h2;
    }
    }
#if CONV_V_PH == 6
    if (which == 0 && !(F.wave & 1)) p0_convert_experts<false, true>(F);
#endif
#undef LD_IDX
#undef LD_RS
}
__device__ __forceinline__ void p6b_reduce(Frame& F) {
    PHASE_IDS(F);
    const float* PD = (const float*)(F.ws + WS_PD); const float* GATE = (const float*)(F.ws + WS_GATE); const float* SS1P = (const float*)(F.ws + WS_SS1P); float* WACT = (float*)(F.ws + WS_WACT);
    const int gw = F.vcu * NWAVES + F.wave, NGW = F.G * NWAVES;
#pragma unroll 1
    for (int t = gw; t < T; t += NGW) {
#if PD_F16
        const float rs2 = 1.0f;
        f32x2v acc = (f32x2v){0.f, 0.f};
        { unsigned pw_[4];
#pragma unroll
          for (int sl = 0; sl < 4; ++sl) pw_[sl] = ((const GAS unsigned*)PD)[((size_t)t * 4 + sl) * (NSEL / 2) + F.lane];
#pragma unroll
          for (int sl = 0; sl < 4; ++sl) { const unsigned w_ = pw_[sl]; const h2v hv_ = __builtin_bit_cast(h2v, w_); acc += (f32x2v){(float)hv_.x, (float)hv_.y}; } }
#else
        float ssv = F.lane < 16 ? SS1P[(size_t)t * 16 + F.lane] : 0.f; ssv = wave_sum(ssv);
        const float rs2 = (1.0f / USCALE) / sqrtf(ssv * (1.0f / DMODEL) + EPS);
        f32x2v acc = (f32x2v){0.f, 0.f};
#pragma unroll
        for (int sl = 0; sl < 4; ++sl) acc += *(const GAS f32x2v*)(PD + ((size_t)t * 4 + sl) * NSEL + 2 * F.lane);
#endif
        const f32x2v gt = *(const GAS f32x2v*)(GATE + (size_t)t * NSEL + 2 * F.lane);
        const float w0_ = gt.x * gelu_tanh(acc.x * rs2), w1_ = gt.y * gelu_tanh(acc.y * rs2);
        ((GAS unsigned*)(F.ws + WS_WH))[(size_t)t * (NSEL / 2) + F.lane] = __builtin_bit_cast(unsigned, __builtin_amdgcn_cvt_pkrtz(w0_, w1_));
#if SELFCHECK
        *(GAS f32x2v*)(WACT + (size_t)t * NSEL + 2 * F.lane) = (f32x2v){w0_, w1_};
#endif
    }
}
__device__ __forceinline__ float xchg32(float send, bool up) { const auto rr = __builtin_amdgcn_permlane32_swap(__float_as_uint(send), __float_as_uint(send), false, false); return __uint_as_float(up ? rr[0] : rr[1]); }
__device__ __forceinline__ void p7_experts_v(Frame& F) {
    constexpr unsigned EMASK = 0xffffu;
    PHASE_IDS(F);
    const bf16* H1B = (const bf16*)(F.ws + WS_H1B); const unsigned short* SEL = (const unsigned short*)(F.ws + WS_SEL); const unsigned* WH = (const unsigned*)(F.ws + WS_WH);
    bf16* H2B = (bf16*)(F.ws + WS_H2B); float* SS2P = (float*)(F.ws + WS_SS2);
    int s, gws, nws; slice_of_block<4>(F, 1, s, gws, nws);
    const __amdgpu_buffer_rsrc_t rsrc = __builtin_amdgcn_make_buffer_rsrc((void*)(F.ws + WS_EV + (size_t)s * SLICE_BYTES), 0, (int)SLICE_BYTES, 0x00020000);
    const unsigned lane16 = 16u * (F.lane & 7); const int g = F.lane >> 3, c = F.lane & 7;
    const bool up32 = (F.lane & 32) != 0, up16 = (F.lane & 16) != 0, up8 = (F.lane & 8) != 0;
    const int k0 = (up32 ? 16 : 0) + (up16 ? 8 : 0) + (up8 ? 4 : 0);
    const unsigned short* selp = SEL + 16 * g; const bf16* hp = H1B + 256 * s + 32 * c + k0;
    typedef unsigned u32x2v __attribute__((ext_vector_type(2)));
#if V_INWAVE_W
    const float* PDp = (const float*)(F.ws + WS_PD) + 2 * F.lane; const float* GTp = (const float*)(F.ws + WS_GATE) + 2 * F.lane; const float* RS2 = (const float*)(F.ws + WS_RS2);
    struct WSrc { f32x2v pd[4]; f32x2v gt; float rs; };
#define LD_W(W, t_) do { _Pragma("unroll") for (int sl_ = 0; sl_ < 4; ++sl_) W.pd[sl_] = *(const GAS f32x2v*)(PDp + ((t_) * 4 + sl_) * NSEL); W.gt = *(const GAS f32x2v*)(GTp + (t_) * NSEL); W.rs = RS2[t_]; } while (0)
    WSrc wc, wn, w2;
#else
    const unsigned* wp = WH + 8 * g;
#define LD_W(W, t_) do { W[0] = *(const GAS v4u*)(wp + (t_) * (NSEL / 2)); W[1] = *(const GAS v4u*)(wp + (t_) * (NSEL / 2) + 4); } while (0)
    v4u wc[2], wn[2], w2[2];
#endif
#define LD_IDXW(I, W, HR, tt) do { const size_t t_ = (size_t)((tt) < T ? (tt) : T - 1); I.i0 = *(const GAS v4u*)(selp + t_ * NSEL); I.i1 = *(const GAS v4u*)(selp + t_ * NSEL + 8); \
        LD_W(W, t_); HR = *(const GAS u32x2v*)(hp + t_ * DMODEL); } while (0)
    TokIdx In, In2; u32x2v hrc, hrn, hr2; v4u r[16];
    int t = gws;
    if (t >= T) return;
    { TokIdx Ic; LD_IDXW(Ic, wc, hrc, t); LD_IDXW(In, wn, hrn, t + nws);
#pragma unroll
      for (int b = 0; b < 16; ++b) r[b] = LD_ROW(Ic, b); }
#pragma unroll 1
    for (; t < T; t += nws) {
        LD_IDXW(In2, w2, hr2, t + 2 * nws);
        h2v ov[16];
#pragma unroll
        for (int k = 0; k < 16; ++k) ov[k] = (h2v){(_Float16)0.f, (_Float16)0.f};
#if V_INWAVE_W
        unsigned wq[8];
        { f32x2v a_ = wc.pd[0]; a_ += wc.pd[1]; a_ += wc.pd[2]; a_ += wc.pd[3]; const float r_ = wc.rs * (1.0f / USCALE);
          const unsigned mine = __builtin_bit_cast(unsigned, __builtin_amdgcn_cvt_pkrtz(wc.gt.x * gelu_tanh(a_.x * r_), wc.gt.y * gelu_tanh(a_.y * r_)));
#pragma unroll
          for (int j = 0; j < 8; ++j) wq[j] = (unsigned)__builtin_amdgcn_ds_bpermute(4 * ((F.lane & ~7) + j), (int)mine); }
#endif
#pragma unroll
        for (int b = 0; b < 16; ++b) {
#if V_INWAVE_W
            const unsigned wu_ = wq[b >> 1];
#else
            const unsigned wu_ = (b >> 3) ? ((((b >> 1) & 3) == 0) ? wc[1].x : (((b >> 1) & 3) == 1) ? wc[1].y : (((b >> 1) & 3) == 2) ? wc[1].z : wc[1].w) : ((((b >> 1) & 3) == 0) ? wc[0].x : (((b >> 1) & 3) == 1) ? wc[0].y : (((b >> 1) & 3) == 2) ? wc[0].z : wc[0].w);
#endif
            const h2v wp_ = __builtin_bit_cast(h2v, wu_); const h2v wv = (b & 1) ? (h2v){wp_.y, wp_.y} : (h2v){wp_.x, wp_.x};
            asm volatile("" : "+v"(r[b]));
#pragma unroll
            for (int q = 0; q < 4; ++q) { ov[4 * q] += wv * __builtin_amdgcn_cvt_scalef32_pk_f16_fp4(r[b][q], 1.0f, 0); ov[4 * q + 1] += wv * __builtin_amdgcn_cvt_scalef32_pk_f16_fp4(r[b][q], 1.0f, 1);
                ov[4 * q + 2] += wv * __builtin_amdgcn_cvt_scalef32_pk_f16_fp4(r[b][q], 1.0f, 2); ov[4 * q + 3] += wv * __builtin_amdgcn_cvt_scalef32_pk_f16_fp4(r[b][q], 1.0f, 3); }
            r[b] = LD_ROW(In, b);
        }
#pragma unroll
        for (int i = 0; i < 8; ++i) { const h2v keep = up32 ? ov[8 + i] : ov[i], send = up32 ? ov[i] : ov[8 + i];
            ov[i] = keep + __builtin_bit_cast(h2v, __float_as_uint(xchg32(__uint_as_float(__builtin_bit_cast(unsigned, send)), up32))); }
#pragma unroll
        for (int i = 0; i < 4; ++i) { const h2v keep = up16 ? ov[4 + i] : ov[i], send = up16 ? ov[i] : ov[4 + i];
            ov[i] = keep + __builtin_bit_cast(h2v, (unsigned)__shfl_xor((int)__builtin_bit_cast(unsigned, send), 16)); }
        float o[4];
#pragma unroll
        for (int i = 0; i < 2; ++i) { const h2v keep = up8 ? ov[2 + i] : ov[i], send = up8 ? ov[i] : ov[2 + i];
            const h2v got = __builtin_bit_cast(h2v, (unsigned)__shfl_xor((int)__builtin_bit_cast(unsigned, send), 8));
            o[2 * i] = (float)keep.x + (float)got.x; o[2 * i + 1] = (float)keep.y + (float)got.y; }
        const float a0 = __uint_as_float(hrc.x << 16) + o[0] * (1.0f / VSCALE), a1 = __uint_as_float(hrc.x & 0xffff0000u) + o[1] * (1.0f / VSCALE);
        const float a2 = __uint_as_float(hrc.y << 16) + o[2] * (1.0f / VSCALE), a3 = __uint_as_float(hrc.y & 0xffff0000u) + o[3] * (1.0f / VSCALE);
        *(GAS u32x2v*)(H2B + (size_t)t * DMODEL + 256 * s + 32 * c + k0) = (u32x2v){pk2(a0, a1), pk2(a2, a3)};
        const float ss = wave_sum((a0 * a0 + a1 * a1) + (a2 * a2 + a3 * a3));
        if (F.lane == 0) SS2P[(size_t)t * 4 + s] = ss;
        In = In2; hrc = hrn; hrn = hr2;
#if V_INWAVE_W
        wc = wn; wn = w2;
#else
#pragma unroll
        for (int q = 0; q < 2; ++q) { wc[q] = wn[q]; wn[q] = w2[q]; }
#endif
    }
#undef LD_ROW
#undef LD_IDXW
#undef LD_W
}

template <int I0, int N> __device__ __forceinline__ void ple_gemm(Frame& F) {
    pg8::Gemm g{(const pg8::bf16_t*)(F.ws + WS_PB), (const pg8::bf16_t*)(F.ws + WS_WP), T, DMODEL, DPLE};
    pg8::SubOrder<I0, N> S; S.S.init(T, DMODEL, F.G, (int)blockIdx.x);
    pg8::EpiRowScale E{(pg8::bf16_t*)(F.ws + WS_PLE), DMODEL, -1};
    pg8::gemm_phase<pg8::EpiRowScale, pg8::SubOrder<I0, N>, true, true>(F.lds + RING_OFF, g, S, E);
}

constexpr int N_PHASES = 10;
struct Args { const float* in[23]; float* out; unsigned char* ws; int ph_lo, ph_hi, probe; };
__global__ void __launch_bounds__(NWAVES * 64, 2) mega_fwd(Args args) {
    extern __shared__ __attribute__((aligned(16))) unsigned char lds[];
    Frame F;
    F.lds = (LAS unsigned char*)lds;
    F.MISC = (volatile LAS unsigned*)(F.lds + MISC_OFF);
    F.tid = threadIdx.x; F.lane = F.tid & 63; F.wave = __builtin_amdgcn_readfirstlane(F.tid >> 6);
    F.G = gridDim.x; { const int bx = blockIdx.x; F.vcu = (F.G % 8 == 0) ? (bx % 8) * (F.G / 8) + bx / 8 : bx; }
    F.ws = args.ws; F.ctl = (gu32*)(args.ws + WS_CTL); F.out = args.out;
#pragma unroll
    for (int i = 0; i < 23; ++i) F.in[i] = args.in[i];
    for (int u = F.tid; u < (LDS_BYTES - LDSCTL_OFF) / 4; u += NWAVES * 64) ((LAS unsigned*)(F.lds + LDSCTL_OFF))[u] = 0u;
    __syncthreads();
    const int lo = args.ph_lo, hi = args.ph_hi;
    XcdBarrier bar; bar.bar = (unsigned*)(F.ctl + CW_BAR); bar.x = 0; bar.st = nullptr;
    if (hi - lo > 1) bar = xcd_barrier_post((unsigned*)(F.ctl + CW_BAR), F.MISC + 8);
#define IN(k) ((((PH_MASK) >> (k)) & 1) && lo <= (k) && (k) < hi)
#define SEAM(k) do { if (IN(k) && IN((k) + 1)) xcd_barrier(bar); } while (0)
#if CONV_IN_SEAMS
#define SEAM_FILL(k, work) do { const bool sb_ = IN(k) && IN((k) + 1); if (sb_) xcd_barrier_arrive(bar); work; if (sb_) xcd_barrier_wait(bar); } while (0)
#else
#define SEAM_FILL(k, work) SEAM(k)
#endif

    if (IN(0)) { p0_prologue<0>(F); if (IN(1)) xcd_barrier_arrive(bar); p0_prologue<1>(F); if (IN(1)) xcd_barrier_wait(bar); }

    if (IN(1)) {
        p1_scan(F);
        pg8::Gemm g{(const pg8::bf16_t*)(F.ws + WS_XB), (const pg8::bf16_t*)(F.ws + WS_WI), T, NINP, DMODEL};
        pg8::StaticOrder S; S.init(T, NINP, F.G, (int)blockIdx.x);
        { const float* RS1 = (const float*)(F.ws + WS_RS1); LAS float* tab = (LAS float*)(F.lds + RSA_OFF); pg8::Unit u;
          float tv_[8]; int nu_ = 0;
#pragma unroll
          for (int i = 0; i < 8; ++i) { const bool ok_ = S.next(i, u); tv_[i] = (ok_ && F.tid < 256) ? RS1[u.pm * 256 + F.tid] : 0.f; nu_ += ok_ ? 1 : 0; }
#pragma unroll
          for (int i = 0; i < 8; ++i) if (i < nu_ && F.tid < 256) tab[i * 256 + F.tid] = tv_[i];
          __syncthreads(); }
        pg8::EpiInProj E{(pg8::bf16_t*)(F.ws + WS_QKV), (pg8::bf16_t*)(F.ws + WS_U), RSA_OFF - RING_OFF, F.in[I_Q_NORM], F.in[I_K_NORM]};
        pg8::gemm_phase<pg8::EpiInProj, pg8::StaticOrder, true, true>(F.lds + RING_OFF, g, S, E);
        SEAM_FILL(1, ({ if (IN(2)) p2_conv_stage(F); convert_expert_rows<false>(F, 0, NEXP / 2); }));
    }

    if (IN(2)) {
        static_assert(attn_body::LDS_BYTES <= RING_BYTES, "attention LDS");
        const attn_body::AttnTensors AT{(const attn_body::bf16*)(F.ws + WS_QKV), (const attn_body::bf16*)(F.ws + WS_QKV) + 512, (const attn_body::bf16*)(F.ws + WS_QKV) + 1024,
                                        (attn_body::bf16*)(F.ws + WS_Y), (const float*)(F.ws + WS_G), (float*)(F.ws + WS_SSA)};
#if ATTN_DYNAMIC
        p2_conv(F, !IN(1));
        __syncthreads();
        float skip_thr, sref_;
        { float m_ = fabsf(F.in[I_Q_NORM][F.lane] * F.in[I_K_NORM][F.lane]);
#pragma unroll
          for (int o_ = 32; o_ >= 1; o_ >>= 1) m_ = fmaxf(m_, __shfl_xor(m_, o_));
          skip_thr = -(37.5f + 2.0f * 1.01f * 64.0f * 0.125f * LOG2E * m_); skip_thr = __builtin_bit_cast(float, __builtin_amdgcn_readfirstlane(__builtin_bit_cast(int, skip_thr)));
          sref_ = 0.5f * (-skip_thr - 37.5f); sref_ = __builtin_bit_cast(float, __builtin_amdgcn_readfirstlane(__builtin_bit_cast(int, sref_))); }
        { gu32* actr = F.ctl + CW_ATQ; unsigned nxt = 0u;
          if (F.tid == 0) nxt = __hip_atomic_fetch_add((unsigned*)actr, 1u, __ATOMIC_RELAXED, __HIP_MEMORY_SCOPE_AGENT);
          for (;;) {
              if (F.tid == 0) F.MISC[24] = nxt;
              __syncthreads();
              const unsigned cur = (unsigned)__builtin_amdgcn_readfirstlane((int)F.MISC[24]);
              __syncthreads();
              if (cur >= (unsigned)(BATCH * NH * 8)) break;
              if (F.tid == 0) nxt = __hip_atomic_fetch_add((unsigned*)actr, 1u, __ATOMIC_RELAXED, __HIP_MEMORY_SCOPE_AGENT);
              const int qb = 7 - (int)(cur >> 7), bh = (int)(cur & 127u);
              attn_body::attn_unit<100>(bh >> 3, bh & 7, qb, AT.Q, AT.K, AT.V, AT.O, AT.G, AT.SSA, (char*)lds + RING_OFF, skip_thr, sref_);
          } }
#else
        const attn_body::StaticOrder S((int)F.G, (int)blockIdx.x);
        for (int r_ = 0; r_ < ATTN_REPS; ++r_) attn_body::attn_phase<attn_body::StaticOrder>((char*)lds + RING_OFF, AT, S);
        for (int r_ = 0; r_ < CONV_REPS; ++r_) p2_conv(F, true);
#endif
        SEAM_FILL(2, convert_expert_rows<false>(F, NEXP / 2, NEXP));
    }

    if (IN(3)) {
        pg8::Gemm g{(const pg8::bf16_t*)(F.ws + WS_Y), (const pg8::bf16_t*)(F.ws + WS_WO), T, DMODEL, DMODEL};
        pg8::StaticOrder S; S.init(T, DMODEL, F.G, (int)blockIdx.x);
        { const float* SSA = (const float*)(F.ws + WS_SSA); LAS float* tab = (LAS float*)(F.lds + RSA_OFF); pg8::Unit u;
          for (int i = 0; i < 8 && S.next(i, u); ++i) if (F.tid < 256) { const int row = u.pm * 256 + F.tid;
              const f32x4 s0 = *(const f32x4*)(SSA + (size_t)row * 8), s1 = *(const f32x4*)(SSA + (size_t)row * 8 + 4);
              tab[i * 256 + F.tid] = __builtin_amdgcn_rsqf(((s0.x + s0.y) + (s0.z + s0.w) + (s1.x + s1.y) + (s1.z + s1.w)) * (1.0f / DATT) + EPS); }
          __syncthreads(); }
        pg8::EpiOutProj E{(const pg8::bf16_t*)(F.ws + WS_XB), (pg8::bf16_t*)(F.ws + WS_H1B), (float*)(F.ws + WS_SS1P), (const float*)(F.ws + WS_SSA), F.ws + WS_H1Q, RSA_OFF - RING_OFF};
#if PROBE_MODE
        if (args.probe) { pg8::EpiOutProjT<PROBE_MODE> E2{(const pg8::bf16_t*)(F.ws + WS_XB), (pg8::bf16_t*)(F.ws + WS_H1B), (float*)(F.ws + WS_SS1P), (const float*)(F.ws + WS_SSA), F.ws + WS_H1Q, RSA_OFF - RING_OFF};
            pg8::gemm_phase<pg8::EpiOutProjT<PROBE_MODE>, pg8::StaticOrder, true, true>(F.lds + RING_OFF, g, S, E2); } else
#endif
        pg8::gemm_phase<pg8::EpiOutProj, pg8::StaticOrder, true, true>(F.lds + RING_OFF, g, S, E);
        SEAM_FILL(3, convert_expert_rows<true>(F, 0, NEXP / 2));
    }
    if (IN(4)) {
        pg8::Gemm g{(const pg8::bf16_t*)(F.ws + WS_H1B), (const pg8::bf16_t*)(F.ws + WS_WQ), T, PH * PQ, DMODEL};
        pg8::StaticOrder S; S.init(T, PH * PQ, F.G, (int)blockIdx.x);
        { const float* SS1P = (const float*)(F.ws + WS_SS1P); LAS float* tab = (LAS float*)(F.lds + RSA_OFF); pg8::Unit u;
          for (int i0 = 0; i0 < 8; i0 += 4) {
          f32x4 tb_[4][4]; int nu_ = 0; int upm_[4], upn_[4];
#pragma unroll
          for (int i = 0; i < 4; ++i) { const bool ok_ = S.next(i0 + i, u); upm_[i] = u.pm; upn_[i] = ok_ ? u.pn : -1; const float* sp = SS1P + ((ok_ && F.tid < 256) ? (size_t)(u.pm * 256 + F.tid) : 0) * 16;
#pragma unroll
              for (int q4_ = 0; q4_ < 4; ++q4_) tb_[i][q4_] = *(const f32x4*)(sp + 4 * q4_); nu_ += ok_ ? 1 : 0; }
#pragma unroll
          for (int i = 0; i < 4; ++i) if (i < nu_ && F.tid < 256) { float s = 0.f;
#pragma unroll
              for (int q4_ = 0; q4_ < 4; ++q4_) { const f32x4 v = tb_[i][q4_]; s += (v.x + v.y) + (v.z + v.w); }
              const float rs_ = __builtin_amdgcn_rsqf(s * (1.0f / DMODEL) + EPS); tab[(i0 + i) * 256 + F.tid] = rs_;
              if (upn_[i] == 0) ((float*)(F.ws + WS_RS2))[upm_[i] * 256 + F.tid] = rs_; }
          if (nu_ < 4) break; }
          __syncthreads(); }
        pg8::EpiRowScale E{(pg8::bf16_t*)(F.ws + WS_QP), 0, RSA_OFF - RING_OFF};
        pg8::gemm_phase<pg8::EpiRowScale, pg8::StaticOrder, true, true>(F.lds + RING_OFF, g, S, E);
#if TOPK_LOCAL
        if (IN(4) && IN(5)) { __builtin_amdgcn_fence(__ATOMIC_RELEASE, "workgroup"); __syncthreads(); __builtin_amdgcn_fence(__ATOMIC_ACQUIRE, "workgroup"); }
#else
        SEAM(4);
#endif
    }
    if (IN(5)) { p5_topk(F); if (IN(6)) xcd_barrier_arrive(bar); }
    if (IN(6)) {
#if P_LATE
        p0_prologue<2>(F);
#else
        ple_gemm<0, PLE_SPLIT>(F);
#endif
        if (IN(5)) xcd_barrier_wait(bar);
        p6_experts_u<0xffffu>(F, (float*)(F.ws + WS_PD), 0);
#if PROBE_U
        p6_experts_u<PROBE_U_MASK>(F, F.out, 2);
#endif
        SEAM_FILL(6, convert_expert_rows<true>(F, NEXP / 2, NEXP));
    }
#if V_INWAVE_W && !SELFCHECK
#else
#if P_LATE
    if (IN(7)) { p6b_reduce(F); SEAM_FILL(7, (ple_gemm<0, PLE_SPLIT>(F))); }
#else
    if (IN(7)) { p6b_reduce(F); SEAM_FILL(7, (ple_gemm<PLE_SPLIT, (1 << 20)>(F))); }
#endif
#endif
#if P_LATE
    if (IN(8)) { p7_experts_v(F); SEAM_FILL(8, (ple_gemm<PLE_SPLIT, (1 << 20)>(F))); }
#else
    if (IN(8)) { p7_experts_v(F); SEAM(8); }
#endif
    if (IN(9)) {
        pg8::Gemm g{(const pg8::bf16_t*)(F.ws + WS_H2B), (const pg8::bf16_t*)(F.ws + WS_WG), T, DMODEL, DMODEL};
        pg8::StaticOrder S; S.init(T, DMODEL, F.G, (int)blockIdx.x);
        { const float* SS2P = (const float*)(F.ws + WS_SS2); LAS float* tab = (LAS float*)(F.lds + RSA_OFF); pg8::Unit u;
          for (int i = 0; i < 8 && S.next(i, u); ++i) if (F.tid < 256) { const f32x4 v0 = *(const f32x4*)(SS2P + (size_t)(u.pm * 256 + F.tid) * 4);
              tab[i * 256 + F.tid] = __builtin_amdgcn_rsqf(((v0.x + v0.y) + (v0.z + v0.w)) * (1.0f / DMODEL) + EPS); }
          __syncthreads(); }
        pg8::EpiFinal E{(const pg8::bf16_t*)(F.ws + WS_H2B), (const pg8::bf16_t*)(F.ws + WS_PLE), RSA_OFF - RING_OFF, F.out};
        pg8::gemm_phase<pg8::EpiFinal, pg8::StaticOrder, true, true>(F.lds + RING_OFF, g, S, E);
    }

#undef IN
#undef SEAM
#undef SEAM_FILL
}

#if SELFCHECK
namespace chk {
constexpr int NS = 64;
__device__ __forceinline__ int sample_token(int i) {
    switch (i) { case 0: return 0; case 1: return 2047; case 2: return 2048; case 3: return T - 1; case 4: return 255; case 5: return 256; case 6: return 31; case 7: return 2048 * 7 + 1000; default: break; }
    return (int)(((long)i * 7919 + 13) % T);
}
__device__ __forceinline__ float bf2f(unsigned short v) { return __uint_as_float((unsigned)v << 16); }
__device__ float block_sum(float v, float* red) {
    for (int o = 1; o < 64; o <<= 1) v += __shfl_xor(v, o);
    const int w = threadIdx.x >> 6, nw = blockDim.x >> 6;
    __syncthreads(); if ((threadIdx.x & 63) == 0) red[w] = v; __syncthreads();
    float t = 0.f; for (int i = 0; i < nw; ++i) t += red[i];
    return t;
}
__device__ float block_max(float v, float* red) {
    for (int o = 1; o < 64; o <<= 1) v = fmaxf(v, __shfl_xor(v, o));
    const int w = threadIdx.x >> 6, nw = blockDim.x >> 6;
    __syncthreads(); if ((threadIdx.x & 63) == 0) red[w] = v; __syncthreads();
    float t = red[0]; for (int i = 1; i < nw; ++i) t = fmaxf(t, red[i]);
    return t;
}
__device__ void verdict(unsigned* code, int bit, float d2, float r2, float tol) { if (threadIdx.x == 0 && !(d2 <= tol * tol * r2 + 1e-10f)) atomicOr(code, 1u << bit); }

__global__ void __launch_bounds__(256) chk_inproj(Args a) {
    __shared__ float zs[NIN]; __shared__ float xs[DMODEL]; __shared__ float msq[16]; __shared__ float red[8];
    const int t = sample_token(blockIdx.x), tid = threadIdx.x; unsigned* code = (unsigned*)(a.ws + WS_CTL) + CW_CODE;
    const float* x = a.in[I_X] + (size_t)t * DMODEL; float s = 0.f;
    for (int k = tid; k < DMODEL; k += 256) s += x[k] * x[k];
    const float rs = 1.0f / sqrtf(block_sum(s, red) / DMODEL + EPS);
    for (int k = tid; k < DMODEL; k += 256) xs[k] = x[k] * rs * a.in[I_LN_MIX][k];
    __syncthreads();
    for (int c = tid; c < NIN; c += 256) { float acc = 0.f; const float* w = a.in[I_W_IN] + c; for (int k = 0; k < DMODEL; ++k) acc += xs[k] * w[(size_t)k * NIN]; zs[c] = acc; }
    __syncthreads();
    if (tid < 16) { float m = 0.f; for (int d = 0; d < 64; ++d) { const float v = zs[64 * tid + d]; m += v * v; } msq[tid] = m / 64.f; }
    __syncthreads();
    const unsigned short* QKV = (const unsigned short*)(a.ws + WS_QKV) + (size_t)t * 1536; const unsigned short* U = (const unsigned short*)(a.ws + WS_U) + (size_t)t * 512;
    float d2[5] = {0, 0, 0, 0, 0}, r2[5] = {0, 0, 0, 0, 0};
    for (int i = tid; i < 512; i += 256) { const int h = i >> 6, d = i & 63;
        float e = zs[i] / sqrtf(msq[h] + EPS) * a.in[I_Q_NORM][d] * pg8::ATT_C2, v = bf2f(QKV[i]); d2[0] += (e - v) * (e - v); r2[0] += e * e;
        e = zs[512 + i] / sqrtf(msq[8 + h] + EPS) * a.in[I_K_NORM][d]; v = bf2f(QKV[512 + i]); d2[1] += (e - v) * (e - v); r2[1] += e * e;
        e = zs[1024 + i]; v = bf2f(QKV[1024 + i]); d2[2] += (e - v) * (e - v); r2[2] += e * e;
        e = zs[COL_A + i] / (1.f + expf(-zs[COL_G + i])); v = bf2f(U[i]); d2[3] += (e - v) * (e - v); r2[3] += e * e; }
    if (tid < 8) { const float z = zs[COL_F + tid] + a.in[I_B_FGATE][tid]; const float e = (fminf(z, 0.f) - log1pf(expf(-fabsf(z)))) * LOG2E, v = ((const float*)(a.ws + WS_LF))[(size_t)t * 8 + tid]; d2[4] += (e - v) * (e - v); r2[4] += e * e; }
    for (int g = 0; g < 5; ++g) { const float dd = block_sum(d2[g], red), rr = block_sum(r2[g], red); verdict(code, g, dd, rr, 2e-2f); }
}
__global__ void chk_scan(Args a) {
    const int i = threadIdx.x; unsigned* code = (unsigned*)(a.ws + WS_CTL) + CW_CODE;
    const int bh = (i * 5) % (BATCH * NH), s = i == 0 ? 0 : (i == 1 ? SEQ - 1 : (i * 331 + 77) % SEQ), b = bh >> 3, h = bh & 7;
    const float* LF = (const float*)(a.ws + WS_LF); double acc = 0.0; for (int u = 0; u <= s; ++u) acc += LF[((size_t)b * SEQ + u) * 8 + h];
    const float v = ((const float*)(a.ws + WS_G))[(size_t)bh * SEQ + s];
    if (!(fabsf(v - (float)acc) <= 2e-3f * (1.f + fabsf((float)acc)))) atomicOr(code, 1u << 5);
}
__global__ void __launch_bounds__(256) chk_attn(Args a) {
    __shared__ float l[SEQ]; __shared__ float qs[64]; __shared__ float part[4][64]; __shared__ float red[8];
    const int t = sample_token(blockIdx.x), h = blockIdx.x & 7, tid = threadIdx.x, b = t / SEQ, st = t % SEQ; unsigned* code = (unsigned*)(a.ws + WS_CTL) + CW_CODE;
    const unsigned short* QKV = (const unsigned short*)(a.ws + WS_QKV); const float* G = (const float*)(a.ws + WS_G) + (size_t)(b * NH + h) * SEQ;
    if (tid < 64) qs[tid] = bf2f(QKV[(size_t)t * 1536 + 64 * h + tid]);
    __syncthreads();
    float mx = -INFINITY;
    for (int s = tid; s <= st; s += 256) { const unsigned short* kr = QKV + ((size_t)b * SEQ + s) * 1536 + 512 + 64 * h; float acc = 0.f; for (int d = 0; d < 64; ++d) acc += qs[d] * bf2f(kr[d]);
        acc += G[st] - G[s]; l[s] = acc; mx = fmaxf(mx, acc); }
    mx = block_max(mx, red);
    float sm = 0.f; for (int s = tid; s <= st; s += 256) { const float p = exp2f(l[s] - mx); l[s] = p; sm += p; }
    sm = block_sum(sm, red);
    { const int d = tid & 63, pt = tid >> 6; float acc = 0.f; for (int s = pt; s <= st; s += 4) acc += l[s] * bf2f(QKV[((size_t)b * SEQ + s) * 1536 + 1024 + 64 * h + d]); part[pt][d] = acc; }
    __syncthreads();
    float d2 = 0.f, r2 = 0.f, e2 = 0.f;
    if (tid < 64) { const float e = (part[0][tid] + part[1][tid] + part[2][tid] + part[3][tid]) / sm, v = bf2f(((const unsigned short*)(a.ws + WS_Y))[(size_t)t * 1024 + 64 * h + tid]); d2 = (e - v) * (e - v); r2 = e * e; e2 = e * e; }
    d2 = block_sum(d2, red); r2 = block_sum(r2, red); verdict(code, 6, d2, r2, 3e-2f);
    if (tid == 0) { const float v = ((const float*)(a.ws + WS_SSA))[(size_t)t * 8 + h]; if (!(fabsf(v - r2) <= 0.05f * r2 + 1e-6f)) atomicOr(code, 1u << 7); }
}
__global__ void __launch_bounds__(512) chk_conv(Args a) {
    __shared__ float red[8];
    const int t = sample_token(blockIdx.x), c = threadIdx.x, b = t / SEQ, st = t % SEQ; unsigned* code = (unsigned*)(a.ws + WS_CTL) + CW_CODE;
    const unsigned short* U = (const unsigned short*)(a.ws + WS_U);
    float y = a.in[I_CONV_B][c];
    for (int j = 0; j < CW; ++j) { const int s = st - 30 + j; if (s >= 0) y += a.in[I_CONV_W][j * DCONV + c] * bf2f(U[((size_t)b * SEQ + s) * DCONV + c]); }
    const float mu = block_sum(y, red) / DCONV; const float var = block_sum((y - mu) * (y - mu), red) / DCONV;
    const float ln = (y - mu) / sqrtf(var + LN_EPS) * a.in[I_CONV_LN_G][c] + a.in[I_CONV_LN_B][c]; const float sw = ln / (1.f + expf(-ln));
    const float ss = block_sum(sw * sw, red) / DCONV; const float e = sw / sqrtf(ss + EPS);
    const float v = bf2f(((const unsigned short*)(a.ws + WS_Y))[(size_t)t * 1024 + 512 + c]);
    const float d2 = block_sum((e - v) * (e - v), red), r2 = block_sum(e * e, red); verdict(code, 8, d2, r2, 2e-2f);
}
__device__ __forceinline__ size_t qp_elem(int t, int n) { const int head = n >> 8, w = n & 255, half = w >> 7, cc = w & 127; return pg8::qpf_byte(t, head, half, cc >> 4, (cc >> 3) & 1) / 2 + (cc & 7); }
__device__ void dense_row(const float* a, int K, const float* W, int ldw, int N, float* out) {
    for (int n = threadIdx.x; n < N; n += blockDim.x) { float acc = 0.f; for (int k = 0; k < K; ++k) acc += a[k] * W[(size_t)k * ldw + n]; out[n] = acc; }
}
__global__ void __launch_bounds__(256) chk_outproj(Args a) {
    __shared__ float ys[DMODEL]; __shared__ float hs[DMODEL]; __shared__ float red[8];
    const int t = sample_token(blockIdx.x), tid = threadIdx.x; unsigned* code = (unsigned*)(a.ws + WS_CTL) + CW_CODE;
    const unsigned short* Y = (const unsigned short*)(a.ws + WS_Y) + (size_t)t * DMODEL;
    float s = 0.f; for (int c = tid; c < DATT; c += 256) { const float v = bf2f(Y[c]); s += v * v; }
    const float rsa = 1.0f / sqrtf(block_sum(s, red) / DATT + EPS);
    for (int c = tid; c < DMODEL; c += 256) ys[c] = c < DATT ? bf2f(Y[c]) * rsa * a.in[I_ATTN_OUT_NORM][c] : bf2f(Y[c]) * a.in[I_CONV_OUT_NORM][c - DATT];
    __syncthreads();
    dense_row(ys, DMODEL, a.in[I_W_OUT], DMODEL, DMODEL, hs);
    __syncthreads();
    float d2 = 0.f, r2 = 0.f;
    for (int n = tid; n < DMODEL; n += 256) { const float e = a.in[I_X][(size_t)t * DMODEL + n] + hs[n], v = bf2f(((const unsigned short*)(a.ws + WS_H1B))[(size_t)t * DMODEL + n]); d2 += (e - v) * (e - v); r2 += e * e; }
    d2 = block_sum(d2, red); r2 = block_sum(r2, red); verdict(code, 9, d2, r2, 2e-2f);
    if (tid == 0) { float ss = 0.f; for (int i = 0; i < 16; ++i) ss += ((const float*)(a.ws + WS_SS1P))[(size_t)t * 16 + i]; if (!(fabsf(ss - r2) <= 0.03f * r2)) atomicOr(code, 1u << 10); }
}
__global__ void __launch_bounds__(256) chk_peerq(Args a) {
    __shared__ float xs[DMODEL]; __shared__ float qs[PH * PQ]; __shared__ float red[8];
    const int t = sample_token(blockIdx.x), tid = threadIdx.x; unsigned* code = (unsigned*)(a.ws + WS_CTL) + CW_CODE;
    const unsigned short* H = (const unsigned short*)(a.ws + WS_H1B) + (size_t)t * DMODEL;
    float s = 0.f; for (int c = tid; c < DMODEL; c += 256) { const float v = bf2f(H[c]); s += v * v; }
    const float rs = 1.0f / sqrtf(block_sum(s, red) / DMODEL + EPS);
    for (int c = tid; c < DMODEL; c += 256) xs[c] = bf2f(H[c]) * rs * a.in[I_LN_FFN][c];
    __syncthreads();
    dense_row(xs, DMODEL, a.in[I_W_PEER_Q], PH * PQ, PH * PQ, qs);
    __syncthreads();
    float d2 = 0.f, r2 = 0.f;
    for (int n = tid; n < PH * PQ; n += 256) { const float e = qs[n], v = bf2f(((const unsigned short*)(a.ws + WS_QP))[qp_elem(t, n)]); d2 += (e - v) * (e - v); r2 += e * e; }
    d2 = block_sum(d2, red); r2 = block_sum(r2, red); verdict(code, 11, d2, r2, 2e-2f);
}
__global__ void __launch_bounds__(256) chk_topk(Args a) {
    __shared__ float s1[NKEY], s2[NKEY]; __shared__ float red[8]; __shared__ int bad;
    const int t = sample_token(blockIdx.x), h = (blockIdx.x * 3) & 7, tid = threadIdx.x; unsigned* code = (unsigned*)(a.ws + WS_CTL) + CW_CODE;
    const unsigned short* QPp = (const unsigned short*)(a.ws + WS_QP);
    if (tid == 0) bad = 0;
    { const int k = tid & 127, half = tid >> 7; const float* sk = (half ? a.in[I_SUB_KEYS2] : a.in[I_SUB_KEYS1]) + (size_t)k * PHALF; float acc = 0.f;
      for (int d = 0; d < PHALF; ++d) acc += bf2f(QPp[qp_elem(t, h * PQ + half * PHALF + d)]) * sk[d];
      if (half) s2[k] = acc; else s1[k] = acc; }
    __syncthreads();
    const unsigned short* sel = (const unsigned short*)(a.ws + WS_SEL) + (size_t)t * NSEL + h * PK; const float* gate = (const float*)(a.ws + WS_GATE) + (size_t)t * NSEL + h * PK;
    float cs[PK]; float mx = -INFINITY;
    for (int i = 0; i < PK; ++i) { const int e = sel[i]; cs[i] = s1[e >> 7] + s2[e & 127]; mx = fmaxf(mx, cs[i]); }
    for (int i = 0; i < PK; ++i) {
        int cnt = 0; for (int c = tid; c < NKEY * NKEY; c += 256) cnt += (s1[c >> 7] + s2[c & 127] > cs[i] + 2e-2f) ? 1 : 0;
        const float tot = block_sum((float)cnt, red); if (tid == 0 && tot >= 16.f) bad = 1;
        for (int j = 0; j < i; ++j) if (tid == 0 && sel[j] == sel[i]) bad = 1;
    }
    if (tid == 0) { float sum = 0.f; for (int i = 0; i < PK; ++i) sum += expf(cs[i] - mx);
        for (int i = 0; i < PK; ++i) { const float e = expf(cs[i] - mx) / sum; if (!(fabsf(gate[i] - e) <= 0.02f * e + 1e-4f)) bad = 1; }
        if (bad) atomicOr(code, 1u << 12); }
}
__global__ void __launch_bounds__(256) chk_experts(Args a) {
    __shared__ float xs[DMODEL]; __shared__ float ws_[NSEL]; __shared__ float red[8];
    const int t = sample_token(blockIdx.x), tid = threadIdx.x; unsigned* code = (unsigned*)(a.ws + WS_CTL) + CW_CODE;
    const unsigned short* H = (const unsigned short*)(a.ws + WS_H1B) + (size_t)t * DMODEL;
    float s = 0.f; for (int c = tid; c < DMODEL; c += 256) { const float v = bf2f(H[c]); s += v * v; }
    const float rs = 1.0f / sqrtf(block_sum(s, red) / DMODEL + EPS);
    for (int c = tid; c < DMODEL; c += 256) xs[c] = bf2f(H[c]) * rs * a.in[I_LN_FFN][c];
    __syncthreads();
    const unsigned short* sel = (const unsigned short*)(a.ws + WS_SEL) + (size_t)t * NSEL; const float* gate = (const float*)(a.ws + WS_GATE) + (size_t)t * NSEL;
    float d2 = 0.f, r2 = 0.f;
    if (tid < NSEL) { const float* u = a.in[I_EXPERT_U] + (size_t)sel[tid] * DMODEL; float acc = 0.f; for (int d = 0; d < DMODEL; ++d) acc += u[d] * xs[d];
        const float act = 0.5f * acc * (1.f + tanhf(0.7978845608028654f * (acc + 0.044715f * acc * acc * acc))); const float e = gate[tid] * act, v = ((const float*)(a.ws + WS_WACT))[(size_t)t * NSEL + tid];
        ws_[tid] = e; d2 = (e - v) * (e - v); r2 = e * e; }
    d2 = block_sum(d2, red); r2 = block_sum(r2, red); verdict(code, 13, d2, r2, 2.5e-1f);
    __syncthreads();
    d2 = 0.f; r2 = 0.f;
    for (int d = tid; d < DMODEL; d += 256) { float acc = bf2f(H[d]); for (int j = 0; j < NSEL; ++j) acc += ws_[j] * a.in[I_EXPERT_V][(size_t)sel[j] * DMODEL + d];
        const float v = bf2f(((const unsigned short*)(a.ws + WS_H2B))[(size_t)t * DMODEL + d]); d2 += (acc - v) * (acc - v); r2 += acc * acc; }
    d2 = block_sum(d2, red); r2 = block_sum(r2, red); verdict(code, 14, d2, r2, 5e-2f);
    if (tid == 0) { float ss = 0.f; for (int i = 0; i < 4; ++i) ss += ((const float*)(a.ws + WS_SS2))[(size_t)t * 4 + i]; if (!(fabsf(ss - r2) <= 0.03f * r2)) atomicOr(code, 1u << 15); }
}
__global__ void __launch_bounds__(256) chk_ple(Args a) {
    __shared__ float ps[DPLE]; __shared__ float os[DMODEL]; __shared__ float red[8];
    const int t = sample_token(blockIdx.x), tid = threadIdx.x; unsigned* code = (unsigned*)(a.ws + WS_CTL) + CW_CODE;
    for (int c = tid; c < DPLE; c += 256) ps[c] = a.in[I_P][(size_t)t * DPLE + c];
    __syncthreads();
    dense_row(ps, DPLE, a.in[I_W_PL_PROJ], DMODEL, DMODEL, os);
    __syncthreads();
    float d2 = 0.f, r2 = 0.f;
    for (int n = tid; n < DMODEL; n += 256) { const float e = os[n], v = bf2f(((const unsigned short*)(a.ws + WS_PLE))[(size_t)t * DMODEL + n]); d2 += (e - v) * (e - v); r2 += e * e; }
    d2 = block_sum(d2, red); r2 = block_sum(r2, red); verdict(code, 16, d2, r2, 2e-2f);
}
__global__ void __launch_bounds__(256) chk_final(Args a) {
    __shared__ float xs[DMODEL]; __shared__ float gs[DMODEL]; __shared__ float red[8];
    const int t = sample_token(blockIdx.x), tid = threadIdx.x; unsigned* code = (unsigned*)(a.ws + WS_CTL) + CW_CODE;
    const unsigned short* H = (const unsigned short*)(a.ws + WS_H2B) + (size_t)t * DMODEL;
    float s = 0.f; for (int c = tid; c < DMODEL; c += 256) { const float v = bf2f(H[c]); s += v * v; }
    const float rs = 1.0f / sqrtf(block_sum(s, red) / DMODEL + EPS);
    for (int c = tid; c < DMODEL; c += 256) xs[c] = bf2f(H[c]) * rs * a.in[I_LN_PL][c];
    __syncthreads();
    dense_row(xs, DMODEL, a.in[I_W_PL_GATE], DMODEL, DMODEL, gs);
    __syncthreads();
    float d2 = 0.f, r2 = 0.f;
    for (int n = tid; n < DMODEL; n += 256) { const float e = bf2f(H[n]) + bf2f(((const unsigned short*)(a.ws + WS_PLE))[(size_t)t * DMODEL + n]) / (1.f + expf(-gs[n])), v = a.out[(size_t)t * DMODEL + n]; d2 += (e - v) * (e - v); r2 += e * e; }
    d2 = block_sum(d2, red); r2 = block_sum(r2, red); verdict(code, 17, d2, r2, 1e-2f);
}

__global__ void finish(Args a, int complete) {
    const unsigned code = ((const unsigned*)(a.ws + WS_CTL))[CW_CODE];
    const float add = code ? 1000.f * (float)(1 + __builtin_ctz(code)) : 0.f;
    for (size_t i = (size_t)blockIdx.x * blockDim.x + threadIdx.x; i < (size_t)T * DMODEL; i += (size_t)gridDim.x * blockDim.x) a.out[i] = (complete ? a.out[i] : 0.f) + add;
}
}
#endif

extern "C" void kernel_launch(void* const* d_in, const int* in_sizes, int n_in, void* d_out, int out_size, void* d_ws, size_t ws_size, hipStream_t stream) {
    static int grid = 0;
    if (grid == 0) {
        if (n_in != 23 || in_sizes[0] != T * DMODEL || out_size != T * DMODEL || ws_size < WS_END) { fprintf(stderr, "kernel_launch: unexpected problem (n_in %d, in0 %d, out %d, ws %zu); nothing launched\n", n_in, n_in > 0 ? in_sizes[0] : -1, out_size, ws_size); grid = -1; return; }
        int dev = 0, cus = 0, per_cu = 0;
        if (hipGetDevice(&dev) != hipSuccess || hipDeviceGetAttribute(&cus, hipDeviceAttributeMultiprocessorCount, dev) != hipSuccess) { grid = -1; return; }
        if (hipFuncSetAttribute((const void*)mega_fwd, hipFuncAttributeMaxDynamicSharedMemorySize, LDS_BYTES) != hipSuccess) { fprintf(stderr, "kernel_launch: hipFuncSetAttribute failed\n"); grid = -1; return; }
        if (hipOccupancyMaxActiveBlocksPerMultiprocessor(&per_cu, (const void*)mega_fwd, NWAVES * 64, LDS_BYTES) != hipSuccess || per_cu < 1) { fprintf(stderr, "kernel_launch: occupancy query says %d\n", per_cu); per_cu = 1; }
        (void)hipGetLastError();
        grid = cus;
    }
    if (grid < 0) return;
    (void)hipMemsetAsync((char*)d_ws + WS_CTL, 0, CTL_ZERO_BYTES, stream);
    Args a{};
    for (int i = 0; i < 23; ++i) a.in[i] = (const float*)d_in[i];
    a.out = (float*)d_out; a.ws = (unsigned char*)d_ws;
    constexpr int LASTP = LAST_PHASE < N_PHASES - 1 ? LAST_PHASE : N_PHASES - 1;
#if MK_ONE_LAUNCH
    a.ph_lo = 0; a.ph_hi = LASTP + 1;
    void* kargs[] = {&a};
    hipError_t e = hipLaunchCooperativeKernel((const void*)mega_fwd, dim3(grid), dim3(NWAVES * 64), kargs, LDS_BYTES, stream);
    if (e != hipSuccess) fprintf(stderr, "kernel_launch: cooperative launch failed: %s (grid %d)\n", hipGetErrorString(e), grid);
#else
    for (int ph = 0; ph <= LASTP; ++ph) {
        a.ph_lo = ph; a.ph_hi = ph + 1;
#if PROBE_MODE
        if (ph == PROBE_PH) { a.probe = 1; for (int rep = 0; rep < PROBE_N; ++rep) hipLaunchKernelGGL(mega_fwd, dim3(grid), dim3(NWAVES * 64), LDS_BYTES, stream, a); a.probe = 0; }
#endif
        for (int rep = 0; rep < 1 + (((REPEAT_MASK) >> ph) & 1) * (REPEAT_N - 1); ++rep) hipLaunchKernelGGL(mega_fwd, dim3(grid), dim3(NWAVES * 64), LDS_BYTES, stream, a);
#if SELFCHECK
        if (ph == 1) { hipLaunchKernelGGL(chk::chk_inproj, dim3(chk::NS), dim3(256), 0, stream, a); hipLaunchKernelGGL(chk::chk_scan, dim3(1), dim3(64), 0, stream, a); }
        if (ph == 2) { hipLaunchKernelGGL(chk::chk_attn, dim3(chk::NS), dim3(256), 0, stream, a); hipLaunchKernelGGL(chk::chk_conv, dim3(chk::NS), dim3(512), 0, stream, a); }
                if (ph == 3) hipLaunchKernelGGL(chk::chk_outproj, dim3(chk::NS), dim3(256), 0, stream, a);
        if (ph == 4) hipLaunchKernelGGL(chk::chk_peerq, dim3(chk::NS), dim3(256), 0, stream, a);
        if (ph == 5) hipLaunchKernelGGL(chk::chk_topk, dim3(chk::NS), dim3(256), 0, stream, a);
        if (ph == 8) hipLaunchKernelGGL(chk::chk_ple, dim3(chk::NS), dim3(256), 0, stream, a);
        if (ph == 8) hipLaunchKernelGGL(chk::chk_experts, dim3(chk::NS), dim3(256), 0, stream, a);
        if (ph == 9) hipLaunchKernelGGL(chk::chk_final, dim3(chk::NS), dim3(256), 0, stream, a);

#endif
    }
#endif
#if SELFCHECK
    hipLaunchKernelGGL(chk::finish, dim3(2048), dim3(256), 0, stream, a, (int)(LASTP == N_PHASES - 1));
#endif
}
```
